# Optimizing an MI355X kernel written in HIP

```python
import jax, jax.numpy as jnp
from jax import lax
import numpy as np

D_MODEL = 1024
BATCH = 8
SEQ = 4096
DEPTH = 2

HEAD_DIM = 64
BLOCK_Q = 128
ROPE_THETA = 10000.0
EPS = 1e-6
N_BRANCH = 3
FOX_HEADS = 8
FOX_WIDTH = FOX_HEADS * HEAD_DIM
DSA_HEADS = 8
DSA_WIDTH = DSA_HEADS * HEAD_DIM
DSA_KV_RANK = 128
IDX_HEADS = 8
IDX_DIM = 64
DSA_TOPK_MAX = 256
SB_HEADS = 8
SB_WIDTH = SB_HEADS * HEAD_DIM

IN_SIZES = (FOX_WIDTH, FOX_WIDTH, FOX_WIDTH, FOX_HEADS, FOX_WIDTH,
            DSA_WIDTH, DSA_KV_RANK, IDX_HEADS * IDX_DIM, IDX_DIM, IDX_HEADS, DSA_WIDTH,
            SB_WIDTH, SB_WIDTH, SB_WIDTH, SB_WIDTH,
            N_BRANCH * D_MODEL)
N_IN = sum(IN_SIZES)

kernel_name = "hybrid_fox_dsa_stickbreak_gated_block"


def rms_norm(x, g):
    x32 = x.astype(jnp.float32)
    y = x32 * lax.rsqrt(jnp.mean(x32 * x32, axis=-1, keepdims=True) + EPS)
    return (y * g.astype(jnp.float32)).astype(x.dtype)


def rope(x, positions):
    half = x.shape[-1] // 2
    inv_freq = ROPE_THETA ** (-jnp.arange(half, dtype=jnp.float32) / half)
    ang = positions.astype(jnp.float32)[..., None] * inv_freq
    if x.ndim == 4:
        ang = ang[:, :, None, :]
    cos, sin = jnp.cos(ang), jnp.sin(ang)
    x32 = x.astype(jnp.float32)
    x1, x2 = x32[..., :half], x32[..., half:]
    return jnp.concatenate([x1 * cos - x2 * sin, x2 * cos + x1 * sin], axis=-1).astype(x.dtype)


def fox_attention(q, k, v, log_f):
    S, d = q.shape[1], q.shape[3]
    scale = d ** -0.5
    F = jnp.cumsum(log_f, axis=1).transpose(0, 2, 1)
    outs = []
    for i in range(S // BLOCK_Q):
        q0, q1 = i * BLOCK_Q, (i + 1) * BLOCK_Q
        s = jnp.einsum('bqhd,bkhd->bhqk', q[:, q0:q1], k[:, :q1]).astype(jnp.float32) * scale
        bias = F[:, :, q0:q1, None] - F[:, :, None, :q1]
        mask = jnp.arange(q0, q1)[:, None] >= jnp.arange(q1)[None, :]
        p = jax.nn.softmax(jnp.where(mask, s + bias, -jnp.inf), axis=-1)
        outs.append(jnp.einsum('bhqk,bkhd->bqhd', p.astype(v.dtype), v[:, :q1]))
    return jnp.concatenate(outs, axis=1)


def dsa_attention(q, k, v, iq, ik, iw, k_top):
    S, d = q.shape[1], q.shape[3]
    scale = d ** -0.5
    idx_scale = IDX_DIM ** -0.5
    gather = jax.vmap(lambda a, i: a[i])
    outs = []
    for i in range(S // BLOCK_Q):
        q0, q1 = i * BLOCK_Q, (i + 1) * BLOCK_Q
        kend = max(q1, k_top)
        qpos = jnp.arange(q0, q1)
        si = jnp.einsum('bqhd,bkd->bqhk', iq[:, q0:q1], ik[:, :kend]).astype(jnp.float32) * idx_scale
        score = jnp.einsum('bqhk,bqh->bqk', jax.nn.relu(si), iw[:, q0:q1].astype(jnp.float32))
        score = jnp.where(jnp.arange(kend)[None, None, :] <= qpos[None, :, None], score, -jnp.inf)
        _, sel = lax.top_k(score, k_top)
        valid = sel <= qpos[None, :, None]
        k_sel = gather(k, sel)
        v_sel = gather(v, sel)
        s = jnp.einsum('bqhd,bqkd->bqhk', q[:, q0:q1], k_sel).astype(jnp.float32) * scale
        p = jax.nn.softmax(jnp.where(valid[:, :, None, :], s, -jnp.inf), axis=-1)
        outs.append(jnp.einsum('bqhk,bqkd->bqhd', p.astype(v.dtype), v_sel))
    return jnp.concatenate(outs, axis=1)


def stick_breaking_attention(q, k, v):
    S, d = q.shape[1], q.shape[3]
    scale = d ** -0.5
    outs = []
    for i in range(S // BLOCK_Q):
        q0, q1 = i * BLOCK_Q, (i + 1) * BLOCK_Q
        z = jnp.einsum('bqhd,bkhd->bhqk', q[:, q0:q1], k[:, :q1]).astype(jnp.float32) * scale
        mask = jnp.arange(q0, q1)[:, None] > jnp.arange(q1)[None, :]
        log_1m = jnp.where(mask, jax.nn.log_sigmoid(-z), 0.0)
        between = lax.cumsum(log_1m, axis=3, reverse=True) - log_1m
        a = jnp.where(mask, jnp.exp(jax.nn.log_sigmoid(z) + between), 0.0)
        outs.append(jnp.einsum('bhqk,bkhd->bqhd', a.astype(v.dtype), v[:, :q1]))
    return jnp.concatenate(outs, axis=1)


def mixer_layer(x, c, positions, w_ada, b_ada, g_norm, w_in, b_fgt, g_kv, w_kv_up,
                w_br_fox, w_br_dsa, w_br_sb, w_out):
    B, S, _ = x.shape
    k_top = min(DSA_TOPK_MAX, S // 4)
    mod = jax.nn.silu(c) @ w_ada + b_ada
    shift, scale, gate = jnp.split(mod, 3, axis=-1)
    h = rms_norm(x, g_norm) * (1.0 + scale[:, None, :]) + shift[:, None, :]
    z = h @ w_in
    points = [int(p) for p in np.cumsum(IN_SIZES)[:-1]]
    (fq, fk, fv, ff, fg,
     dq, dckv, diq, dik, diw, dg,
     sq, sk, sv, sg, merge) = jnp.split(z, points, axis=-1)
    heads = lambda t, n: t.reshape(B, S, n, HEAD_DIM)

    log_f = jax.nn.log_sigmoid((ff + b_fgt).astype(jnp.float32))
    y_fox = fox_attention(heads(fq, FOX_HEADS), heads(fk, FOX_HEADS), heads(fv, FOX_HEADS), log_f)
    y_fox = y_fox.reshape(B, S, FOX_WIDTH) * jax.nn.silu(fg)

    kv = rms_norm(dckv, g_kv) @ w_kv_up
    dk, dv = kv[..., :HEAD_DIM], kv[..., HEAD_DIM:]
    q_d = rope(heads(dq, DSA_HEADS), positions)
    dk = rope(dk, positions)
    iq = rope(diq.reshape(B, S, IDX_HEADS, IDX_DIM), positions)
    ik = rope(dik, positions)
    iw = diw * (IDX_HEADS ** -0.5)
    y_dsa = dsa_attention(q_d, dk, dv, iq, ik, iw, k_top)
    y_dsa = y_dsa.reshape(B, S, DSA_WIDTH) * jax.nn.silu(dg)

    y_sb = stick_breaking_attention(heads(sq, SB_HEADS), heads(sk, SB_HEADS), heads(sv, SB_HEADS))
    y_sb = y_sb.reshape(B, S, SB_WIDTH) * jax.nn.silu(sg)

    m_fox, m_dsa, m_sb = jnp.split(jax.nn.sigmoid(merge), N_BRANCH, axis=-1)
    mixed = m_fox * (y_fox @ w_br_fox) + m_dsa * (y_dsa @ w_br_dsa) + m_sb * (y_sb @ w_br_sb)
    return x + gate[:, None, :] * (mixed @ w_out)


def setup_inputs(seed: int = 0) -> dict:
    key = jax.random.key(seed)
    ks = jax.random.split(key, 16)
    nrm = lambda k, shape, s: jax.random.normal(k, shape, jnp.float32) * s
    D = D_MODEL
    x = nrm(ks[0], (BATCH, SEQ, D), 1.0)
    c = nrm(ks[1], (BATCH, D), 1.0)
    offsets = jax.random.randint(ks[2], (BATCH, 1), 0, SEQ, dtype=jnp.int32)
    positions = jnp.arange(SEQ, dtype=jnp.int32)[None, :] + offsets
    return {
        "x": x,
        "c": c,
        "positions": positions,
        "w_ada": nrm(ks[3], (DEPTH, D, 3 * D), 0.5 * D ** -0.5),
        "b_ada": nrm(ks[4], (DEPTH, 3 * D), 0.02),
        "g_norm": 1.0 + nrm(ks[5], (DEPTH, D), 0.02),
        "w_in": nrm(ks[6], (DEPTH, D, N_IN), D ** -0.5),
        "b_fgt": 2.0 + nrm(ks[7], (DEPTH, FOX_HEADS), 0.5),
        "g_kv": 1.0 + nrm(ks[8], (DEPTH, DSA_KV_RANK), 0.02),
        "w_kv_up": nrm(ks[9], (DEPTH, DSA_KV_RANK, 2 * HEAD_DIM), DSA_KV_RANK ** -0.5),
        "w_br_fox": nrm(ks[10], (DEPTH, FOX_WIDTH, D), FOX_WIDTH ** -0.5),
        "w_br_dsa": nrm(ks[11], (DEPTH, DSA_WIDTH, D), DSA_WIDTH ** -0.5),
        "w_br_sb": nrm(ks[12], (DEPTH, SB_WIDTH, D), SB_WIDTH ** -0.5),
        "w_out": nrm(ks[13], (DEPTH, D, D), D ** -0.5),
        "g_final": 1.0 + nrm(ks[14], (D,), 0.02),
    }


def reference(x, c, positions, w_ada, b_ada, g_norm, w_in, b_fgt, g_kv, w_kv_up,
              w_br_fox, w_br_dsa, w_br_sb, w_out, g_final):
    for l in range(DEPTH):
        x = mixer_layer(x, c, positions, w_ada[l], b_ada[l], g_norm[l], w_in[l], b_fgt[l],
                        g_kv[l], w_kv_up[l], w_br_fox[l], w_br_dsa[l], w_br_sb[l], w_out[l])
    return rms_norm(x, g_final)
```

```cpp
#include <hip/hip_runtime.h>
#include <hip/hip_cooperative_groups.h>
#include <cstdio>
#include <cstdint>
namespace cg = cooperative_groups;
#ifndef REP_DA
#define REP_DA 1
#endif
#ifndef REP_DB
#define REP_DB 1
#endif
#ifndef REP_DC
#define REP_DC 1
#endif

#define LAS __attribute__((address_space(3)))
typedef unsigned short bf16_t;
typedef short bf16x8 __attribute__((ext_vector_type(8)));
typedef short bf16x4 __attribute__((ext_vector_type(4)));
typedef float f32x4 __attribute__((ext_vector_type(4)));
typedef float f32x2 __attribute__((ext_vector_type(2)));
typedef float f32x16 __attribute__((ext_vector_type(16)));
typedef unsigned u32x4 __attribute__((ext_vector_type(4)));
typedef unsigned u32x2 __attribute__((ext_vector_type(2)));

constexpr int DM = 1024, NB = 8, SEQ = 4096, NTOK = NB * SEQ, DEPTH = 2;
constexpr int NIN = 8912, NPAD = 8960;
constexpr float LOG2E = 1.4426950408889634f;
constexpr float C2 = 0.125f * LOG2E;
constexpr float EPS = 1e-6f;
constexpr int NWAVES = 8, NTHR = 512;
constexpr int LDS_BYTES = 147456;

constexpr size_t MiB = 1u << 20;
constexpr size_t WS_MOD = 1 * MiB;
constexpr size_t WS_F2 = 2 * MiB;
constexpr size_t WS_CS = 8 * MiB;
constexpr size_t WS_WTBR = 16 * MiB;
constexpr size_t WS_WTOUT = 22 * MiB;
constexpr size_t WS_WTIN = 28 * MiB;
constexpr size_t WS_H = 46 * MiB;
constexpr size_t WS_QF = 110 * MiB;
constexpr size_t WS_QD = 142 * MiB;
constexpr size_t WS_QS = 174 * MiB;
constexpr size_t WS_GF = 206 * MiB;
constexpr size_t WS_GD = 238 * MiB;
constexpr size_t WS_GS = 270 * MiB;
constexpr size_t WS_MIX = 206 * MiB;
constexpr size_t WS_KF = 302 * MiB;
constexpr size_t WS_KS = 334 * MiB;
constexpr size_t WS_VT = 366 * MiB;
constexpr size_t WS_IQ = 430 * MiB;
constexpr size_t WS_DCKV = 462 * MiB;
constexpr size_t WS_MISCF = 470 * MiB;
constexpr size_t WS_DK = 486 * MiB;
constexpr size_t WS_DV = 490 * MiB;
constexpr size_t WS_M3 = 302 * MiB;
constexpr size_t WS_IK = 494 * MiB;
constexpr size_t WS_END = 498 * MiB;

__device__ const double INVF[32] = {1.0, 0.7498942093324559, 0.5623413251903491, 0.4216965034285822, 0.31622776601683794, 0.23713737056616552, 0.1778279410038923, 0.1333521432163324, 0.1, 0.07498942093324558, 0.05623413251903491, 0.042169650342858224, 0.03162277660168379, 0.023713737056616554, 0.01778279410038923, 0.01333521432163324, 0.01, 0.007498942093324558, 0.005623413251903491, 0.004216965034285823, 0.0031622776601683794, 0.0023713737056616554, 0.0017782794100389228, 0.001333521432163324, 0.001, 0.0007498942093324559, 0.0005623413251903491, 0.00042169650342858224, 0.00031622776601683794, 0.00023713737056616554, 0.00017782794100389227, 0.0001333521432163324};

typedef __bf16 bf16x2_t __attribute__((ext_vector_type(2)));
__device__ __forceinline__ unsigned cvt_pk(float lo, float hi) { f32x2 v = {lo, hi}; bf16x2_t b = __builtin_convertvector(v, bf16x2_t); return __builtin_bit_cast(unsigned, b); }
__device__ __forceinline__ float bf2f(bf16_t v) { return __uint_as_float((unsigned)v << 16); }
__device__ __forceinline__ float bflo(unsigned w) { return __uint_as_float(w << 16); }
__device__ __forceinline__ float bfhi(unsigned w) { return __uint_as_float(w & 0xffff0000u); }
__device__ __forceinline__ float ex2(float x) { return __builtin_amdgcn_exp2f(x); }
__device__ __forceinline__ float lg2(float x) { return __builtin_amdgcn_logf(x); }
__device__ __forceinline__ float sigmoidf_(float x) { return __builtin_amdgcn_rcpf(1.0f + ex2(-x * LOG2E)); }
__device__ __forceinline__ int lane_id_fresh() { unsigned ones = ~0u; asm volatile("" : "+s"(ones)); return __builtin_amdgcn_mbcnt_hi(ones, __builtin_amdgcn_mbcnt_lo(ones, 0u)); }
__device__ __forceinline__ float shx(float v, int o, int lane) { return __int_as_float(__builtin_amdgcn_ds_bpermute((lane ^ o) << 2, __float_as_int(v))); }
__device__ __forceinline__ float wave_sum(float v, int lane) {
#pragma unroll
    for (int o = 1; o < 64; o <<= 1) v += shx(v, o, lane);
    return v;
}
__device__ __forceinline__ int crow(int r, int hi) { return (r & 3) + 8 * (r >> 2) + 4 * hi; }
__device__ __forceinline__ f32x16 mfma32(bf16x8 a, bf16x8 b, f32x16 c) { return __builtin_amdgcn_mfma_f32_32x32x16_bf16(a, b, c, 0, 0, 0); }
__device__ __forceinline__ f32x4 mfma16(bf16x8 a, bf16x8 b, f32x4 c) { return __builtin_amdgcn_mfma_f32_16x16x32_bf16(a, b, c, 0, 0, 0); }
__device__ __forceinline__ bf16x8 pack8(float a0, float a1, float a2, float a3, float a4, float a5, float a6, float a7) {
    u32x4 w; w.x = cvt_pk(a0, a1); w.y = cvt_pk(a2, a3); w.z = cvt_pk(a4, a5); w.w = cvt_pk(a6, a7); return __builtin_bit_cast(bf16x8, w);
}
__device__ __forceinline__ int mbcnt64(unsigned long long m) { return __builtin_amdgcn_mbcnt_hi((unsigned)(m >> 32), __builtin_amdgcn_mbcnt_lo((unsigned)m, 0u)); }

namespace pg8 {
constexpr int BM = 256, BK = 64, HALF = 128, HTB = HALF * BK * 2, STAGE_BYTES = 8 * HTB, NXCD = 8, WGM = 8;
__device__ __forceinline__ int lds_byte(int r, int c) { const int st = (r >> 4) * 2 + (c >> 5), rr = r & 15, cc = c & 31, ob = rr * 64 + cc * 2; return st * 1024 + (ob ^ (((ob >> 9) & 1) << 5)); }
__device__ __forceinline__ void stage_rc(int b, int& R, int& C) { const int st = b / 1024, sb = b % 1024, swz = sb ^ (((sb >> 9) & 1) << 5); R = (st >> 1) * 16 + swz / 64; C = (st & 1) * 32 + (swz % 64) / 2; }
__device__ __forceinline__ int perm32(int rho) { const int n = rho >> 4, i = rho & 15; return 8 * (i >> 2) + 4 * n + (i & 3); }
struct Unit { int pm, pn, aux; };

struct StaticOrder {
    int nM, nN, nwg, G, c;
    __device__ void init(int M, int N, int G_, int c_) { nM = M / BM; nN = N / BM; nwg = nM * nN; G = G_; c = c_; }
    __device__ bool next(int i, Unit& u) const {
        const long L = (long)i * G + c; if (L >= nwg) return false;
        int wgid = (int)L; { const int q = nwg / NXCD, r = nwg % NXCD, xcd = wgid % NXCD, off = wgid / NXCD; wgid = (xcd < r ? xcd * (q + 1) : r * (q + 1) + (xcd - r) * q) + off; }
        const int nig = WGM * nN, gid = wgid / nig, fm = gid * WGM, gsz = (nM - fm) < WGM ? (nM - fm) : WGM;
        u.pm = fm + ((wgid % nig) % gsz); u.pn = (wgid % nig) / gsz; u.aux = 0; return true;
    }
};
struct SchedStd {
    const char* A; const char* B; size_t tstep; StaticOrder so;
    __device__ void init(const void* A_, const void* B_, int M, int N, int K, int G, int c) { A = (const char*)A_; B = (const char*)B_; tstep = (size_t)BM * K * 2; so.init(M, N, G, c); }
    __device__ __forceinline__ bool next(int i, Unit& u) const { return so.next(i, u); }
    __device__ __forceinline__ const char* a_base(const Unit& u) const { return A + (size_t)u.pm * tstep; }
    __device__ __forceinline__ const char* b_base(const Unit& u) const { return B + (size_t)u.pn * tstep; }
};
struct SchedMix {
    const char* Y; const char* W; int G, c;
    __device__ __forceinline__ bool next(int i, Unit& u) const { const int tl = c + G * (i / 3); if (tl >= 512) return false; u.pm = tl >> 2; u.pn = tl & 3; u.aux = i % 3; return true; }
    __device__ __forceinline__ const char* a_base(const Unit& u) const { return Y + (size_t)u.aux * (32 * MiB) + (size_t)u.pm * (256 * 512 * 2); }
    __device__ __forceinline__ const char* b_base(const Unit& u) const { return W + (size_t)u.aux * (1024 * 512 * 2) + (size_t)u.pn * (256 * 512 * 2); }
};

template <class Epi, class Sched>
__device__ __forceinline__ void gemm_phase(LAS unsigned char* lds, const int K, const Sched& S, const Epi& E, const int wid) {
    int lane = lane_id_fresh(); asm volatile("" : "+v"(lane));
    const int tid = wid * 64 + lane, wr = wid >> 2, wc = wid & 3, fr = lane & 15, fq = lane >> 4;
    const int nt = K / BK;
    unsigned voffA[2], voffB[2];
#pragma unroll
    for (int i = 0; i < 2; ++i) { int R, C; stage_rc(tid * 16 + i * 8192, R, C); const int Rb = (R & ~31) + perm32(R & 31);
        voffA[i] = (unsigned)(R * K + C) * 2u; voffB[i] = (unsigned)(Rb * K + C) * 2u; }
    const size_t kstep = (size_t)(BK * 2);
    const size_t hstep = (size_t)HALF * K * 2;
    const unsigned ldsw = (unsigned)wid * 1024u;
    const int aoff = lds_byte(wr * 64 + fr, fq * 8), boff = lds_byte(wc * 32 + fr, fq * 8);
#define PG8_SA(b, h) (((b) * 2 + (h)) * HTB)
#define PG8_SB(b, h) ((4 + (b) * 2 + (h)) * HTB)
#define PG8_STAGE(bufoff, gbase, voff) do { _Pragma("unroll") for (int _i = 0; _i < 2; ++_i) \
        __builtin_amdgcn_global_load_lds((const unsigned*)((const char*)(gbase) + (voff)[_i]), (LAS unsigned*)(lds + (bufoff) + ldsw + _i * 8192), 16, 0, 0); } while (0)
#define PG8_LDA(dst, b, h) do { _Pragma("unroll") for (int m = 0; m < 4; ++m) _Pragma("unroll") for (int k = 0; k < 2; ++k) dst[m][k] = *(const LAS bf16x8*)(lds + PG8_SA(b, h) + aoff + m * 2048 + k * 1024); } while (0)
#define PG8_LDB(dst, b, h) do { _Pragma("unroll") for (int n = 0; n < 2; ++n) _Pragma("unroll") for (int k = 0; k < 2; ++k) dst[n][k] = *(const LAS bf16x8*)(lds + PG8_SB(b, h) + boff + n * 2048 + k * 1024); } while (0)
#define PG8_MMA(ai, bj, At, Bt) do { __builtin_amdgcn_s_setprio(1); _Pragma("unroll") for (int m = 0; m < 4; ++m) _Pragma("unroll") for (int n = 0; n < 2; ++n) _Pragma("unroll") for (int k = 0; k < 2; ++k) \
        acc[ai][bj][m][n] = __builtin_amdgcn_mfma_f32_16x16x32_bf16(Bt[n][k], At[m][k], acc[ai][bj][m][n], 0, 0, 0); __builtin_amdgcn_s_setprio(0); } while (0)
#define PG8_WAIT_V(n) asm volatile("s_waitcnt vmcnt(" #n ")" ::: "memory")
#define PG8_WAIT_L(n) asm volatile("s_waitcnt lgkmcnt(" #n ")" ::: "memory")
#define PG8_BAR __builtin_amdgcn_s_barrier()
#define PG8_SCHED __builtin_amdgcn_sched_barrier(0)
    Unit cur, nxt; int ui = 0;
    if (!S.next(0, cur)) return;
    f32x4 acc[2][2][4][2];
#pragma unroll
    for (int a = 0; a < 2; ++a)
#pragma unroll
        for (int b = 0; b < 2; ++b)
#pragma unroll
            for (int m = 0; m < 4; ++m)
#pragma unroll
                for (int n = 0; n < 2; ++n) acc[a][b][m][n] = (f32x4){0.f, 0.f, 0.f, 0.f};
    bf16x8 At[4][2], B0[2][2], B1[2][2];
    const char* cA = S.a_base(cur); const char* cB = S.b_base(cur);
    PG8_STAGE(PG8_SB(0, 0), cB, voffB); PG8_STAGE(PG8_SB(0, 1), cB + hstep, voffB); PG8_STAGE(PG8_SA(0, 0), cA, voffA); PG8_STAGE(PG8_SA(0, 1), cA + hstep, voffA);
    if (wr == 1) PG8_BAR;
    PG8_WAIT_V(2); PG8_BAR;
    PG8_STAGE(PG8_SB(1, 0), cB + kstep, voffB); PG8_STAGE(PG8_SA(1, 0), cA + kstep, voffA); PG8_STAGE(PG8_SB(1, 1), cB + hstep + kstep, voffB);
    PG8_WAIT_V(6); PG8_BAR;
    for (;;) {
        const bool has_next = S.next(ui + 1, nxt);
        const char* nA = has_next ? S.a_base(nxt) : cA; const char* nB = has_next ? S.b_base(nxt) : cB;
        for (int t = 0; t < nt; t += 2) {
            const bool last = (t == nt - 2);
            const char* a1 = cA + (size_t)(t + 1) * kstep;
            const char* a2 = last ? nA : cA + (size_t)(t + 2) * kstep; const char* b2 = last ? nB : cB + (size_t)(t + 2) * kstep;
            const char* a3 = a2 + kstep; const char* b3 = b2 + kstep;
            PG8_LDB(B0, 0, 0); PG8_LDB(B1, 0, 1); PG8_SCHED; PG8_LDA(At, 0, 0); PG8_STAGE(PG8_SA(1, 1), a1 + hstep, voffA);
            PG8_WAIT_V(8); PG8_WAIT_L(0); PG8_BAR; PG8_MMA(0, 0, At, B0); PG8_MMA(0, 1, At, B1); PG8_BAR; PG8_SCHED;
            PG8_LDA(At, 0, 1); PG8_STAGE(PG8_SB(0, 0), b2, voffB); PG8_STAGE(PG8_SB(0, 1), b2 + hstep, voffB); PG8_STAGE(PG8_SA(0, 0), a2, voffA);
            PG8_WAIT_V(8); PG8_WAIT_L(0); PG8_BAR; PG8_MMA(1, 0, At, B0); PG8_MMA(1, 1, At, B1); PG8_BAR; PG8_SCHED;
            PG8_LDB(B0, 1, 0); PG8_LDB(B1, 1, 1); PG8_SCHED; PG8_LDA(At, 1, 0); PG8_STAGE(PG8_SA(0, 1), a2 + hstep, voffA);
            PG8_WAIT_V(8); PG8_WAIT_L(0); PG8_BAR; PG8_MMA(0, 0, At, B0); PG8_MMA(0, 1, At, B1); PG8_BAR; PG8_SCHED;
            PG8_LDA(At, 1, 1); PG8_STAGE(PG8_SB(1, 0), b3, voffB); PG8_STAGE(PG8_SB(1, 1), b3 + hstep, voffB); PG8_STAGE(PG8_SA(1, 0), a3, voffA);
            PG8_WAIT_V(8); PG8_WAIT_L(0); PG8_BAR; PG8_MMA(1, 0, At, B0); PG8_MMA(1, 1, At, B1); PG8_BAR; PG8_SCHED;
        }
        if (wr == 0) PG8_BAR;
        E(acc, cur, wr, wc, fr, fq);
        if (!has_next) break;
#pragma unroll
        for (int a = 0; a < 2; ++a)
#pragma unroll
            for (int b = 0; b < 2; ++b)
#pragma unroll
                for (int m = 0; m < 4; ++m)
#pragma unroll
                    for (int n = 0; n < 2; ++n) acc[a][b][m][n] = (f32x4){0.f, 0.f, 0.f, 0.f};
        cur = nxt; cA = nA; cB = nB; ++ui;
        if (wr == 1) PG8_BAR;
    }
    PG8_WAIT_V(0);
    PG8_BAR;
#undef PG8_SA
#undef PG8_SB
#undef PG8_STAGE
#undef PG8_LDA
#undef PG8_LDB
#undef PG8_MMA
#undef PG8_WAIT_V
#undef PG8_WAIT_L
#undef PG8_BAR
#undef PG8_SCHED
}
}
using pg8::Unit;

__device__ __forceinline__ u32x4 pack_f8(const f32x4& v0, const f32x4& v1) { u32x4 w; w.x = cvt_pk(v0[0], v0[1]); w.y = cvt_pk(v0[2], v0[3]); w.z = cvt_pk(v1[0], v1[1]); w.w = cvt_pk(v1[2], v1[3]); return w; }

struct EpiIn {
    unsigned char* ws;
    __device__ __forceinline__ void operator()(const f32x4 (&acc)[2][2][4][2], const Unit& u, int wr, int wc, int fr, int fq) const {
        const int pn = u.pn; const int row0 = u.pm * 256 + wr * 64 + fr;
        if (pn == 18) {
            bf16_t* dc = (bf16_t*)(ws + WS_DCKV); float* mf = (float*)(ws + WS_MISCF);
            const int col = wc * 32 + 8 * fq;
#pragma unroll
            for (int ai = 0; ai < 2; ++ai)
#pragma unroll
                for (int m = 0; m < 4; ++m) { const size_t row = (size_t)(row0 + ai * 128 + m * 16);
                    *(u32x4*)(dc + row * 128 + col) = pack_f8(acc[ai][0][m][0], acc[ai][0][m][1]);
                    *(f32x4*)(mf + row * 128 + col) = acc[ai][1][m][0]; *(f32x4*)(mf + row * 128 + col + 4) = acc[ai][1][m][1]; asm volatile("" ::: "memory"); }
            return;
        }
        const int grp = pn >> 1, half = pn & 1;
        size_t boff; int mode = 0; float sc = 1.f;
        switch (grp) {
            case 0: boff = WS_QF; sc = C2; break;
            case 1: boff = WS_KF; mode = 3; break;
            case 2: boff = WS_GF; mode = 1; break;
            case 3: boff = WS_QD; mode = 2; sc = C2; break;
            case 4: boff = WS_IQ; mode = 2; break;
            case 5: boff = WS_GD; mode = 1; break;
            case 6: boff = WS_QS; sc = C2; break;
            case 7: boff = WS_KS; mode = 3; break;
            default: boff = WS_GS; mode = 1; break;
        }
        bf16_t* base = (bf16_t*)(ws + boff);
        if (mode == 2) {
            const f32x4* cs = (const f32x4*)(ws + WS_CS);
            const int head = half * 4 + wc, i0 = 8 * fq;
#pragma unroll
            for (int ai = 0; ai < 2; ++ai)
#pragma unroll
                for (int m = 0; m < 4; ++m) { const size_t row = (size_t)(row0 + ai * 128 + m * 16);
                    const f32x4* cp = cs + (row * 32 + i0) / 2;
                    f32x4 y1[2], y2[2];
#pragma unroll
                    for (int n = 0; n < 2; ++n) { const f32x4 ca = cp[2 * n], cb = cp[2 * n + 1];
                        const f32x4 x1 = acc[ai][0][m][n], x2 = acc[ai][1][m][n];
                        y1[n][0] = (x1[0] * ca[0] - x2[0] * ca[1]) * sc; y2[n][0] = (x2[0] * ca[0] + x1[0] * ca[1]) * sc;
                        y1[n][1] = (x1[1] * ca[2] - x2[1] * ca[3]) * sc; y2[n][1] = (x2[1] * ca[2] + x1[1] * ca[3]) * sc;
                        y1[n][2] = (x1[2] * cb[0] - x2[2] * cb[1]) * sc; y2[n][2] = (x2[2] * cb[0] + x1[2] * cb[1]) * sc;
                        y1[n][3] = (x1[3] * cb[2] - x2[3] * cb[3]) * sc; y2[n][3] = (x2[3] * cb[2] + x1[3] * cb[3]) * sc; }
                    bf16_t* rp = base + row * 512 + head * 64 + i0;
                    *(u32x4*)rp = pack_f8(y1[0], y1[1]); *(u32x4*)(rp + 32) = pack_f8(y2[0], y2[1]); if (m & 1) asm volatile("" ::: "memory"); }
            return;
        }
        if (mode == 3) {
#pragma unroll
            for (int ai = 0; ai < 2; ++ai)
#pragma unroll
                for (int m = 0; m < 4; ++m) { const int tok = row0 + ai * 128 + m * 16; const int b = tok >> 12, sq = tok & 4095, kv = sq & 63;
#pragma unroll
                    for (int bj = 0; bj < 2; ++bj) { const int head = half * 4 + bj * 2 + (wc >> 1), d0 = (wc & 1) * 2 + (fq >> 1);
                        bf16_t* bp = base + (((size_t)(b * 8 + head) * 64 + (sq >> 6)) * 4096) + (((kv >> 5) * 4 + d0) * 64 + (fq & 1) * 32 + (kv & 31)) * 8;
                        *(u32x4*)bp = pack_f8(acc[ai][bj][m][0], acc[ai][bj][m][1]); }
                    asm volatile("" ::: "memory"); }
            return;
        }
        const int col0 = half * 256 + wc * 32 + 8 * fq;
#pragma unroll
        for (int ai = 0; ai < 2; ++ai)
#pragma unroll
            for (int m = 0; m < 4; ++m) { bf16_t* rowp = base + (size_t)(row0 + ai * 128 + m * 16) * 512 + col0;
#pragma unroll
                for (int bj = 0; bj < 2; ++bj) { f32x4 v0 = acc[ai][bj][m][0], v1 = acc[ai][bj][m][1];
                    if (mode == 1) {
#pragma unroll
                        for (int e = 0; e < 4; ++e) { v0[e] = v0[e] * sigmoidf_(v0[e]); v1[e] = v1[e] * sigmoidf_(v1[e]); } }
                    else { v0 = v0 * sc; v1 = v1 * sc; }
                    *(u32x4*)(rowp + bj * 128) = pack_f8(v0, v1); asm volatile("" ::: "memory"); } }
    }
};
struct EpiPlain {
    bf16_t* O; size_t ldc;
    __device__ __forceinline__ void operator()(const f32x4 (&acc)[2][2][4][2], const Unit& u, int wr, int wc, int fr, int fq) const {
        const int row0 = u.pm * 256 + wr * 64 + fr, col0 = u.pn * 256 + wc * 32 + 8 * fq;
#pragma unroll
        for (int ai = 0; ai < 2; ++ai)
#pragma unroll
            for (int m = 0; m < 4; ++m) { const int r = row0 + ai * 128 + m * 16; const int hb = r >> 6, d = r & 63;
#pragma unroll
                for (int bj = 0; bj < 2; ++bj) { const int tok = col0 + bj * 128; const int b = tok >> 12, sq = tok & 4095, j = sq >> 6, kv0 = sq & 63;
                    bf16_t* bp = O + (((size_t)(hb * 8 + b) * 64 + j) * 4096) + (((kv0 >> 4) * 2 + (d >> 5)) * 64 + (d & 31)) * 8 + ((kv0 & 8) >> 1);
                    const u32x4 w = pack_f8(acc[ai][bj][m][0], acc[ai][bj][m][1]);
                    *(u32x2*)bp = (u32x2){w.x, w.y}; *(u32x2*)(bp + 32 * 8) = (u32x2){w.z, w.w}; }
                asm volatile("" ::: "memory"); }
    }
};
struct EpiMerge {
    bf16_t* O;
    __device__ __forceinline__ void operator()(const f32x4 (&acc)[2][2][4][2], const Unit& u, int wr, int wc, int fr, int fq) const {
        const int row0 = u.pm * 256 + wr * 64 + fr, col0 = u.pn * 256 + wc * 32 + 8 * fq;
#pragma unroll
        for (int ai = 0; ai < 2; ++ai)
#pragma unroll
            for (int m = 0; m < 4; ++m) { bf16_t* rowp = O + (size_t)(row0 + ai * 128 + m * 16) * 3072 + col0;
#pragma unroll
                for (int bj = 0; bj < 2; ++bj) { f32x4 v0 = acc[ai][bj][m][0], v1 = acc[ai][bj][m][1];
#pragma unroll
                    for (int e = 0; e < 4; ++e) { v0[e] = sigmoidf_(v0[e]); v1[e] = sigmoidf_(v1[e]); }
                    *(u32x4*)(rowp + bj * 128) = pack_f8(v0, v1); asm volatile("" ::: "memory"); } }
    }
};
struct EpiMix {
    const bf16_t* M3; bf16_t* MIX;
    __device__ __forceinline__ void operator()(const f32x4 (&acc)[2][2][4][2], const Unit& u, int wr, int wc, int fr, int fq) const {
        const int row0 = u.pm * 256 + wr * 64 + fr, col0 = u.pn * 256 + wc * 32 + 8 * fq; const int br = u.aux;
#pragma unroll
        for (int ai = 0; ai < 2; ++ai) {
            u32x4 g[2][4], o[2][4];
#pragma unroll
            for (int bj = 0; bj < 2; ++bj)
#pragma unroll
                for (int m = 0; m < 4; ++m) { const size_t row = (size_t)(row0 + ai * 128 + m * 16); const int col = col0 + bj * 128;
                    g[bj][m] = *(const u32x4*)(M3 + row * 3072 + br * 1024 + col);
                    if (br != 0) o[bj][m] = *(const u32x4*)(MIX + row * 1024 + col); else o[bj][m] = (u32x4){0u, 0u, 0u, 0u}; }
#pragma unroll
            for (int bj = 0; bj < 2; ++bj)
#pragma unroll
                for (int m = 0; m < 4; ++m) { const size_t row = (size_t)(row0 + ai * 128 + m * 16); const int col = col0 + bj * 128;
                    const u32x4 gg = g[bj][m], oo = o[bj][m];
                    f32x4 v0 = acc[ai][bj][m][0], v1 = acc[ai][bj][m][1];
                    v0[0] = v0[0] * bflo(gg.x) + bflo(oo.x); v0[1] = v0[1] * bfhi(gg.x) + bfhi(oo.x); v0[2] = v0[2] * bflo(gg.y) + bflo(oo.y); v0[3] = v0[3] * bfhi(gg.y) + bfhi(oo.y);
                    v1[0] = v1[0] * bflo(gg.z) + bflo(oo.z); v1[1] = v1[1] * bfhi(gg.z) + bfhi(oo.z); v1[2] = v1[2] * bflo(gg.w) + bflo(oo.w); v1[3] = v1[3] * bfhi(gg.w) + bfhi(oo.w);
                    *(u32x4*)(MIX + row * 1024 + col) = pack_f8(v0, v1); }
            asm volatile("" ::: "memory"); }
    }
};
struct EpiOut {
    const float* xold; float* xnew; const float* gate;
    __device__ __forceinline__ void operator()(const f32x4 (&acc)[2][2][4][2], const Unit& u, int wr, int wc, int fr, int fq) const {
        const int row0 = u.pm * 256 + wr * 64 + fr, col0 = u.pn * 256 + wc * 32 + 8 * fq; const int b = u.pm >> 4;
        const float* gp = gate + (size_t)b * 3072;
#pragma unroll
        for (int bj = 0; bj < 2; ++bj) { const int col = col0 + bj * 128; const f32x4 g0 = *(const f32x4*)(gp + col), g1 = *(const f32x4*)(gp + col + 4);
#pragma unroll
            for (int ai = 0; ai < 2; ++ai) {
                f32x4 a0[4], a1[4];
#pragma unroll
                for (int m = 0; m < 4; ++m) { const size_t off = (size_t)(row0 + ai * 128 + m * 16) * 1024 + col; a0[m] = *(const f32x4*)(xold + off); a1[m] = *(const f32x4*)(xold + off + 4); }
#pragma unroll
                for (int m = 0; m < 4; ++m) { const size_t off = (size_t)(row0 + ai * 128 + m * 16) * 1024 + col;
                    *(f32x4*)(xnew + off) = a0[m] + g0 * acc[ai][bj][m][0]; *(f32x4*)(xnew + off + 4) = a1[m] + g1 * acc[ai][bj][m][1]; }
                asm volatile("" ::: "memory"); } }
    }
};

__device__ __forceinline__ int in_src_col(int np) {
    const int tile = np >> 8, cp = np & 255;
    const int rp = 64 * ((cp & 127) >> 5) + 32 * (cp >> 7) + (cp & 31);
    if (tile < 2) return np;
    if (tile < 4) return 512 + (np - 2 * 256);
    if (tile < 6) return 1544 + (np - 4 * 256);
    if (tile < 8) return 2056 + (tile - 6) * 256 + rp;
    if (tile < 10) return 2696 + (tile - 8) * 256 + rp;
    if (tile < 12) return 3280 + (np - 10 * 256);
    if (tile < 14) return 3792 + (np - 12 * 256);
    if (tile < 16) return 4304 + (np - 14 * 256);
    if (tile < 18) return 5328 + (np - 16 * 256);
    if (tile == 18) { if (cp < 128) return 2568 + cp; if (cp < 192) return 3208 + cp - 128; if (cp < 200) return 1536 + cp - 192; if (cp < 208) return 3272 + cp - 200; return -1; }
    if (tile < 31) return 5840 + (np - 19 * 256);
    if (tile < 33) return 1024 + (np - 31 * 256);
    return 4816 + (np - 33 * 256);
}
template <bool MAP>
__device__ __forceinline__ void transpose_item(const float* W, int K, int N, int NP, bf16_t* WT, LAS float* scr, int item, int lane) {
    const int nblk = NP / 32, kb = item / nblk, nb = item % nblk, k0 = 64 * kb, n0 = 32 * nb;
    int src = n0 + (lane & 31); if (MAP) src = in_src_col(src);
#pragma unroll
    for (int i = 0; i < 32; ++i) { const int kk = 2 * i + (lane >> 5); scr[kk * 33 + (lane & 31)] = (src >= 0) ? W[(size_t)(k0 + kk) * N + src] : 0.f; }
    asm volatile("s_waitcnt lgkmcnt(0)" ::: "memory");
    const int c = lane & 7;
#pragma unroll
    for (int j = 0; j < 4; ++j) { const int n = (lane >> 3) + 8 * j; const LAS float* s = scr + (8 * c) * 33 + n;
        u32x4 o; o.x = cvt_pk(s[0 * 33], s[1 * 33]); o.y = cvt_pk(s[2 * 33], s[3 * 33]); o.z = cvt_pk(s[4 * 33], s[5 * 33]); o.w = cvt_pk(s[6 * 33], s[7 * 33]);
        *(u32x4*)(WT + (size_t)(n0 + n) * K + k0 + 8 * c) = o; }
    asm volatile("s_waitcnt lgkmcnt(0)" ::: "memory");
}

template <bool SB>
__device__ __forceinline__ void attn_fs_wave(const bf16_t* Q, const bf16_t* Kb, const bf16_t* VT, const float* F2, const bf16_t* G, bf16_t* Y, int b, int h, int q0w, int lane, bool do_store, const unsigned* kmaxw) {
    asm volatile("" : "+v"(lane));
    const int r32 = lane & 31, hi = lane >> 5;
    const int tq = q0w + r32;
    const size_t rowQ = (size_t)b * SEQ + tq;
    bf16x8 qf[4];
#pragma unroll
    for (int d0 = 0; d0 < 4; ++d0) qf[d0] = *(const bf16x8*)(Q + rowQ * 512 + h * 64 + d0 * 16 + hi * 8);
    f32x16 o0, o1;
#pragma unroll
    for (int r = 0; r < 16; ++r) { o0[r] = 0.f; o1[r] = 0.f; }
    float m = -INFINITY, l = 0.f, carry = 0.f, Ft = 0.f;
    const float* F2b = F2 + (size_t)(b * 8 + h) * SEQ;
    float qk = 0.f;
    if (!SB) { Ft = F2b[tq];
        float ss = 0.f;
#pragma unroll
        for (int d0 = 0; d0 < 4; ++d0)
#pragma unroll
            for (int e = 0; e < 8; ++e) { const float f = bf2f((bf16_t)qf[d0][e]); ss += f * f; }
        ss += shx(ss, 32, lane);
        qk = sqrtf(ss * __uint_as_float(kmaxw[b * 8 + h])) * 1.001f; }
    const bf16_t* Kh = Kb + (size_t)(b * 8 + h) * 64 * 4096;
    const bf16_t* VTh = VT + (size_t)(h * 8 + b) * 64 * 4096;
    const int jmax = (q0w + 31) >> 6;
    bf16x8 kf[2][4];
#pragma unroll
    for (int hf = 0; hf < 2; ++hf)
#pragma unroll
        for (int d0 = 0; d0 < 4; ++d0) kf[hf][d0] = *(const bf16x8*)(Kh + (size_t)jmax * 4096 + ((hf * 4 + d0) * 64 + lane) * 8);
    for (int j = jmax; j >= 0; --j) {
        const int kv0 = j * 64;
        bf16x8 vf[4][2];
#pragma unroll
        for (int ks = 0; ks < 4; ++ks)
#pragma unroll
            for (int dd = 0; dd < 2; ++dd) vf[ks][dd] = *(const bf16x8*)(VTh + (size_t)j * 4096 + ((ks * 2 + dd) * 64 + lane) * 8);
        bf16x8 kn[2][4];
        { const int jn = (j > 0 ? j - 1 : 0);
#pragma unroll
          for (int hf = 0; hf < 2; ++hf)
#pragma unroll
              for (int d0 = 0; d0 < 4; ++d0) kn[hf][d0] = *(const bf16x8*)(Kh + (size_t)jn * 4096 + ((hf * 4 + d0) * 64 + lane) * 8); }
        f32x4 fa4[4], fb4[4]; float fs_next = 0.f;
        if (!SB) {
#pragma unroll
            for (int g = 0; g < 4; ++g) { fa4[g] = *(const f32x4*)(F2b + kv0 + 8 * g + 4 * hi); fb4[g] = *(const f32x4*)(F2b + kv0 + 32 + 8 * g + 4 * hi); }
            fs_next = F2b[j > 0 ? 64 * j - 1 : 0];
        }
        asm volatile("" ::: "memory");
        f32x16 p0, p1;
#pragma unroll
        for (int r = 0; r < 16; ++r) { p0[r] = 0.f; p1[r] = 0.f; }
#pragma unroll
        for (int d0 = 0; d0 < 4; ++d0) { p0 = mfma32(kf[0][d0], qf[d0], p0); p1 = mfma32(kf[1][d0], qf[d0], p1); }
        if (!SB) {
#pragma unroll
            for (int g = 0; g < 4; ++g) { const f32x4 fa = fa4[g], fb = fb4[g];
#pragma unroll
                for (int e = 0; e < 4; ++e) { p0[4 * g + e] += Ft - fa[e]; p1[4 * g + e] += Ft - fb[e]; } }
            if (j == jmax) {
#pragma unroll
                for (int r = 0; r < 16; ++r) { const int kv = kv0 + crow(r, hi); if (kv > tq) p0[r] = -INFINITY; if (kv + 32 > tq) p1[r] = -INFINITY; } }
            float mx = p0[0];
#pragma unroll
            for (int r = 1; r < 16; ++r) mx = fmaxf(mx, p0[r]);
#pragma unroll
            for (int r = 0; r < 16; ++r) mx = fmaxf(mx, p1[r]);
            mx = fmaxf(mx, shx(mx, 32, lane));
            const float mnew = fmaxf(m, mx); const float alpha = ex2(m - mnew); m = mnew;
            l *= alpha;
#pragma unroll
            for (int r = 0; r < 16; ++r) { o0[r] *= alpha; o1[r] *= alpha; }
            float s = 0.f;
#pragma unroll
            for (int r = 0; r < 16; ++r) { p0[r] = ex2(p0[r] - m); p1[r] = ex2(p1[r] - m); s += p0[r] + p1[r]; }
            l += s;
        } else {
            float lm0[16], lm1[16];
#pragma unroll
            for (int r = 0; r < 16; ++r) {
                const int kv = kv0 + crow(r, hi);
                const float z0 = p0[r], z1 = p1[r];
                const float sp0 = (z0 > 40.f) ? z0 : lg2(1.0f + ex2(z0)), sp1 = (z1 > 40.f) ? z1 : lg2(1.0f + ex2(z1));
                const bool v0 = kv < tq, v1 = (kv + 32) < tq;
                lm0[r] = v0 ? sp0 : 0.f; lm1[r] = v1 ? sp1 : 0.f;
                p0[r] = v0 ? (z0 - sp0) : -INFINITY; p1[r] = v1 ? (z1 - sp1) : -INFINITY;
            }
            float gs0[4], gs1[4], ps0[4], ps1[4];
#pragma unroll
            for (int a = 0; a < 4; ++a) { gs0[a] = (lm0[4 * a] + lm0[4 * a + 1]) + (lm0[4 * a + 2] + lm0[4 * a + 3]); gs1[a] = (lm1[4 * a] + lm1[4 * a + 1]) + (lm1[4 * a + 2] + lm1[4 * a + 3]); }
#pragma unroll
            for (int a = 0; a < 4; ++a) { ps0[a] = shx(gs0[a], 32, lane); ps1[a] = shx(gs1[a], 32, lane); }
            float run = carry;
            float ex0[4], ex1[4];
#pragma unroll
            for (int a = 3; a >= 0; --a) { const float odd = hi ? gs1[a] : ps1[a]; const float pair = gs1[a] + ps1[a]; ex1[a] = run + (hi ? 0.f : odd); run += pair; }
#pragma unroll
            for (int a = 3; a >= 0; --a) { const float odd = hi ? gs0[a] : ps0[a]; const float pair = gs0[a] + ps0[a]; ex0[a] = run + (hi ? 0.f : odd); run += pair; }
            carry = run;
#pragma unroll
            for (int a = 0; a < 4; ++a) {
                float w = ex0[a];
                p0[4 * a + 3] = ex2(p0[4 * a + 3] - w); w += lm0[4 * a + 3];
                p0[4 * a + 2] = ex2(p0[4 * a + 2] - w); w += lm0[4 * a + 2];
                p0[4 * a + 1] = ex2(p0[4 * a + 1] - w); w += lm0[4 * a + 1];
                p0[4 * a + 0] = ex2(p0[4 * a + 0] - w);
                w = ex1[a];
                p1[4 * a + 3] = ex2(p1[4 * a + 3] - w); w += lm1[4 * a + 3];
                p1[4 * a + 2] = ex2(p1[4 * a + 2] - w); w += lm1[4 * a + 2];
                p1[4 * a + 1] = ex2(p1[4 * a + 1] - w); w += lm1[4 * a + 1];
                p1[4 * a + 0] = ex2(p1[4 * a + 0] - w);
            }
        }
        bf16x8 pw[4];
        pw[0] = pack8(p0[0], p0[1], p0[2], p0[3], p0[4], p0[5], p0[6], p0[7]);
        pw[1] = pack8(p0[8], p0[9], p0[10], p0[11], p0[12], p0[13], p0[14], p0[15]);
        pw[2] = pack8(p1[0], p1[1], p1[2], p1[3], p1[4], p1[5], p1[6], p1[7]);
        pw[3] = pack8(p1[8], p1[9], p1[10], p1[11], p1[12], p1[13], p1[14], p1[15]);
#pragma unroll
        for (int ks = 0; ks < 4; ++ks) { o0 = mfma32(vf[ks][0], pw[ks], o0); o1 = mfma32(vf[ks][1], pw[ks], o1); }
#pragma unroll
        for (int hf = 0; hf < 2; ++hf)
#pragma unroll
            for (int d0 = 0; d0 < 4; ++d0) kf[hf][d0] = kn[hf][d0];
        if (SB) { if (__all(carry > 160.f)) break; }
        else if (j > 0) {
            const float fs = fs_next;
            if (__all(qk + Ft - m + 64.f < fs)) break; }
    }
    float inv = 1.f;
    if (!SB) { const float lt = l + shx(l, 32, lane); inv = 1.0f / lt; }
    if (do_store)
#pragma unroll
    for (int g = 0; g < 4; ++g)
#pragma unroll
        for (int dd = 0; dd < 2; ++dd) {
            const size_t off = rowQ * 512 + h * 64 + dd * 32 + 8 * g + 4 * hi;
            const u32x2 gg = *(const u32x2*)(G + off);
            const f32x16& o = dd ? o1 : o0;
            u32x2 w; w.x = cvt_pk(o[4 * g] * inv * bflo(gg.x), o[4 * g + 1] * inv * bfhi(gg.x)); w.y = cvt_pk(o[4 * g + 2] * inv * bflo(gg.y), o[4 * g + 3] * inv * bfhi(gg.y));
            *(u32x2*)(Y + off) = w;
        }
}

__device__ __forceinline__ int wave_total(int v) {
    v += __builtin_amdgcn_update_dpp(0, v, 0x111, 0xf, 0xf, false);
    v += __builtin_amdgcn_update_dpp(0, v, 0x112, 0xf, 0xf, false);
    v += __builtin_amdgcn_update_dpp(0, v, 0x114, 0xf, 0xf, false);
    v += __builtin_amdgcn_update_dpp(0, v, 0x118, 0xf, 0xf, false);
    v += __builtin_amdgcn_update_dpp(0, v, 0x142, 0xa, 0xf, false);
    v += __builtin_amdgcn_update_dpp(0, v, 0x143, 0xc, 0xf, false);
    return __builtin_amdgcn_readlane(v, 63);
}
#ifndef DSA_SELFCHECK
#define DSA_SELFCHECK 0
#endif
__device__ __forceinline__ void dsa_unit(LAS unsigned char* lds, unsigned char* ws, int b, int t0, int wid, int lane, bool do_store) {
    asm volatile("" : "+v"(lane));
    LAS float* sc = (LAS float*)lds;
    LAS int* lists = (LAS int*)(lds + 131072);
    const bf16_t* IQ = (const bf16_t*)(ws + WS_IQ); const bf16_t* IK = (const bf16_t*)(ws + WS_IK);
    const float* MF = (const float*)(ws + WS_MISCF);
    const bf16_t* DK = (const bf16_t*)(ws + WS_DK); const bf16_t* DV = (const bf16_t*)(ws + WS_DV);
    const bf16_t* GD = (const bf16_t*)(ws + WS_GD); bf16_t* QD = (bf16_t*)(ws + WS_QD);
    const size_t tokb = (size_t)b * SEQ;
    const int r32 = lane & 31, hi = lane >> 5;
    for (int ra_ = 0; ra_ < REP_DA; ++ra_) {
        const int a_ = r32 >> 3, uu = (r32 >> 2) & 1, bb = r32 & 3; const int qq = 2 * uu + (a_ >> 1), hd = 4 * (a_ & 1) + bb;
        bf16x8 af[2][4];
#pragma unroll
        for (int rt = 0; rt < 2; ++rt)
#pragma unroll
            for (int d0 = 0; d0 < 4; ++d0) af[rt][d0] = *(const bf16x8*)(IQ + (tokb + t0 + 4 * rt + qq) * 512 + hd * 64 + d0 * 16 + hi * 8);
        const float WSC = 0.35355339059327373f * 0.125f;
        float w[2][16];
#pragma unroll
        for (int rt = 0; rt < 2; ++rt)
#pragma unroll
            for (int qh = 0; qh < 2; ++qh) { const float* wp = MF + (tokb + t0 + 4 * rt + 2 * hi + qh) * 128 + 72; const f32x4 wa = *(const f32x4*)wp, wb = *(const f32x4*)(wp + 4);
#pragma unroll
                for (int e = 0; e < 4; ++e) { w[rt][8 * qh + e] = wa[e] * WSC; w[rt][8 * qh + 4 + e] = wb[e] * WSC; } }
        const int nkt = (t0 + 8 + 31) >> 5;
        bf16x8 bfr[4];
#pragma unroll
        for (int d0 = 0; d0 < 4; ++d0) bfr[d0] = *(const bf16x8*)(IK + (((size_t)b * 128 + (wid < nkt ? wid : 0)) * 4 + d0) * 512 + lane * 8);
        for (int kt = wid; kt < nkt; kt += 8) {
            const int key = kt * 32 + r32;
            bf16x8 bnx[4];
            { const int ktn = (kt + 8 < nkt) ? kt + 8 : kt;
#pragma unroll
              for (int d0 = 0; d0 < 4; ++d0) bnx[d0] = *(const bf16x8*)(IK + (((size_t)b * 128 + ktn) * 4 + d0) * 512 + lane * 8); }
            asm volatile("" ::: "memory");
            f32x16 c0, c1;
#pragma unroll
            for (int r = 0; r < 16; ++r) { c0[r] = 0.f; c1[r] = 0.f; }
#pragma unroll
            for (int d0 = 0; d0 < 4; ++d0) { c0 = mfma32(af[0][d0], bfr[d0], c0); c1 = mfma32(af[1][d0], bfr[d0], c1); }
            float s00 = 0.f, s01 = 0.f, s10 = 0.f, s11 = 0.f;
#pragma unroll
            for (int r = 0; r < 8; ++r) { s00 += w[0][r] * fmaxf(c0[r], 0.f); s01 += w[0][8 + r] * fmaxf(c0[8 + r], 0.f); s10 += w[1][r] * fmaxf(c1[r], 0.f); s11 += w[1][8 + r] * fmaxf(c1[8 + r], 0.f); }
            const int q00 = 2 * hi, q01 = 2 * hi + 1, q10 = 4 + 2 * hi, q11 = 5 + 2 * hi;
            sc[q00 * 4096 + key] = (key > t0 + q00) ? -INFINITY : s00;
            sc[q01 * 4096 + key] = (key > t0 + q01) ? -INFINITY : s01;
            sc[q10 * 4096 + key] = (key > t0 + q10) ? -INFINITY : s10;
            sc[q11 * 4096 + key] = (key > t0 + q11) ? -INFINITY : s11;
#pragma unroll
            for (int d0 = 0; d0 < 4; ++d0) bfr[d0] = bnx[d0];
        }
    }
    __syncthreads();
    const int t = t0 + wid, n = t + 1;
    int count; bool badsel = false; (void)badsel;
    for (int rb_ = 0; rb_ < REP_DB; ++rb_) {
        unsigned key[64];
        const LAS float* row = sc + wid * 4096;
#pragma unroll
        for (int j = 0; j < 64; ++j) { const int idx = j * 64 + lane; const int idc = idx < n ? idx : n - 1;
            const unsigned bits = __float_as_uint(row[idc]); const unsigned k = bits ^ (unsigned)(((int)bits >> 31) | (int)0x80000000);
            key[j] = idx < n ? k : 0u; }
        unsigned T = 0u; int cT = 0;
        const int nb8 = (n + 511) >> 9;
        bool bad = false; (void)bad;
#define DSA_COUNT(CAND, OUT) do { int cl_ = 0; _Pragma("unroll") for (int jb = 0; jb < 8; ++jb) { if (jb < nb8) { _Pragma("unroll") for (int j = 8 * jb; j < 8 * jb + 8; ++j) cl_ += (key[j] >= (CAND)) ? 1 : 0; } } \
            OUT = wave_total(cl_); \
            if (DSA_SELFCHECK) { int c2_ = 0; _Pragma("unroll") for (int j = 0; j < 64; ++j) c2_ += __builtin_popcountll(__ballot(key[j] >= (CAND))); if (c2_ != OUT) bad = true; } } while (0)
        if (n > 256) {
            int bit = 30, c;
            DSA_COUNT(0x80000000u, c);
            if (c >= 256) { T = 0x80000000u; cT = c;
                if (c > 256) {
                    unsigned mxk = 0u;
#pragma unroll
                    for (int jb = 0; jb < 8; ++jb) { if (jb < nb8) {
#pragma unroll
                        for (int j = 8 * jb; j < 8 * jb + 8; ++j) mxk = key[j] > mxk ? key[j] : mxk; } }
#pragma unroll
                    for (int o = 1; o < 64; o <<= 1) { const unsigned ov = (unsigned)__builtin_amdgcn_ds_bpermute((lane ^ o) << 2, (int)mxk); mxk = ov > mxk ? ov : mxk; }
                    unsigned cand = mxk & 0xFF800000u;
                    for (int tr_ = 0; tr_ < 4; ++tr_) { DSA_COUNT(cand, c); if (c >= 256) { T = cand; cT = c; bit = 22; break; } if (cand <= 0x80800000u) break; cand -= 0x00800000u; }
                }
            }
            for (; bit >= 0 && cT != 256; --bit) { const unsigned cand = T | (1u << bit); DSA_COUNT(cand, c); if (c >= 256) { T = cand; cT = c; } }
            if (DSA_SELFCHECK) {
                unsigned Tr = 0u; int cr = 0;
                for (int b2 = 31; b2 >= 0; --b2) { const unsigned cand = Tr | (1u << b2); int c2 = 0;
#pragma unroll
                    for (int j = 0; j < 64; ++j) c2 += __builtin_popcountll(__ballot(key[j] >= cand));
                    if (c2 >= 256) { Tr = cand; cr = c2; if (c2 == 256) break; } }
                if (cT == 256 || cr == 256) { if (cT != cr) bad = true; } else if (T != Tr) bad = true;
            }
        }
        if (n <= 256) {
            for (int p2 = lane; p2 < 256; p2 += 64) lists[wid * 256 + p2] = p2;
        } else if (cT == 256) {
            int cl = 0;
#pragma unroll
            for (int jb = 0; jb < 8; ++jb) { if (jb < nb8) {
#pragma unroll
                for (int j = 8 * jb; j < 8 * jb + 8; ++j) cl += (key[j] >= T) ? 1 : 0; } }
            int incl = cl;
#pragma unroll
            for (int o = 1; o < 64; o <<= 1) { const int nbv = __builtin_amdgcn_ds_bpermute(((lane >= o) ? (lane - o) : lane) << 2, incl); if (lane >= o) incl += nbv; }
            int off = wid * 256 + incl - cl;
#pragma unroll
            for (int jb = 0; jb < 8; ++jb) { if (jb < nb8) {
#pragma unroll
                for (int j = 8 * jb; j < 8 * jb + 8; ++j) { if (key[j] >= T) { lists[off] = j * 64 + lane; ++off; } } } }
        } else {
        int eqbase = 0;
#pragma unroll
        for (int j = 0; j < 64; ++j) { const int idx = j * 64 + lane;
            const bool eq = (key[j] == T); const unsigned long long meq = __ballot(eq); const int r = eqbase + mbcnt64(meq);
            if (eq && r < 256) lists[wid * 256 + 255 - r] = idx;
            eqbase += __builtin_popcountll(meq); __builtin_amdgcn_sched_barrier(0); }
        int base = 0;
#pragma unroll
        for (int j = 0; j < 64; ++j) { const int idx = j * 64 + lane;
            const bool gt = (key[j] > T); const unsigned long long mg = __ballot(gt); const int pos = base + mbcnt64(mg);
            if (gt) lists[wid * 256 + pos] = idx;
            base += __builtin_popcountll(mg); __builtin_amdgcn_sched_barrier(0); }
        }
        count = n < 256 ? n : 256; badsel = badsel || bad;
    }
    asm volatile("s_waitcnt lgkmcnt(0)" ::: "memory");
    __builtin_amdgcn_wave_barrier();
    for (int rc_ = 0; rc_ < REP_DC; ++rc_) {
        const bool do_store_c = do_store && (rc_ == REP_DC - 1);
        const int hh = lane & 15, g = lane >> 4;
        bf16x8 qb[2];
#pragma unroll
        for (int ks = 0; ks < 2; ++ks) { if (hh < 8) qb[ks] = *(const bf16x8*)(QD + (tokb + t) * 512 + hh * 64 + ks * 32 + g * 8); else qb[ks] = (bf16x8){0, 0, 0, 0, 0, 0, 0, 0}; }
        const LAS int* lw = lists + wid * 256;
        const int cg = count - 4 * g;
        float s[64];
        const int nhalf = (count > 128) ? 2 : 1;
        u32x4 vr[16];
        {
            bf16x8 ka[16][2];
#pragma unroll
            for (int tile = 0; tile < 16; ++tile) { const int idx = lw[tile * 16 + hh];
                ka[tile][0] = *(const bf16x8*)(DK + (tokb + idx) * 64 + g * 8); ka[tile][1] = *(const bf16x8*)(DK + (tokb + idx) * 64 + 32 + g * 8); }
#pragma unroll
            for (int i = 0; i < 16; ++i) { const int row = i * 8 + (lane >> 3); const int idx = lw[row]; vr[i] = *(const u32x4*)(DV + (tokb + idx) * 64 + (lane & 7) * 8); }
            asm volatile("" ::: "memory");
#pragma unroll
            for (int tile = 0; tile < 16; ++tile) {
                f32x4 c = (f32x4){0.f, 0.f, 0.f, 0.f}; c = mfma16(ka[tile][0], qb[0], c); c = mfma16(ka[tile][1], qb[1], c);
#pragma unroll
                for (int j = 0; j < 4; ++j) s[4 * tile + j] = (tile * 16 + j < cg) ? c[j] : -INFINITY; }
        }
        float mx = s[0];
#pragma unroll
        for (int j = 1; j < 64; ++j) mx = fmaxf(mx, s[j]);
        mx = fmaxf(mx, shx(mx, 16, lane)); mx = fmaxf(mx, shx(mx, 32, lane));
        float sum = 0.f;
#pragma unroll
        for (int j = 0; j < 64; ++j) { s[j] = ex2(s[j] - mx); sum += s[j]; }
        sum += shx(sum, 16, lane); sum += shx(sum, 32, lane);
        LAS unsigned char* vs = (LAS unsigned char*)(sc + wid * 4096);
        f32x4 oacc[4];
#pragma unroll
        for (int dt = 0; dt < 4; ++dt) oacc[dt] = (f32x4){0.f, 0.f, 0.f, 0.f};
        u32x2 ggv[4];
#pragma unroll
        for (int dt = 0; dt < 4; ++dt) ggv[dt] = *(const u32x2*)(GD + (tokb + t) * 512 + (hh & 7) * 64 + dt * 16 + 4 * g);
#pragma unroll
        for (int half = 0; half < 2; ++half) {
            if (half < nhalf) {
#pragma unroll
                for (int i = 0; i < 16; ++i) { const int row = i * 8 + (lane >> 3); const int phys = (lane & 7) ^ (2 * ((row >> 2) & 1) + 4 * ((row >> 1) & 1)); *(LAS u32x4*)(vs + row * 128 + phys * 16) = vr[i]; }
                asm volatile("s_waitcnt lgkmcnt(0)" ::: "memory");
                __builtin_amdgcn_wave_barrier();
                if (half == 0 && nhalf == 2) {
#pragma unroll
                    for (int i = 0; i < 16; ++i) { const int row = i * 8 + (lane >> 3); const int idx = lw[128 + row]; vr[i] = *(const u32x4*)(DV + (tokb + idx) * 64 + (lane & 7) * 8); }
                    asm volatile("" ::: "memory");
                }
                const int q_ = (lane >> 2) & 3, p_ = lane & 3;
#pragma unroll
                for (int ks = 0; ks < 4; ++ks) {
                    const int ta = 2 * (half * 4 + ks), tb = ta + 1;
                    const bf16x8 pb = pack8(s[4 * ta], s[4 * ta + 1], s[4 * ta + 2], s[4 * ta + 3], s[4 * tb], s[4 * tb + 1], s[4 * tb + 2], s[4 * tb + 3]);
#pragma unroll
                    for (int dt = 0; dt < 4; ++dt) {
                        const int phys = (2 * dt + (p_ >> 1)) ^ (2 * (g & 1) + 4 * (q_ >> 1));
                        LAS unsigned char* ap = vs + (4 * g + q_) * 128 + phys * 16 + 8 * (p_ & 1) + ks * 4096;
                        const bf16x4 lo = __builtin_bit_cast(bf16x4, __builtin_amdgcn_ds_read_tr16_b64_v4i16((LAS bf16x4*)ap));
                        const bf16x4 hi4 = __builtin_bit_cast(bf16x4, __builtin_amdgcn_ds_read_tr16_b64_v4i16((LAS bf16x4*)(ap + 2048)));
                        const bf16x8 va = (bf16x8){lo[0], lo[1], lo[2], lo[3], hi4[0], hi4[1], hi4[2], hi4[3]};
                        oacc[dt] = mfma16(va, pb, oacc[dt]);
                    }
                }
                asm volatile("s_waitcnt lgkmcnt(0)" ::: "memory");
                __builtin_amdgcn_wave_barrier();
            }
        }
        if (hh < 8 && do_store_c) {
            float inv = 1.0f / sum;
            if (DSA_SELFCHECK && badsel) inv = __builtin_nanf("");
#pragma unroll
            for (int dt = 0; dt < 4; ++dt) { const size_t off = (tokb + t) * 512 + hh * 64 + dt * 16 + 4 * g;
                const u32x2 gg = ggv[dt];
                u32x2 w; w.x = cvt_pk(oacc[dt][0] * inv * bflo(gg.x), oacc[dt][1] * inv * bfhi(gg.x)); w.y = cvt_pk(oacc[dt][2] * inv * bflo(gg.y), oacc[dt][3] * inv * bfhi(gg.y));
                *(u32x2*)(QD + off) = w; }
        }
    }
    __syncthreads();
}

#define XB_TMO      128
#define XB_XCNT(j)  (256  + 64 * (j))
#define XB_XSUB(j)  (1280 + 64 * (j))
#define XB_XGEN(j)  (2304 + 64 * (j))
#define XB_TOP      3328
#define XB_TOPGEN   3392
#define XCD_BAR_WORDS 3456
#define XB_SPIN_CAP (1u << 22)
__device__ __forceinline__ unsigned xb_ld(unsigned* p)              { return __hip_atomic_load(p, __ATOMIC_RELAXED, __HIP_MEMORY_SCOPE_AGENT); }
__device__ __forceinline__ unsigned xb_add(unsigned* p, unsigned v) { return __hip_atomic_fetch_add(p, v, __ATOMIC_RELAXED, __HIP_MEMORY_SCOPE_AGENT); }
__device__ __forceinline__ unsigned xb_xcc_id() { return (unsigned)__builtin_amdgcn_s_getreg((3 << 11) | 20) & 0xFu; }
#define XB_SPIN(cond, bar) do { unsigned _sp = 0; while (cond) { __builtin_amdgcn_s_sleep(1); \
    if ((++_sp & 255u) == 0u) { if (xb_ld(&(bar)[XB_TMO])) break; if (_sp > XB_SPIN_CAP) { atomicAdd(&(bar)[XB_TMO], 1u); break; } } } } while (0)
__device__ __forceinline__ void xcd_barrier_complete(unsigned* bar, unsigned x, unsigned G, unsigned& nloc, unsigned& nx) {
    unsigned sum, cnt, mine, sp = 0u;
    for (;;) {
        sum = 0u; cnt = 0u; mine = 0u;
#pragma unroll
        for (unsigned j = 0; j < 16; ++j) { const unsigned c = xb_ld(&bar[XB_XCNT(j)]); sum += c; cnt += (c > 0u) ? 1u : 0u; mine = (j == x) ? c : mine; }
        if (sum == G) break;
        __builtin_amdgcn_s_sleep(1);
        if ((++sp & 255u) == 0u) { if (xb_ld(&bar[XB_TMO])) break; if (sp > XB_SPIN_CAP) { atomicAdd(&bar[XB_TMO], 1u); break; } }
    }
    nloc = mine > 0u ? mine : 1u; nx = cnt > 0u ? cnt : 1u;
}
__device__ __forceinline__ void xcd_barrier(unsigned* bar, unsigned x, unsigned G, volatile LAS unsigned* st, bool leader) {
    asm volatile("s_waitcnt vmcnt(0)" ::: "memory");
    __syncthreads();
    if (leader) {
        __builtin_amdgcn_s_waitcnt(0);
        unsigned nloc = st[0], nx = st[1];
        if (nloc == 0u) { xcd_barrier_complete(bar, x, G, nloc, nx); st[0] = nloc; st[1] = nx; }
        const unsigned old = xb_add(&bar[XB_XSUB(x)], 1u);
        const unsigned gen = old / nloc;
        if (old + 1u == (gen + 1u) * nloc) {
            __builtin_amdgcn_fence(__ATOMIC_RELEASE, "agent");
            asm volatile("s_waitcnt vmcnt(0)" ::: "memory");
            const unsigned og = xb_add(&bar[XB_TOP], 1u);
            const unsigned tg = og / nx;
            if (og + 1u == (tg + 1u) * nx) xb_add(&bar[XB_TOPGEN], 1u);
            else XB_SPIN(xb_ld(&bar[XB_TOPGEN]) == tg, bar);
            __builtin_amdgcn_fence(__ATOMIC_ACQUIRE, "agent");
            xb_add(&bar[XB_XGEN(x)], 1u);
            asm volatile("s_waitcnt vmcnt(0)" ::: "memory");
        } else {
            XB_SPIN(xb_ld(&bar[XB_XGEN(x)]) == gen, bar);
            __builtin_amdgcn_fence(__ATOMIC_ACQUIRE, "agent");
            asm volatile("s_waitcnt vmcnt(0)" ::: "memory");
        }
    }
    __syncthreads();
}
__device__ __forceinline__ void grid_bar(unsigned* bar, unsigned target, unsigned gen, bool leader) {
    asm volatile("s_waitcnt vmcnt(0) lgkmcnt(0)" ::: "memory");
    __syncthreads();
    if (leader) {
        __builtin_amdgcn_fence(__ATOMIC_RELEASE, "agent");
        asm volatile("s_waitcnt vmcnt(0)" ::: "memory");
        const unsigned old = __hip_atomic_fetch_add(&bar[0], 1u, __ATOMIC_RELAXED, __HIP_MEMORY_SCOPE_AGENT);
        if (old + 1u == target) __hip_atomic_fetch_add(&bar[64], 1u, __ATOMIC_RELAXED, __HIP_MEMORY_SCOPE_AGENT);
        else while (__hip_atomic_load(&bar[64], __ATOMIC_RELAXED, __HIP_MEMORY_SCOPE_AGENT) <= gen) __builtin_amdgcn_s_sleep(1);
        __builtin_amdgcn_fence(__ATOMIC_ACQUIRE, "agent");
        asm volatile("s_waitcnt vmcnt(0)" ::: "memory");
    }
    __syncthreads();
}
#ifndef DBG
#define DBG 0
#endif
#ifndef REP_P2
#define REP_P2 1
#endif
#ifndef REP_FOX
#define REP_FOX 1
#endif
#ifndef REP_SB
#define REP_SB 1
#endif
#ifndef REP_DSA
#define REP_DSA 1
#endif
#ifndef REP_P0
#define REP_P0 1
#endif
#ifndef REP_P1
#define REP_P1 1
#endif
#ifndef REP_P3
#define REP_P3 1
#endif
#ifndef REP_P5A
#define REP_P5A 1
#endif
#ifndef REP_P5B
#define REP_P5B 1
#endif
#ifndef REP_BAR
#define REP_BAR 1
#endif
#ifndef REP_P6
#define REP_P6 1
#endif
#ifndef REP_FIN
#define REP_FIN 1
#endif
__device__ __forceinline__ float dbg_value(const unsigned char* ws, int m, int c) {
    auto B = [&](size_t off, size_t idx) { return bf2f(((const bf16_t*)(ws + off))[idx]); };
    const size_t r512 = (size_t)m * 512;
    if (DBG == 1) return B(WS_H, (size_t)m * 1024 + c);
    if (DBG == 2) {
        if (c < 512) return B(WS_QF, r512 + c) + B(WS_KF, r512 + c) + B(WS_GF, r512 + c) + B(WS_QD, r512 + c) + B(WS_IQ, r512 + c) + B(WS_GD, r512 + c) + B(WS_QS, r512 + c) + B(WS_KS, r512 + c) + B(WS_GS, r512 + c);
        if (c < 640) return B(WS_DCKV, (size_t)m * 128 + (c - 512));
        if (c < 768) return ((const float*)(ws + WS_MISCF))[(size_t)m * 128 + (c - 640)];
        { const int cc = c - 768; float v = 0.f; for (int q = 0; q < 4; ++q) v += B(WS_VT, (size_t)(4 * cc + q) * NTOK + m); return v; }
    }
    if (DBG == 3) {
        if (c < 64) return B(WS_DK, (size_t)m * 64 + c);
        if (c < 128) return B(WS_DV, (size_t)m * 64 + c - 64);
        if (c < 192) return B(WS_IK, (size_t)m * 64 + c - 128);
        if (c < 200) return ((const float*)(ws + WS_F2))[(size_t)((m >> 12) * 8 + (c - 192)) * SEQ + (m & 4095)];
        return 0.f;
    }
    if (DBG == 4 || DBG == 41 || DBG == 42 || DBG == 43) { if (c < 512) return B(WS_QF, r512 + c); return B(WS_QD, r512 + c - 512) + B(WS_QS, r512 + c - 512); }
    if (DBG == 5) return B(WS_M3, (size_t)m * 3072 + c) + B(WS_M3, (size_t)m * 3072 + 1024 + c) + B(WS_M3, (size_t)m * 3072 + 2048 + c);
    if (DBG == 6) return B(WS_MIX, (size_t)m * 1024 + c);
    return 0.f;
}
#define DBG_DUMP(k) if (DBG != 0 && (DBG == (k) || DBG / 10 == (k)) && l == 0) { KArgP ap2_ = (KArgP)__builtin_amdgcn_kernarg_segment_ptr(); float* o_ = ap2_->out; const unsigned char* w_ = ap2_->ws; \
        for (size_t e = (size_t)bx0 * NTHR + wid0 * 64 + lane_id_fresh(); e < (size_t)NTOK * 1024; e += (size_t)G0 * NTHR) o_[e] = dbg_value(w_, (int)(e >> 10), (int)(e & 1023)); return; }
#ifndef ONLY
#define ONLY -1
#endif
#define PH(k) (ONLY < 0 || ONLY == (k))
struct Args { const float* x; const float* c; const int* pos; const float* w_ada; const float* b_ada; const float* g_norm; const float* w_in; const float* b_fgt;
              const float* g_kv; const float* w_kv_up; const float* w_br[3]; const float* w_out; const float* g_final; float* out; unsigned char* ws; };

typedef const __attribute__((address_space(4))) Args* KArgP;
__global__ void __launch_bounds__(NTHR, 2) fwd_megakernel(Args A_kernarg) {
    extern __shared__ __attribute__((aligned(16))) unsigned char lds_raw[];
    LAS unsigned char* lds = (LAS unsigned char*)lds_raw;
    cg::grid_group grid = cg::this_grid();
    const int G0 = gridDim.x, bx0 = blockIdx.x;
    const int wid0 = __builtin_amdgcn_readfirstlane((int)threadIdx.x >> 6);
    const unsigned xcc_id = xb_xcc_id();
    unsigned* const barp = (unsigned*)(((KArgP)__builtin_amdgcn_kernarg_segment_ptr())->ws + 4096);
    if (threadIdx.x == 0) { ((volatile LAS unsigned*)(lds + 147000))[0] = 0u; ((volatile LAS unsigned*)(lds + 147000))[1] = 0u;
        (void)xb_add(barp + XB_XCNT(xcc_id), 1u); }
    __syncthreads();
#define LOAD_ARGS KArgP ap_ = (KArgP)__builtin_amdgcn_kernarg_segment_ptr(); int G = G0, bx = bx0; asm volatile("" : "+s"(ap_), "+s"(G), "+s"(bx)); const int NGW = G * NWAVES; (void)NGW; unsigned char* ws = A.ws; float* MOD = (float*)(ws + WS_MOD); (void)MOD;
#define A (*ap_)
#define PHASE_VARS LOAD_ARGS int lane = lane_id_fresh(); asm volatile("" : "+v"(lane)); const int wid = wid0; const int tid = wid * 64 + lane; (void)tid; const int gw = bx * NWAVES + wid; LAS float* scr = (LAS float*)(lds + wid * 16384); (void)scr; (void)gw; (void)lane;

    if constexpr (PH(0)) for (int rep_ = 0; rep_ < REP_P0; ++rep_) {
        PHASE_VARS
        LAS float* red = (LAS float*)lds;
        LAS float* sl = (LAS float*)(lds + 32768);
        if (bx < 96) {
#pragma unroll
            for (int i = 0; i < 16; ++i) { const float cv = A.c[tid + i * NTHR]; sl[tid + i * NTHR] = cv / (1.0f + __expf(-cv)); } }
        __syncthreads();
        for (int it = bx; it < 96; it += G) {
            const int l = it / 48, cgp = it % 48, cc = tid & 63, kp = tid >> 6; const int col = cgp * 64 + cc;
            float acc[8];
#pragma unroll
            for (int b = 0; b < 8; ++b) acc[b] = 0.f;
            const float* wp = A.w_ada + ((size_t)l * 1024 + kp * 128) * 3072 + col;
#pragma unroll 32
            for (int k = 0; k < 128; ++k) { const float w = wp[(size_t)k * 3072];
#pragma unroll
                for (int b = 0; b < 8; ++b) acc[b] += sl[b * 1024 + kp * 128 + k] * w; }
#pragma unroll
            for (int b = 0; b < 8; ++b) red[(kp * 8 + b) * 64 + cc] = acc[b];
            __syncthreads();
            { const int b = tid >> 6; float s = 0.f;
#pragma unroll
              for (int k2 = 0; k2 < 8; ++k2) s += red[(k2 * 8 + b) * 64 + cc];
              MOD[((size_t)l * 8 + b) * 3072 + col] = s + A.b_ada[l * 3072 + col]; }
            __syncthreads();
        }
        f32x2* CS = (f32x2*)(ws + WS_CS);
        for (int e = bx * NTHR + tid; e < NTOK * 32; e += G * NTHR) { const int tok = e >> 5, i = e & 31;
            const double rev = (double)A.pos[tok] * INVF[i] * 0.15915494309189535; const double fr = rev - floor(rev); const float f = (float)fr;
            CS[e] = (f32x2){__builtin_amdgcn_cosf(f), __builtin_amdgcn_sinf(f)}; }
        __syncthreads();
        for (int it = gw; it < 2 * (3 * 256 + 512); it += NGW) { const int l = it / 1280; int r = it % 1280;
            if (r < 768) { const int br = r / 256; transpose_item<false>(A.w_br[br] + (size_t)l * 512 * 1024, 512, 1024, 1024, (bf16_t*)(ws + WS_WTBR) + ((size_t)l * 3 + br) * 1024 * 512, scr, r % 256, lane); }
            else { r -= 768; transpose_item<false>(A.w_out + (size_t)l * 1024 * 1024, 1024, 1024, 1024, (bf16_t*)(ws + WS_WTOUT) + (size_t)l * 1024 * 1024, scr, r, lane); } }
    }
    if (G0 == 0x7fffff01) grid.sync();
    { const int ln_ = lane_id_fresh(); unsigned* bp_ = barp; unsigned xc_ = xcc_id; asm volatile("" : "+s"(bp_), "+s"(xc_)); xcd_barrier(bp_, xc_, (unsigned)G0, (volatile LAS unsigned*)(lds + 147000), wid0 == 0 && ln_ == 0); }

    for (int l = 0; l < DEPTH; ++l) {
        if constexpr (PH(1)) for (int rep_ = 0; rep_ < REP_P1; ++rep_) {
            PHASE_VARS
            const float* xsrc = (l == 0) ? A.x : A.out;
            for (int it = gw; it < 16 * (NPAD / 32); it += NGW) transpose_item<true>(A.w_in + (size_t)l * 1024 * NIN, 1024, NIN, NPAD, (bf16_t*)(ws + WS_WTIN), scr, it, lane);
            bf16_t* H = (bf16_t*)(ws + WS_H); const float* gn = A.g_norm + l * 1024;
            for (int m0 = gw * 4; m0 < NTOK; m0 += NGW * 4) {
                f32x4 v[4][4]; float ss[4];
#pragma unroll
                for (int r = 0; r < 4; ++r) { const f32x4* xr = (const f32x4*)(xsrc + (size_t)(m0 + r) * 1024) + lane; ss[r] = 0.f;
#pragma unroll
                    for (int j = 0; j < 4; ++j) v[r][j] = xr[64 * j]; }
#pragma unroll
                for (int r = 0; r < 4; ++r)
#pragma unroll
                    for (int j = 0; j < 4; ++j) ss[r] += (v[r][j][0] * v[r][j][0] + v[r][j][1] * v[r][j][1]) + (v[r][j][2] * v[r][j][2] + v[r][j][3] * v[r][j][3]);
#pragma unroll
                for (int o = 1; o < 64; o <<= 1) {
#pragma unroll
                    for (int r = 0; r < 4; ++r) ss[r] += shx(ss[r], o, lane); }
                const float* mp = MOD + ((size_t)l * 8 + (m0 >> 12)) * 3072;
#pragma unroll
                for (int j = 0; j < 4; ++j) { const int col = 4 * lane + 256 * j;
                    const f32x4 gg = *(const f32x4*)(gn + col), sh = *(const f32x4*)(mp + col), scl = *(const f32x4*)(mp + 1024 + col);
                    const f32x4 gs = gg * (scl + 1.0f);
#pragma unroll
                    for (int r = 0; r < 4; ++r) { const float rstd = 1.0f / sqrtf(ss[r] * (1.0f / 1024.f) + EPS);
                        const f32x4 hv = v[r][j] * rstd * gs + sh;
                        u32x2 w; w.x = cvt_pk(hv[0], hv[1]); w.y = cvt_pk(hv[2], hv[3]);
                        *(u32x2*)(H + (size_t)(m0 + r) * 1024 + col) = w; } }
            }
        }
        { const int ln_ = lane_id_fresh(); unsigned* bp_ = barp; unsigned xc_ = xcc_id; asm volatile("" : "+s"(bp_), "+s"(xc_)); xcd_barrier(bp_, xc_, (unsigned)G0, (volatile LAS unsigned*)(lds + 147000), wid0 == 0 && ln_ == 0); }
        DBG_DUMP(1)
        if constexpr (PH(2)) {
            LOAD_ARGS
            for (int rep_ = 0; rep_ < REP_P2; ++rep_) {
            pg8::SchedStd S; S.init(ws + WS_H, ws + WS_WTIN, NTOK, 19 * 256, 1024, G, bx);
            EpiIn E{ws};
            pg8::gemm_phase<EpiIn, pg8::SchedStd>(lds, 1024, S, E, wid0);
            pg8::SchedStd S2; S2.init(ws + WS_WTIN + (size_t)31 * 256 * 1024 * 2, ws + WS_H, 1024, NTOK, 1024, G, bx);
            EpiPlain E2{(bf16_t*)(ws + WS_VT), (size_t)NTOK};
            pg8::gemm_phase<EpiPlain, pg8::SchedStd>(lds, 1024, S2, E2, wid0);
            }
        }
        { const int ln_ = lane_id_fresh(); unsigned* bp_ = barp; unsigned xc_ = xcc_id; asm volatile("" : "+s"(bp_), "+s"(xc_)); xcd_barrier(bp_, xc_, (unsigned)G0, (volatile LAS unsigned*)(lds + 147000), wid0 == 0 && ln_ == 0); }
        DBG_DUMP(2)
        if constexpr (PH(3)) for (int rep_ = 0; rep_ < REP_P3; ++rep_) {
            PHASE_VARS
            const float* MF = (const float*)(ws + WS_MISCF);
            if (bx < 64) {
                const int b = bx >> 3, h = bx & 7; const float bf = A.b_fgt[l * 8 + h];
                const float* mfp = MF + ((size_t)b * SEQ + tid * 8) * 128 + 64 + h;
                float v[8]; float run = 0.f;
#pragma unroll
                for (int i = 0; i < 8; ++i) { const float xx = mfp[(size_t)i * 128] + bf; run += -lg2(1.0f + ex2(-xx * LOG2E)); v[i] = run; }
                float incl = run;
#pragma unroll
                for (int o = 1; o < 64; o <<= 1) { const float nb = __int_as_float(__builtin_amdgcn_ds_bpermute(((lane >= o) ? (lane - o) : lane) << 2, __float_as_int(incl))); if (lane >= o) incl += nb; }
                LAS float* wt = (LAS float*)(lds + 70000);
                if (lane == 63) wt[wid] = incl;
                __syncthreads();
                float off = 0.f;
#pragma unroll
                for (int w2 = 0; w2 < 8; ++w2) { const float tv = wt[w2]; if (w2 < wid) off += tv; }
                const float excl = incl - run + off;
                float* Fo = (float*)(ws + WS_F2) + (size_t)bx * SEQ + tid * 8;
                *(f32x4*)Fo = (f32x4){v[0] + excl, v[1] + excl, v[2] + excl, v[3] + excl}; *(f32x4*)(Fo + 4) = (f32x4){v[4] + excl, v[5] + excl, v[6] + excl, v[7] + excl};
            }
            for (int blk = gw; blk < 8 * 8 * 64; blk += NGW) {
                const bf16_t* kb = (const bf16_t*)(ws + WS_KF) + (size_t)blk * 4096; float mxk = 0.f;
#pragma unroll
                for (int hf = 0; hf < 2; ++hf) { float ss = 0.f;
#pragma unroll
                    for (int d0 = 0; d0 < 4; ++d0) { const bf16x8 v = *(const bf16x8*)(kb + ((hf * 4 + d0) * 64 + lane) * 8);
#pragma unroll
                        for (int e = 0; e < 8; ++e) { const float f = bf2f((bf16_t)v[e]); ss += f * f; } }
                    ss += shx(ss, 32, lane); mxk = fmaxf(mxk, ss); }
#pragma unroll
                for (int o = 1; o < 32; o <<= 1) mxk = fmaxf(mxk, shx(mxk, o, lane));
                if (lane == 0) __hip_atomic_fetch_max((unsigned*)ws + 128 + l * 64 + (blk >> 6), __float_as_uint(mxk), __ATOMIC_RELAXED, __HIP_MEMORY_SCOPE_AGENT);
            }
            LAS float* Wl = (LAS float*)lds;
            { const f32x4* wsrc = (const f32x4*)(A.w_kv_up + (size_t)l * 128 * 128);
#pragma unroll
              for (int i = 0; i < 8; ++i) ((LAS f32x4*)Wl)[tid + i * NTHR] = wsrc[tid + i * NTHR]; }
            __syncthreads();
            const bf16_t* DC = (const bf16_t*)(ws + WS_DCKV); const f32x2* CS = (const f32x2*)(ws + WS_CS);
            bf16_t* DK = (bf16_t*)(ws + WS_DK); bf16_t* DV = (bf16_t*)(ws + WS_DV); bf16_t* IKo = (bf16_t*)(ws + WS_IK);
            const float gk0 = A.g_kv[l * 128 + lane], gk1 = A.g_kv[l * 128 + 64 + lane];
            for (int t4 = gw; t4 < NTOK / 4; t4 += NGW) {
                float n0[4], n1[4], a0[4], a1[4];
#pragma unroll
                for (int q = 0; q < 4; ++q) { const size_t tok = (size_t)t4 * 4 + q; const float x0 = bf2f(DC[tok * 128 + lane]), x1 = bf2f(DC[tok * 128 + 64 + lane]);
                    const float rstd = 1.0f / sqrtf(wave_sum(x0 * x0 + x1 * x1, lane) * (1.0f / 128.f) + EPS);
                    n0[q] = x0 * rstd * gk0; n1[q] = x1 * rstd * gk1; a0[q] = 0.f; a1[q] = 0.f; }
#pragma unroll 4
                for (int k = 0; k < 64; ++k) { const float w0 = Wl[k * 128 + lane], w1 = Wl[k * 128 + 64 + lane];
#pragma unroll
                    for (int q = 0; q < 4; ++q) { const float nk = __builtin_bit_cast(float, __builtin_amdgcn_readlane(__builtin_bit_cast(int, n0[q]), k)); a0[q] += nk * w0; a1[q] += nk * w1; } }
#pragma unroll 4
                for (int k = 0; k < 64; ++k) { const float w0 = Wl[(64 + k) * 128 + lane], w1 = Wl[(64 + k) * 128 + 64 + lane];
#pragma unroll
                    for (int q = 0; q < 4; ++q) { const float nk = __builtin_bit_cast(float, __builtin_amdgcn_readlane(__builtin_bit_cast(int, n1[q]), k)); a0[q] += nk * w0; a1[q] += nk * w1; } }
#pragma unroll
                for (int q = 0; q < 4; ++q) { const size_t tok = (size_t)t4 * 4 + q; const f32x2 cs = CS[tok * 32 + (lane & 31)];
                    const float pk = shx(a0[q], 32, lane);
                    const float kr = (lane < 32) ? (a0[q] * cs[0] - pk * cs[1]) : (a0[q] * cs[0] + pk * cs[1]);
                    DK[tok * 64 + lane] = (bf16_t)(cvt_pk(kr, 0.f) & 0xffffu); DV[tok * 64 + lane] = (bf16_t)(cvt_pk(a1[q], 0.f) & 0xffffu);
                    const float xi = MF[tok * 128 + lane]; const float pi = shx(xi, 32, lane);
                    const float ir = (lane < 32) ? (xi * cs[0] - pi * cs[1]) : (xi * cs[0] + pi * cs[1]);
                    IKo[(((tok >> 5) * 4 + (lane >> 4)) * 64 + ((lane >> 3) & 1) * 32 + (tok & 31)) * 8 + (lane & 7)] = (bf16_t)(cvt_pk(ir, 0.f) & 0xffffu); }
            }
            __syncthreads();
        }
        { const int ln_ = lane_id_fresh(); unsigned* bp_ = barp; unsigned xc_ = xcc_id; asm volatile("" : "+s"(bp_), "+s"(xc_)); xcd_barrier(bp_, xc_, (unsigned)G0, (volatile LAS unsigned*)(lds + 147000), wid0 == 0 && ln_ == 0); }
        DBG_DUMP(3)
        if constexpr (PH(4) || PH(8) || PH(9)) {
            PHASE_VARS
            const int b = bx & 7, w = bx >> 3, GW = (G + 7) >> 3;
            if constexpr (PH(4) && (DBG != 42 && DBG != 43)) for (int rep_ = 0; rep_ < REP_FOX; ++rep_) for (int u = w; u < 128; u += GW) { const int qb = u >> 3, h = (u + 2 * (u / GW)) & 7; const bool st_ = (rep_ == REP_FOX - 1) || (G0 == 0x7fffff01);
                attn_fs_wave<false>((const bf16_t*)(ws + WS_QF), (const bf16_t*)(ws + WS_KF), (const bf16_t*)(ws + WS_VT), (const float*)(ws + WS_F2), (const bf16_t*)(ws + WS_GF), (bf16_t*)(ws + WS_QF), b, h, qb * 256 + wid * 32, lane, st_, (const unsigned*)ws + 128 + l * 64); }
            if constexpr (PH(8) && (DBG != 41 && DBG != 43)) for (int rep_ = 0; rep_ < REP_SB; ++rep_) for (int u = w; u < 128; u += GW) { const int qb = u >> 3, h = (u + 2 * (u / GW)) & 7; const bool st_ = (rep_ == REP_SB - 1) || (G0 == 0x7fffff01);
                attn_fs_wave<true>((const bf16_t*)(ws + WS_QS), (const bf16_t*)(ws + WS_KS), (const bf16_t*)(ws + WS_VT) + (size_t)512 * NTOK, nullptr, (const bf16_t*)(ws + WS_GS), (bf16_t*)(ws + WS_QS), b, h, qb * 256 + wid * 32, lane, st_, nullptr); }
            __syncthreads();
            if constexpr (PH(9) && (DBG != 41 && DBG != 42)) {
                unsigned* qcnt = (unsigned*)ws + 256 + l * 8 + b; LAS int* ubox = (LAS int*)(lds + 147008);
                for (;;) {
                    if (tid == 0) *ubox = (int)__hip_atomic_fetch_add(qcnt, 1u, __ATOMIC_RELAXED, __HIP_MEMORY_SCOPE_AGENT);
                    __syncthreads();
                    const int k = *ubox;
                    if (k >= 512) break;
                    dsa_unit(lds, ws, b, (511 - k) * 8, wid, lane, true);
                }
            }
        }
        { const int ln_ = lane_id_fresh(); unsigned* bp_ = barp; unsigned xc_ = xcc_id; asm volatile("" : "+s"(bp_), "+s"(xc_)); xcd_barrier(bp_, xc_, (unsigned)G0, (volatile LAS unsigned*)(lds + 147000), wid0 == 0 && ln_ == 0); }
        DBG_DUMP(4)
        if constexpr (PH(5)) for (int rep_ = 0; rep_ < REP_P5A; ++rep_) {
            LOAD_ARGS
            pg8::SchedStd S; S.init(ws + WS_H, ws + WS_WTIN + (size_t)19 * 256 * 1024 * 2, NTOK, 3072, 1024, G, bx);
            EpiMerge E{(bf16_t*)(ws + WS_M3)};
            pg8::gemm_phase<EpiMerge, pg8::SchedStd>(lds, 1024, S, E, wid0);
        }
        { const int ln_ = lane_id_fresh(); unsigned* bp_ = barp; unsigned xc_ = xcc_id; asm volatile("" : "+s"(bp_), "+s"(xc_)); xcd_barrier(bp_, xc_, (unsigned)G0, (volatile LAS unsigned*)(lds + 147000), wid0 == 0 && ln_ == 0); }
        DBG_DUMP(5)
        if constexpr (PH(6)) for (int rep_ = 0; rep_ < REP_P5B; ++rep_) {
            LOAD_ARGS
            pg8::SchedMix S{(const char*)(ws + WS_QF), (const char*)(ws + WS_WTBR) + (size_t)l * 3 * 1024 * 512 * 2, G, bx};
            EpiMix E{(const bf16_t*)(ws + WS_M3), (bf16_t*)(ws + WS_MIX)};
            pg8::gemm_phase<EpiMix, pg8::SchedMix>(lds, 512, S, E, wid0);
        }
        { const int ln_ = lane_id_fresh(); unsigned* bp_ = barp; unsigned xc_ = xcc_id; asm volatile("" : "+s"(bp_), "+s"(xc_)); xcd_barrier(bp_, xc_, (unsigned)G0, (volatile LAS unsigned*)(lds + 147000), wid0 == 0 && ln_ == 0); }
        DBG_DUMP(6)
        if constexpr (PH(7)) for (int rep_ = 0; rep_ < (l == 0 ? REP_P6 : 1); ++rep_) {
            LOAD_ARGS
            const float* xsrc = (l == 0) ? A.x : A.out;
            pg8::SchedStd S; S.init(ws + WS_MIX, ws + WS_WTOUT + (size_t)l * 1024 * 1024 * 2, NTOK, 1024, 1024, G, bx);
            EpiOut E{xsrc, A.out, MOD + (size_t)l * 8 * 3072 + 2048};
            pg8::gemm_phase<EpiOut, pg8::SchedStd>(lds, 1024, S, E, wid0);
        }
        { const int ln_ = lane_id_fresh(); unsigned* bp_ = barp; unsigned xc_ = xcc_id; asm volatile("" : "+s"(bp_), "+s"(xc_)); xcd_barrier(bp_, xc_, (unsigned)G0, (volatile LAS unsigned*)(lds + 147000), wid0 == 0 && ln_ == 0); }
        DBG_DUMP(7)
        for (int rb_ = 1; rb_ < REP_BAR; ++rb_) { const int ln_ = lane_id_fresh(); unsigned* bp_ = barp; unsigned xc_ = xcc_id; asm volatile("" : "+s"(bp_), "+s"(xc_)); xcd_barrier(bp_, xc_, (unsigned)G0, (volatile LAS unsigned*)(lds + 147000), wid0 == 0 && ln_ == 0); }
    }
    PHASE_VARS
    for (int rep_ = 0; rep_ < REP_FIN; ++rep_)
    for (int m0 = gw * 4; m0 < NTOK; m0 += NGW * 4) {
        f32x4 v[4][4]; float ss[4];
#pragma unroll
        for (int r = 0; r < 4; ++r) { const f32x4* xr = (const f32x4*)(A.out + (size_t)(m0 + r) * 1024) + lane; ss[r] = 0.f;
#pragma unroll
            for (int j = 0; j < 4; ++j) v[r][j] = xr[64 * j]; }
        f32x4 gg[4];
#pragma unroll
        for (int j = 0; j < 4; ++j) gg[j] = *(const f32x4*)(A.g_final + 4 * lane + 256 * j);
#pragma unroll
        for (int r = 0; r < 4; ++r)
#pragma unroll
            for (int j = 0; j < 4; ++j) ss[r] += (v[r][j][0] * v[r][j][0] + v[r][j][1] * v[r][j][1]) + (v[r][j][2] * v[r][j][2] + v[r][j][3] * v[r][j][3]);
#pragma unroll
        for (int o = 1; o < 64; o <<= 1) {
#pragma unroll
            for (int r = 0; r < 4; ++r) ss[r] += shx(ss[r], o, lane); }
#pragma unroll
        for (int r = 0; r < 4; ++r) { const float rstd = 1.0f / sqrtf(ss[r] * (1.0f / 1024.f) + EPS); f32x4* xo = (f32x4*)(A.out + (size_t)(m0 + r) * 1024) + lane;
#pragma unroll
            for (int j = 0; j < 4; ++j) { if (rep_ == REP_FIN - 1 || G0 == 0x7fffff01) xo[64 * j] = v[r][j] * rstd * gg[j]; } }
    }
}

#undef A
extern "C" void kernel_launch(void* const* d_in, const int* in_sizes, int n_in, void* d_out, int out_size, void* d_ws, size_t ws_size, hipStream_t stream) {
    static int grid = 0;
    if (grid == 0) {
        if (n_in != 15 || ws_size < WS_END) { fprintf(stderr, "kernel_launch: unexpected n_in %d / ws %zu\n", n_in, ws_size); grid = -1; return; }
        int dev = 0, cus = 0, per_cu = 0;
        hipGetDevice(&dev);
        hipDeviceGetAttribute(&cus, hipDeviceAttributeMultiprocessorCount, dev);
        hipFuncSetAttribute((const void*)fwd_megakernel, hipFuncAttributeMaxDynamicSharedMemorySize, LDS_BYTES);
        hipOccupancyMaxActiveBlocksPerMultiprocessor(&per_cu, (const void*)fwd_megakernel, NTHR, LDS_BYTES);
        if (per_cu < 1) per_cu = 1;
        grid = cus * per_cu;
    }
    if (grid < 0) return;
    Args a{};
    a.x = (const float*)d_in[0]; a.c = (const float*)d_in[1]; a.pos = (const int*)d_in[2]; a.w_ada = (const float*)d_in[3]; a.b_ada = (const float*)d_in[4];
    a.g_norm = (const float*)d_in[5]; a.w_in = (const float*)d_in[6]; a.b_fgt = (const float*)d_in[7]; a.g_kv = (const float*)d_in[8]; a.w_kv_up = (const float*)d_in[9];
    a.w_br[0] = (const float*)d_in[10]; a.w_br[1] = (const float*)d_in[11]; a.w_br[2] = (const float*)d_in[12]; a.w_out = (const float*)d_in[13]; a.g_final = (const float*)d_in[14];
    a.out = (float*)d_out; a.ws = (unsigned char*)d_ws;
    hipMemsetAsync(d_ws, 0, 32768, stream);
    void* args[] = {&a};
    hipError_t e = hipLaunchCooperativeKernel((const void*)fwd_megakernel, dim3(grid), dim3(NTHR), args, LDS_BYTES, stream);
    if (e != hipSuccess) fprintf(stderr, "cooperative launch failed: %s (grid %d)\n", hipGetErrorString(e), grid);
}
```

```cpp
#include <hip/hip_runtime.h>
#include <hip/hip_cooperative_groups.h>
#include <cstdio>
#include <cstdint>
namespace cg = cooperative_groups;
#ifndef REP_DA
#define REP_DA 1
#endif
#ifndef REP_DB
#define REP_DB 1
#endif
#ifndef REP_DC
#define REP_DC 1
#endif

#define LAS __attribute__((address_space(3)))
typedef unsigned short bf16_t;
typedef short bf16x8 __attribute__((ext_vector_type(8)));
typedef short bf16x4 __attribute__((ext_vector_type(4)));
typedef float f32x4 __attribute__((ext_vector_type(4)));
typedef float f32x2 __attribute__((ext_vector_type(2)));
typedef float f32x16 __attribute__((ext_vector_type(16)));
typedef unsigned u32x4 __attribute__((ext_vector_type(4)));
typedef unsigned u32x2 __attribute__((ext_vector_type(2)));

constexpr int DM = 1024, NB = 8, SEQ = 4096, NTOK = NB * SEQ, DEPTH = 2;
constexpr int NIN = 8912, NPAD = 8960;
constexpr float LOG2E = 1.4426950408889634f;
constexpr float C2 = 0.125f * LOG2E;
constexpr float EPS = 1e-6f;
constexpr int NWAVES = 8, NTHR = 512;
constexpr int LDS_BYTES = 147456;

constexpr size_t MiB = 1u << 20;
constexpr size_t WS_MOD = 1 * MiB;
constexpr size_t WS_F2 = 2 * MiB;
constexpr size_t WS_CS = 8 * MiB;
constexpr size_t WS_WTBR = 16 * MiB;
constexpr size_t WS_WTOUT = 22 * MiB;
constexpr size_t WS_WTIN = 28 * MiB;
constexpr size_t WS_H = 46 * MiB;
constexpr size_t WS_QF = 110 * MiB;
constexpr size_t WS_QD = 142 * MiB;
constexpr size_t WS_QS = 174 * MiB;
constexpr size_t WS_GF = 206 * MiB;
constexpr size_t WS_GD = 238 * MiB;
constexpr size_t WS_GS = 270 * MiB;
constexpr size_t WS_MIX = 206 * MiB;
constexpr size_t WS_KF = 302 * MiB;
constexpr size_t WS_KS = 334 * MiB;
constexpr size_t WS_VT = 366 * MiB;
constexpr size_t WS_IQ = 430 * MiB;
constexpr size_t WS_DCKV = 462 * MiB;
constexpr size_t WS_MISCF = 470 * MiB;
constexpr size_t WS_DK = 486 * MiB;
constexpr size_t WS_DV = 490 * MiB;
constexpr size_t WS_M3 = 302 * MiB;
constexpr size_t WS_IK = 494 * MiB;
constexpr size_t WS_END = 498 * MiB;

__device__ const double INVF[32] = {1.0, 0.7498942093324559, 0.5623413251903491, 0.4216965034285822, 0.31622776601683794, 0.23713737056616552, 0.1778279410038923, 0.1333521432163324, 0.1, 0.07498942093324558, 0.05623413251903491, 0.042169650342858224, 0.03162277660168379, 0.023713737056616554, 0.01778279410038923, 0.01333521432163324, 0.01, 0.007498942093324558, 0.005623413251903491, 0.004216965034285823, 0.0031622776601683794, 0.0023713737056616554, 0.0017782794100389228, 0.001333521432163324, 0.001, 0.0007498942093324559, 0.0005623413251903491, 0.00042169650342858224, 0.00031622776601683794, 0.00023713737056616554, 0.00017782794100389227, 0.0001333521432163324};

typedef __bf16 bf16x2_t __attribute__((ext_vector_type(2)));
__device__ __forceinline__ unsigned cvt_pk(float lo, float hi) { f32x2 v = {lo, hi}; bf16x2_t b = __builtin_convertvector(v, bf16x2_t); return __builtin_bit_cast(unsigned, b); }
__device__ __forceinline__ float bf2f(bf16_t v) { return __uint_as_float((unsigned)v << 16); }
__device__ __forceinline__ float bflo(unsigned w) { return __uint_as_float(w << 16); }
__device__ __forceinline__ float bfhi(unsigned w) { return __uint_as_float(w & 0xffff0000u); }
__device__ __forceinline__ float ex2(float x) { return __builtin_amdgcn_exp2f(x); }
__device__ __forceinline__ float lg2(float x) { return __builtin_amdgcn_logf(x); }
__device__ __forceinline__ float sigmoidf_(float x) { return __builtin_amdgcn_rcpf(1.0f + ex2(-x * LOG2E)); }
__device__ __forceinline__ int lane_id_fresh() { unsigned ones = ~0u; asm volatile("" : "+s"(ones)); return __builtin_amdgcn_mbcnt_hi(ones, __builtin_amdgcn_mbcnt_lo(ones, 0u)); }
__device__ __forceinline__ float shx(float v, int o, int lane) { return __int_as_float(__builtin_amdgcn_ds_bpermute((lane ^ o) << 2, __float_as_int(v))); }
__device__ __forceinline__ float shx32(float v, int lane) {
    const auto rr = __builtin_amdgcn_permlane32_swap(__float_as_uint(v), __float_as_uint(v), false, false);
    return __uint_as_float((lane & 32) ? rr[0] : rr[1]);
}
__device__ __forceinline__ float wave_sum(float v, int lane) {
#pragma unroll
    for (int o = 1; o < 64; o <<= 1) v += shx(v, o, lane);
    return v;
}
__device__ __forceinline__ int crow(int r, int hi) { return (r & 3) + 8 * (r >> 2) + 4 * hi; }
__device__ __forceinline__ f32x16 mfma32(bf16x8 a, bf16x8 b, f32x16 c) { return __builtin_amdgcn_mfma_f32_32x32x16_bf16(a, b, c, 0, 0, 0); }
__device__ __forceinline__ f32x4 mfma16(bf16x8 a, bf16x8 b, f32x4 c) { return __builtin_amdgcn_mfma_f32_16x16x32_bf16(a, b, c, 0, 0, 0); }
__device__ __forceinline__ bf16x8 pack8(float a0, float a1, float a2, float a3, float a4, float a5, float a6, float a7) {
    u32x4 w; w.x = cvt_pk(a0, a1); w.y = cvt_pk(a2, a3); w.z = cvt_pk(a4, a5); w.w = cvt_pk(a6, a7); return __builtin_bit_cast(bf16x8, w);
}
__device__ __forceinline__ int mbcnt64(unsigned long long m) { return __builtin_amdgcn_mbcnt_hi((unsigned)(m >> 32), __builtin_amdgcn_mbcnt_lo((unsigned)m, 0u)); }

namespace pg8 {
constexpr int BM = 256, BK = 64, HALF = 128, HTB = HALF * BK * 2, STAGE_BYTES = 8 * HTB, NXCD = 8, WGM = 8;
__device__ __forceinline__ int lds_byte(int r, int c) { const int st = (r >> 4) * 2 + (c >> 5), rr = r & 15, cc = c & 31, ob = rr * 64 + cc * 2; return st * 1024 + (ob ^ (((ob >> 9) & 1) << 5)); }
__device__ __forceinline__ void stage_rc(int b, int& R, int& C) { const int st = b / 1024, sb = b % 1024, swz = sb ^ (((sb >> 9) & 1) << 5); R = (st >> 1) * 16 + swz / 64; C = (st & 1) * 32 + (swz % 64) / 2; }
__device__ __forceinline__ int perm32(int rho) { const int n = rho >> 4, i = rho & 15; return 8 * (i >> 2) + 4 * n + (i & 3); }
struct Unit { int pm, pn, aux; };

struct StaticOrder {
    int nM, nN, nwg, G, c;
    __device__ void init(int M, int N, int G_, int c_) { nM = M / BM; nN = N / BM; nwg = nM * nN; G = G_; c = c_; }
    __device__ bool next(int i, Unit& u) const {
        const long L = (long)i * G + c; if (L >= nwg) return false;
        int wgid = (int)L; { const int q = nwg / NXCD, r = nwg % NXCD, xcd = wgid % NXCD, off = wgid / NXCD; wgid = (xcd < r ? xcd * (q + 1) : r * (q + 1) + (xcd - r) * q) + off; }
        const int nig = WGM * nN, gid = wgid / nig, fm = gid * WGM, gsz = (nM - fm) < WGM ? (nM - fm) : WGM;
        u.pm = fm + ((wgid % nig) % gsz); u.pn = (wgid % nig) / gsz; u.aux = 0; return true;
    }
};
struct SchedStd {
    const char* A; const char* B; size_t tstep; StaticOrder so;
    __device__ void init(const void* A_, const void* B_, int M, int N, int K, int G, int c) { A = (const char*)A_; B = (const char*)B_; tstep = (size_t)BM * K * 2; so.init(M, N, G, c); }
    __device__ __forceinline__ bool next(int i, Unit& u) const { return so.next(i, u); }
    __device__ __forceinline__ const char* a_base(const Unit& u) const { return A + (size_t)u.pm * tstep; }
    __device__ __forceinline__ const char* b_base(const Unit& u) const { return B + (size_t)u.pn * tstep; }
};
struct SchedMix {
    const char* Y; const char* W; int G, c;
    __device__ __forceinline__ bool next(int i, Unit& u) const { const int tl = c + G * (i / 3); if (tl >= 512) return false; u.pm = tl >> 2; u.pn = tl & 3; u.aux = i % 3; return true; }
    __device__ __forceinline__ const char* a_base(const Unit& u) const { return Y + (size_t)u.aux * (32 * MiB) + (size_t)u.pm * (256 * 512 * 2); }
    __device__ __forceinline__ const char* b_base(const Unit& u) const { return W + (size_t)u.aux * (1024 * 512 * 2) + (size_t)u.pn * (256 * 512 * 2); }
};

template <class Epi, class Sched>
__device__ __forceinline__ void gemm_phase(LAS unsigned char* lds, const int K, const Sched& S, const Epi& E, const int wid) {
    int lane = lane_id_fresh(); asm volatile("" : "+v"(lane));
    const int tid = wid * 64 + lane, wr = wid >> 2, wc = wid & 3, fr = lane & 15, fq = lane >> 4;
    const int nt = K / BK;
    unsigned voffA[2], voffB[2];
#pragma unroll
    for (int i = 0; i < 2; ++i) { int R, C; stage_rc(tid * 16 + i * 8192, R, C); const int Rb = (R & ~31) + perm32(R & 31);
        voffA[i] = (unsigned)(R * K + C) * 2u; voffB[i] = (unsigned)(Rb * K + C) * 2u; }
    const size_t kstep = (size_t)(BK * 2);
    const size_t hstep = (size_t)HALF * K * 2;
    const unsigned ldsw = (unsigned)wid * 1024u;
    const int aoff = lds_byte(wr * 64 + fr, fq * 8), boff = lds_byte(wc * 32 + fr, fq * 8);
#define PG8_SA(b, h) (((b) * 2 + (h)) * HTB)
#define PG8_SB(b, h) ((4 + (b) * 2 + (h)) * HTB)
#define PG8_STAGE(bufoff, gbase, voff) do { _Pragma("unroll") for (int _i = 0; _i < 2; ++_i) \
        __builtin_amdgcn_global_load_lds((const unsigned*)((const char*)(gbase) + (voff)[_i]), (LAS unsigned*)(lds + (bufoff) + ldsw + _i * 8192), 16, 0, 0); } while (0)
#define PG8_LDA(dst, b, h) do { _Pragma("unroll") for (int m = 0; m < 4; ++m) _Pragma("unroll") for (int k = 0; k < 2; ++k) dst[m][k] = *(const LAS bf16x8*)(lds + PG8_SA(b, h) + aoff + m * 2048 + k * 1024); } while (0)
#define PG8_LDB(dst, b, h) do { _Pragma("unroll") for (int n = 0; n < 2; ++n) _Pragma("unroll") for (int k = 0; k < 2; ++k) dst[n][k] = *(const LAS bf16x8*)(lds + PG8_SB(b, h) + boff + n * 2048 + k * 1024); } while (0)
#define PG8_MMA(ai, bj, At, Bt) do { __builtin_amdgcn_s_setprio(1); _Pragma("unroll") for (int m = 0; m < 4; ++m) _Pragma("unroll") for (int n = 0; n < 2; ++n) _Pragma("unroll") for (int k = 0; k < 2; ++k) \
        acc[ai][bj][m][n] = __builtin_amdgcn_mfma_f32_16x16x32_bf16(Bt[n][k], At[m][k], acc[ai][bj][m][n], 0, 0, 0); __builtin_amdgcn_s_setprio(0); } while (0)
#define PG8_WAIT_V(n) asm volatile("s_waitcnt vmcnt(" #n ")" ::: "memory")
#define PG8_WAIT_L(n) asm volatile("s_waitcnt lgkmcnt(" #n ")" ::: "memory")
#define PG8_BAR __builtin_amdgcn_s_barrier()
#define PG8_SCHED __builtin_amdgcn_sched_barrier(0)
    Unit cur, nxt; int ui = 0;
    if (!S.next(0, cur)) return;
    f32x4 acc[2][2][4][2];
#pragma unroll
    for (int a = 0; a < 2; ++a)
#pragma unroll
        for (int b = 0; b < 2; ++b)
#pragma unroll
            for (int m = 0; m < 4; ++m)
#pragma unroll
                for (int n = 0; n < 2; ++n) acc[a][b][m][n] = (f32x4){0.f, 0.f, 0.f, 0.f};
    bf16x8 At[4][2], B0[2][2], B1[2][2];
    const char* cA = S.a_base(cur); const char* cB = S.b_base(cur);
    PG8_STAGE(PG8_SB(0, 0), cB, voffB); PG8_STAGE(PG8_SB(0, 1), cB + hstep, voffB); PG8_STAGE(PG8_SA(0, 0), cA, voffA); PG8_STAGE(PG8_SA(0, 1), cA + hstep, voffA);
    if (wr == 1) PG8_BAR;
    PG8_WAIT_V(2); PG8_BAR;
    PG8_STAGE(PG8_SB(1, 0), cB + kstep, voffB); PG8_STAGE(PG8_SA(1, 0), cA + kstep, voffA); PG8_STAGE(PG8_SB(1, 1), cB + hstep + kstep, voffB);
    PG8_WAIT_V(6); PG8_BAR;
    for (;;) {
        const bool has_next = S.next(ui + 1, nxt);
        const char* nA = has_next ? S.a_base(nxt) : cA; const char* nB = has_next ? S.b_base(nxt) : cB;
        for (int t = 0; t < nt; t += 2) {
            const bool last = (t == nt - 2);
            const char* a1 = cA + (size_t)(t + 1) * kstep;
            const char* a2 = last ? nA : cA + (size_t)(t + 2) * kstep; const char* b2 = last ? nB : cB + (size_t)(t + 2) * kstep;
            const char* a3 = a2 + kstep; const char* b3 = b2 + kstep;
            PG8_LDB(B0, 0, 0); PG8_LDB(B1, 0, 1); PG8_SCHED; PG8_LDA(At, 0, 0); PG8_STAGE(PG8_SA(1, 1), a1 + hstep, voffA);
            PG8_WAIT_V(8); PG8_WAIT_L(0); PG8_BAR; PG8_MMA(0, 0, At, B0); PG8_MMA(0, 1, At, B1); PG8_BAR; PG8_SCHED;
            PG8_LDA(At, 0, 1); PG8_STAGE(PG8_SB(0, 0), b2, voffB); PG8_STAGE(PG8_SB(0, 1), b2 + hstep, voffB); PG8_STAGE(PG8_SA(0, 0), a2, voffA);
            PG8_WAIT_V(8); PG8_WAIT_L(0); PG8_BAR; PG8_MMA(1, 0, At, B0); PG8_MMA(1, 1, At, B1); PG8_BAR; PG8_SCHED;
            PG8_LDB(B0, 1, 0); PG8_LDB(B1, 1, 1); PG8_SCHED; PG8_LDA(At, 1, 0); PG8_STAGE(PG8_SA(0, 1), a2 + hstep, voffA);
            PG8_WAIT_V(8); PG8_WAIT_L(0); PG8_BAR; PG8_MMA(0, 0, At, B0); PG8_MMA(0, 1, At, B1); PG8_BAR; PG8_SCHED;
            PG8_LDA(At, 1, 1); PG8_STAGE(PG8_SB(1, 0), b3, voffB); PG8_STAGE(PG8_SB(1, 1), b3 + hstep, voffB); PG8_STAGE(PG8_SA(1, 0), a3, voffA);
            PG8_WAIT_V(8); PG8_WAIT_L(0); PG8_BAR; PG8_MMA(1, 0, At, B0); PG8_MMA(1, 1, At, B1); PG8_BAR; PG8_SCHED;
        }
        if (wr == 0) PG8_BAR;
        E(acc, cur, wr, wc, fr, fq);
        if (!has_next) break;
#pragma unroll
        for (int a = 0; a < 2; ++a)
#pragma unroll
            for (int b = 0; b < 2; ++b)
#pragma unroll
                for (int m = 0; m < 4; ++m)
#pragma unroll
                    for (int n = 0; n < 2; ++n) acc[a][b][m][n] = (f32x4){0.f, 0.f, 0.f, 0.f};
        cur = nxt; cA = nA; cB = nB; ++ui;
        if (wr == 1) PG8_BAR;
    }
    PG8_WAIT_V(0);
    PG8_BAR;
#undef PG8_SA
#undef PG8_SB
#undef PG8_STAGE
#undef PG8_LDA
#undef PG8_LDB
#undef PG8_MMA
#undef PG8_WAIT_V
#undef PG8_WAIT_L
#undef PG8_BAR
#undef PG8_SCHED
}
}
using pg8::Unit;

__device__ __forceinline__ u32x4 pack_f8(const f32x4& v0, const f32x4& v1) { u32x4 w; w.x = cvt_pk(v0[0], v0[1]); w.y = cvt_pk(v0[2], v0[3]); w.z = cvt_pk(v1[0], v1[1]); w.w = cvt_pk(v1[2], v1[3]); return w; }

struct EpiIn {
    unsigned char* ws;
    __device__ __forceinline__ void operator()(const f32x4 (&acc)[2][2][4][2], const Unit& u, int wr, int wc, int fr, int fq) const {
        const int pn = u.pn; const int row0 = u.pm * 256 + wr * 64 + fr;
        if (pn == 18) {
            bf16_t* dc = (bf16_t*)(ws + WS_DCKV); float* mf = (float*)(ws + WS_MISCF);
            const int col = wc * 32 + 8 * fq;
#pragma unroll
            for (int ai = 0; ai < 2; ++ai)
#pragma unroll
                for (int m = 0; m < 4; ++m) { const size_t row = (size_t)(row0 + ai * 128 + m * 16);
                    *(u32x4*)(dc + row * 128 + col) = pack_f8(acc[ai][0][m][0], acc[ai][0][m][1]);
                    *(f32x4*)(mf + row * 128 + col) = acc[ai][1][m][0]; *(f32x4*)(mf + row * 128 + col + 4) = acc[ai][1][m][1]; asm volatile("" ::: "memory"); }
            return;
        }
        const int grp = pn >> 1, half = pn & 1;
        size_t boff; int mode = 0; float sc = 1.f;
        switch (grp) {
            case 0: boff = WS_QF; sc = C2; break;
            case 1: boff = WS_KF; mode = 3; break;
            case 2: boff = WS_GF; mode = 1; break;
            case 3: boff = WS_QD; mode = 2; sc = C2; break;
            case 4: boff = WS_IQ; mode = 2; break;
            case 5: boff = WS_GD; mode = 1; break;
            case 6: boff = WS_QS; sc = C2; break;
            case 7: boff = WS_KS; mode = 3; break;
            default: boff = WS_GS; mode = 1; break;
        }
        bf16_t* base = (bf16_t*)(ws + boff);
        if (mode == 2) {
            const f32x4* cs = (const f32x4*)(ws + WS_CS);
            const int head = half * 4 + wc, i0 = 8 * fq;
#pragma unroll
            for (int ai = 0; ai < 2; ++ai)
#pragma unroll
                for (int m = 0; m < 4; ++m) { const size_t row = (size_t)(row0 + ai * 128 + m * 16);
                    const f32x4* cp = cs + (row * 32 + i0) / 2;
                    f32x4 y1[2], y2[2];
#pragma unroll
                    for (int n = 0; n < 2; ++n) { const f32x4 ca = cp[2 * n], cb = cp[2 * n + 1];
                        const f32x4 x1 = acc[ai][0][m][n], x2 = acc[ai][1][m][n];
                        y1[n][0] = (x1[0] * ca[0] - x2[0] * ca[1]) * sc; y2[n][0] = (x2[0] * ca[0] + x1[0] * ca[1]) * sc;
                        y1[n][1] = (x1[1] * ca[2] - x2[1] * ca[3]) * sc; y2[n][1] = (x2[1] * ca[2] + x1[1] * ca[3]) * sc;
                        y1[n][2] = (x1[2] * cb[0] - x2[2] * cb[1]) * sc; y2[n][2] = (x2[2] * cb[0] + x1[2] * cb[1]) * sc;
                        y1[n][3] = (x1[3] * cb[2] - x2[3] * cb[3]) * sc; y2[n][3] = (x2[3] * cb[2] + x1[3] * cb[3]) * sc; }
                    bf16_t* rp = base + row * 512 + head * 64 + i0;
                    *(u32x4*)rp = pack_f8(y1[0], y1[1]); *(u32x4*)(rp + 32) = pack_f8(y2[0], y2[1]); if (m & 1) asm volatile("" ::: "memory"); }
            return;
        }
        if (mode == 3) {
#pragma unroll
            for (int ai = 0; ai < 2; ++ai)
#pragma unroll
                for (int m = 0; m < 4; ++m) { const int tok = row0 + ai * 128 + m * 16; const int b = tok >> 12, sq = tok & 4095, kv = sq & 63;
#pragma unroll
                    for (int bj = 0; bj < 2; ++bj) { const int head = half * 4 + bj * 2 + (wc >> 1), d0 = (wc & 1) * 2 + (fq >> 1);
                        bf16_t* bp = base + (((size_t)(b * 8 + head) * 64 + (sq >> 6)) * 4096) + (((kv >> 5) * 4 + d0) * 64 + (fq & 1) * 32 + (kv & 31)) * 8;
                        *(u32x4*)bp = pack_f8(acc[ai][bj][m][0], acc[ai][bj][m][1]); }
                    asm volatile("" ::: "memory"); }
            return;
        }
        const int col0 = half * 256 + wc * 32 + 8 * fq;
#pragma unroll
        for (int ai = 0; ai < 2; ++ai)
#pragma unroll
            for (int m = 0; m < 4; ++m) { bf16_t* rowp = base + (size_t)(row0 + ai * 128 + m * 16) * 512 + col0;
#pragma unroll
                for (int bj = 0; bj < 2; ++bj) { f32x4 v0 = acc[ai][bj][m][0], v1 = acc[ai][bj][m][1];
                    if (mode == 1) {
#pragma unroll
                        for (int e = 0; e < 4; ++e) { v0[e] = v0[e] * sigmoidf_(v0[e]); v1[e] = v1[e] * sigmoidf_(v1[e]); } }
                    else { v0 = v0 * sc; v1 = v1 * sc; }
                    *(u32x4*)(rowp + bj * 128) = pack_f8(v0, v1); asm volatile("" ::: "memory"); } }
    }
};
struct EpiPlain {
    bf16_t* O; size_t ldc;
    __device__ __forceinline__ void operator()(const f32x4 (&acc)[2][2][4][2], const Unit& u, int wr, int wc, int fr, int fq) const {
        const int row0 = u.pm * 256 + wr * 64 + fr, col0 = u.pn * 256 + wc * 32 + 8 * fq;
#pragma unroll
        for (int ai = 0; ai < 2; ++ai)
#pragma unroll
            for (int m = 0; m < 4; ++m) { const int r = row0 + ai * 128 + m * 16; const int hb = r >> 6, d = r & 63;
#pragma unroll
                for (int bj = 0; bj < 2; ++bj) { const int tok = col0 + bj * 128; const int b = tok >> 12, sq = tok & 4095, j = sq >> 6, kv0 = sq & 63;
                    bf16_t* bp = O + (((size_t)(hb * 8 + b) * 64 + j) * 4096) + (((kv0 >> 4) * 2 + (d >> 5)) * 64 + (d & 31)) * 8 + ((kv0 & 8) >> 1);
                    const u32x4 w = pack_f8(acc[ai][bj][m][0], acc[ai][bj][m][1]);
                    *(u32x2*)bp = (u32x2){w.x, w.y}; *(u32x2*)(bp + 32 * 8) = (u32x2){w.z, w.w}; }
                asm volatile("" ::: "memory"); }
    }
};
struct EpiMerge {
    bf16_t* O;
    __device__ __forceinline__ void operator()(const f32x4 (&acc)[2][2][4][2], const Unit& u, int wr, int wc, int fr, int fq) const {
        const int row0 = u.pm * 256 + wr * 64 + fr, col0 = u.pn * 256 + wc * 32 + 8 * fq;
#pragma unroll
        for (int ai = 0; ai < 2; ++ai)
#pragma unroll
            for (int m = 0; m < 4; ++m) { bf16_t* rowp = O + (size_t)(row0 + ai * 128 + m * 16) * 3072 + col0;
#pragma unroll
                for (int bj = 0; bj < 2; ++bj) { f32x4 v0 = acc[ai][bj][m][0], v1 = acc[ai][bj][m][1];
#pragma unroll
                    for (int e = 0; e < 4; ++e) { v0[e] = sigmoidf_(v0[e]); v1[e] = sigmoidf_(v1[e]); }
                    *(u32x4*)(rowp + bj * 128) = pack_f8(v0, v1); asm volatile("" ::: "memory"); } }
    }
};
struct EpiMix {
    const bf16_t* M3; bf16_t* MIX;
    __device__ __forceinline__ void operator()(const f32x4 (&acc)[2][2][4][2], const Unit& u, int wr, int wc, int fr, int fq) const {
        const int row0 = u.pm * 256 + wr * 64 + fr, col0 = u.pn * 256 + wc * 32 + 8 * fq; const int br = u.aux;
#pragma unroll
        for (int ai = 0; ai < 2; ++ai) {
            u32x4 g[2][4], o[2][4];
#pragma unroll
            for (int bj = 0; bj < 2; ++bj)
#pragma unroll
                for (int m = 0; m < 4; ++m) { const size_t row = (size_t)(row0 + ai * 128 + m * 16); const int col = col0 + bj * 128;
                    g[bj][m] = *(const u32x4*)(M3 + row * 3072 + br * 1024 + col);
                    if (br != 0) o[bj][m] = *(const u32x4*)(MIX + row * 1024 + col); else o[bj][m] = (u32x4){0u, 0u, 0u, 0u}; }
#pragma unroll
            for (int bj = 0; bj < 2; ++bj)
#pragma unroll
                for (int m = 0; m < 4; ++m) { const size_t row = (size_t)(row0 + ai * 128 + m * 16); const int col = col0 + bj * 128;
                    const u32x4 gg = g[bj][m], oo = o[bj][m];
                    f32x4 v0 = acc[ai][bj][m][0], v1 = acc[ai][bj][m][1];
                    v0[0] = v0[0] * bflo(gg.x) + bflo(oo.x); v0[1] = v0[1] * bfhi(gg.x) + bfhi(oo.x); v0[2] = v0[2] * bflo(gg.y) + bflo(oo.y); v0[3] = v0[3] * bfhi(gg.y) + bfhi(oo.y);
                    v1[0] = v1[0] * bflo(gg.z) + bflo(oo.z); v1[1] = v1[1] * bfhi(gg.z) + bfhi(oo.z); v1[2] = v1[2] * bflo(gg.w) + bflo(oo.w); v1[3] = v1[3] * bfhi(gg.w) + bfhi(oo.w);
                    *(u32x4*)(MIX + row * 1024 + col) = pack_f8(v0, v1); }
            asm volatile("" ::: "memory"); }
    }
};
struct EpiOut {
    const float* xold; float* xnew; const float* gate;
    __device__ __forceinline__ void operator()(const f32x4 (&acc)[2][2][4][2], const Unit& u, int wr, int wc, int fr, int fq) const {
        const int row0 = u.pm * 256 + wr * 64 + fr, col0 = u.pn * 256 + wc * 32 + 8 * fq; const int b = u.pm >> 4;
        const float* gp = gate + (size_t)b * 3072;
#pragma unroll
        for (int bj = 0; bj < 2; ++bj) { const int col = col0 + bj * 128; const f32x4 g0 = *(const f32x4*)(gp + col), g1 = *(const f32x4*)(gp + col + 4);
#pragma unroll
            for (int ai = 0; ai < 2; ++ai) {
                f32x4 a0[4], a1[4];
#pragma unroll
                for (int m = 0; m < 4; ++m) { const size_t off = (size_t)(row0 + ai * 128 + m * 16) * 1024 + col; a0[m] = *(const f32x4*)(xold + off); a1[m] = *(const f32x4*)(xold + off + 4); }
#pragma unroll
                for (int m = 0; m < 4; ++m) { const size_t off = (size_t)(row0 + ai * 128 + m * 16) * 1024 + col;
                    *(f32x4*)(xnew + off) = a0[m] + g0 * acc[ai][bj][m][0]; *(f32x4*)(xnew + off + 4) = a1[m] + g1 * acc[ai][bj][m][1]; }
                asm volatile("" ::: "memory"); } }
    }
};

__device__ __forceinline__ int in_src_col(int np) {
    const int tile = np >> 8, cp = np & 255;
    const int rp = 64 * ((cp & 127) >> 5) + 32 * (cp >> 7) + (cp & 31);
    if (tile < 2) return np;
    if (tile < 4) return 512 + (np - 2 * 256);
    if (tile < 6) return 1544 + (np - 4 * 256);
    if (tile < 8) return 2056 + (tile - 6) * 256 + rp;
    if (tile < 10) return 2696 + (tile - 8) * 256 + rp;
    if (tile < 12) return 3280 + (np - 10 * 256);
    if (tile < 14) return 3792 + (np - 12 * 256);
    if (tile < 16) return 4304 + (np - 14 * 256);
    if (tile < 18) return 5328 + (np - 16 * 256);
    if (tile == 18) { if (cp < 128) return 2568 + cp; if (cp < 192) return 3208 + cp - 128; if (cp < 200) return 1536 + cp - 192; if (cp < 208) return 3272 + cp - 200; return -1; }
    if (tile < 31) return 5840 + (np - 19 * 256);
    if (tile < 33) return 1024 + (np - 31 * 256);
    return 4816 + (np - 33 * 256);
}
template <bool MAP>
__device__ __forceinline__ void transpose_item(const float* W, int K, int N, int NP, bf16_t* WT, LAS float* scr, int item, int lane) {
    const int nblk = NP / 32, kb = item / nblk, nb = item % nblk, k0 = 64 * kb, n0 = 32 * nb;
    int src = n0 + (lane & 31); if (MAP) src = in_src_col(src);
#pragma unroll
    for (int i = 0; i < 32; ++i) { const int kk = 2 * i + (lane >> 5); scr[kk * 33 + (lane & 31)] = (src >= 0) ? W[(size_t)(k0 + kk) * N + src] : 0.f; }
    asm volatile("s_waitcnt lgkmcnt(0)" ::: "memory");
    const int c = lane & 7;
#pragma unroll
    for (int j = 0; j < 4; ++j) { const int n = (lane >> 3) + 8 * j; const LAS float* s = scr + (8 * c) * 33 + n;
        u32x4 o; o.x = cvt_pk(s[0 * 33], s[1 * 33]); o.y = cvt_pk(s[2 * 33], s[3 * 33]); o.z = cvt_pk(s[4 * 33], s[5 * 33]); o.w = cvt_pk(s[6 * 33], s[7 * 33]);
        *(u32x4*)(WT + (size_t)(n0 + n) * K + k0 + 8 * c) = o; }
    asm volatile("s_waitcnt lgkmcnt(0)" ::: "memory");
}

template <bool SB>
__device__ __forceinline__ void attn_fs_wave(const bf16_t* Q, const bf16_t* Kb, const bf16_t* VT, const float* F2, const bf16_t* G, bf16_t* Y, int b, int h, int q0w, int lane, bool do_store, const unsigned* kmaxw) {
    asm volatile("" : "+v"(lane));
    const int r32 = lane & 31, hi = lane >> 5;
    const int tq = q0w + r32;
    const size_t rowQ = (size_t)b * SEQ + tq;
    bf16x8 qf[4];
#pragma unroll
    for (int d0 = 0; d0 < 4; ++d0) qf[d0] = *(const bf16x8*)(Q + rowQ * 512 + h * 64 + d0 * 16 + hi * 8);
    f32x16 o0, o1;
#pragma unroll
    for (int r = 0; r < 16; ++r) { o0[r] = 0.f; o1[r] = 0.f; }
    float m = -INFINITY, l = 0.f, carry = 0.f, Ft = 0.f;
    const float* F2b = F2 + (size_t)(b * 8 + h) * SEQ;
    float qk = 0.f;
    if (!SB) { Ft = F2b[tq];
        float ss = 0.f;
#pragma unroll
        for (int d0 = 0; d0 < 4; ++d0)
#pragma unroll
            for (int e = 0; e < 8; ++e) { const float f = bf2f((bf16_t)qf[d0][e]); ss += f * f; }
        ss += shx32(ss, lane);
        qk = sqrtf(ss * __uint_as_float(kmaxw[b * 8 + h])) * 1.001f; }
    const bf16_t* Kh = Kb + (size_t)(b * 8 + h) * 64 * 4096;
    const bf16_t* VTh = VT + (size_t)(h * 8 + b) * 64 * 4096;
    const int jmax = (q0w + 31) >> 6;
    bf16x8 kf[2][4];
#pragma unroll
    for (int hf = 0; hf < 2; ++hf)
#pragma unroll
        for (int d0 = 0; d0 < 4; ++d0) kf[hf][d0] = *(const bf16x8*)(Kh + (size_t)jmax * 4096 + ((hf * 4 + d0) * 64 + lane) * 8);
    for (int j = jmax; j >= 0; --j) {
        const int kv0 = j * 64;
        bf16x8 vf[4][2];
#pragma unroll
        for (int ks = 0; ks < 4; ++ks)
#pragma unroll
            for (int dd = 0; dd < 2; ++dd) vf[ks][dd] = *(const bf16x8*)(VTh + (size_t)j * 4096 + ((ks * 2 + dd) * 64 + lane) * 8);
        bf16x8 kn[2][4];
        { const int jn = (j > 0 ? j - 1 : 0);
#pragma unroll
          for (int hf = 0; hf < 2; ++hf)
#pragma unroll
              for (int d0 = 0; d0 < 4; ++d0) kn[hf][d0] = *(const bf16x8*)(Kh + (size_t)jn * 4096 + ((hf * 4 + d0) * 64 + lane) * 8); }
        f32x4 fa4[4], fb4[4]; float fs_next = 0.f;
        if (!SB) {
#pragma unroll
            for (int g = 0; g < 4; ++g) { fa4[g] = *(const f32x4*)(F2b + kv0 + 8 * g + 4 * hi); fb4[g] = *(const f32x4*)(F2b + kv0 + 32 + 8 * g + 4 * hi); }
            fs_next = F2b[j > 0 ? 64 * j - 1 : 0];
        }
        asm volatile("" ::: "memory");
        f32x16 p0, p1;
#pragma unroll
        for (int r = 0; r < 16; ++r) { p0[r] = 0.f; p1[r] = 0.f; }
#pragma unroll
        for (int d0 = 0; d0 < 4; ++d0) { p0 = mfma32(kf[0][d0], qf[d0], p0); p1 = mfma32(kf[1][d0], qf[d0], p1); }
        if (!SB) {
#pragma unroll
            for (int g = 0; g < 4; ++g) { const f32x4 fa = fa4[g], fb = fb4[g];
#pragma unroll
                for (int e = 0; e < 4; ++e) { p0[4 * g + e] += Ft - fa[e]; p1[4 * g + e] += Ft - fb[e]; } }
            if (j == jmax) {
#pragma unroll
                for (int r = 0; r < 16; ++r) { const int kv = kv0 + crow(r, hi); if (kv > tq) p0[r] = -INFINITY; if (kv + 32 > tq) p1[r] = -INFINITY; } }
            float mx = p0[0];
#pragma unroll
            for (int r = 1; r < 16; ++r) mx = fmaxf(mx, p0[r]);
#pragma unroll
            for (int r = 0; r < 16; ++r) mx = fmaxf(mx, p1[r]);
            mx = fmaxf(mx, shx32(mx, lane));
            const float mnew = fmaxf(m, mx); const float alpha = ex2(m - mnew); m = mnew;
            l *= alpha;
#pragma unroll
            for (int r = 0; r < 16; ++r) { o0[r] *= alpha; o1[r] *= alpha; }
            float s = 0.f;
#pragma unroll
            for (int r = 0; r < 16; ++r) { p0[r] = ex2(p0[r] - m); p1[r] = ex2(p1[r] - m); s += p0[r] + p1[r]; }
            l += s;
        } else {
            float lm0[16], lm1[16];
#pragma unroll
            for (int r = 0; r < 16; ++r) {
                const int kv = kv0 + crow(r, hi);
                const float z0 = p0[r], z1 = p1[r];
                const float sp0 = (z0 > 40.f) ? z0 : lg2(1.0f + ex2(z0)), sp1 = (z1 > 40.f) ? z1 : lg2(1.0f + ex2(z1));
                const bool v0 = kv < tq, v1 = (kv + 32) < tq;
                lm0[r] = v0 ? sp0 : 0.f; lm1[r] = v1 ? sp1 : 0.f;
                p0[r] = v0 ? (z0 - sp0) : -INFINITY; p1[r] = v1 ? (z1 - sp1) : -INFINITY;
            }
            float gs0[4], gs1[4], ps0[4], ps1[4];
#pragma unroll
            for (int a = 0; a < 4; ++a) { gs0[a] = (lm0[4 * a] + lm0[4 * a + 1]) + (lm0[4 * a + 2] + lm0[4 * a + 3]); gs1[a] = (lm1[4 * a] + lm1[4 * a + 1]) + (lm1[4 * a + 2] + lm1[4 * a + 3]); }
#pragma unroll
            for (int a = 0; a < 4; ++a) { ps0[a] = shx32(gs0[a], lane); ps1[a] = shx32(gs1[a], lane); }
            float run = carry;
            float ex0[4], ex1[4];
#pragma unroll
            for (int a = 3; a >= 0; --a) { const float odd = hi ? gs1[a] : ps1[a]; const float pair = gs1[a] + ps1[a]; ex1[a] = run + (hi ? 0.f : odd); run += pair; }
#pragma unroll
            for (int a = 3; a >= 0; --a) { const float odd = hi ? gs0[a] : ps0[a]; const float pair = gs0[a] + ps0[a]; ex0[a] = run + (hi ? 0.f : odd); run += pair; }
            carry = run;
#pragma unroll
            for (int a = 0; a < 4; ++a) {
                float w = ex0[a];
                p0[4 * a + 3] = ex2(p0[4 * a + 3] - w); w += lm0[4 * a + 3];
                p0[4 * a + 2] = ex2(p0[4 * a + 2] - w); w += lm0[4 * a + 2];
                p0[4 * a + 1] = ex2(p0[4 * a + 1] - w); w += lm0[4 * a + 1];
                p0[4 * a + 0] = ex2(p0[4 * a + 0] - w);
                w = ex1[a];
                p1[4 * a + 3] = ex2(p1[4 * a + 3] - w); w += lm1[4 * a + 3];
                p1[4 * a + 2] = ex2(p1[4 * a + 2] - w); w += lm1[4 * a + 2];
                p1[4 * a + 1] = ex2(p1[4 * a + 1] - w); w += lm1[4 * a + 1];
                p1[4 * a + 0] = ex2(p1[4 * a + 0] - w);
            }
        }
        bf16x8 pw[4];
        pw[0] = pack8(p0[0], p0[1], p0[2], p0[3], p0[4], p0[5], p0[6], p0[7]);
        pw[1] = pack8(p0[8], p0[9], p0[10], p0[11], p0[12], p0[13], p0[14], p0[15]);
        pw[2] = pack8(p1[0], p1[1], p1[2], p1[3], p1[4], p1[5], p1[6], p1[7]);
        pw[3] = pack8(p1[8], p1[9], p1[10], p1[11], p1[12], p1[13], p1[14], p1[15]);
#pragma unroll
        for (int ks = 0; ks < 4; ++ks) { o0 = mfma32(vf[ks][0], pw[ks], o0); o1 = mfma32(vf[ks][1], pw[ks], o1); }
#pragma unroll
        for (int hf = 0; hf < 2; ++hf)
#pragma unroll
            for (int d0 = 0; d0 < 4; ++d0) kf[hf][d0] = kn[hf][d0];
        if (SB) { if (__all(carry > 160.f)) break; }
        else if (j > 0) {
            const float fs = fs_next;
            if (__all(qk + Ft - m + 64.f < fs)) break; }
    }
    float inv = 1.f;
    if (!SB) { const float lt = l + shx32(l, lane); inv = 1.0f / lt; }
    if (do_store)
#pragma unroll
    for (int g = 0; g < 4; ++g)
#pragma unroll
        for (int dd = 0; dd < 2; ++dd) {
            const size_t off = rowQ * 512 + h * 64 + dd * 32 + 8 * g + 4 * hi;
            const u32x2 gg = *(const u32x2*)(G + off);
            const f32x16& o = dd ? o1 : o0;
            u32x2 w; w.x = cvt_pk(o[4 * g] * inv * bflo(gg.x), o[4 * g + 1] * inv * bfhi(gg.x)); w.y = cvt_pk(o[4 * g + 2] * inv * bflo(gg.y), o[4 * g + 3] * inv * bfhi(gg.y));
            *(u32x2*)(Y + off) = w;
        }
}

__device__ __forceinline__ int wave_total(int v) {
    v += __builtin_amdgcn_update_dpp(0, v, 0x111, 0xf, 0xf, false);
    v += __builtin_amdgcn_update_dpp(0, v, 0x112, 0xf, 0xf, false);
    v += __builtin_amdgcn_update_dpp(0, v, 0x114, 0xf, 0xf, false);
    v += __builtin_amdgcn_update_dpp(0, v, 0x118, 0xf, 0xf, false);
    v += __builtin_amdgcn_update_dpp(0, v, 0x142, 0xa, 0xf, false);
    v += __builtin_amdgcn_update_dpp(0, v, 0x143, 0xc, 0xf, false);
    return __builtin_amdgcn_readlane(v, 63);
}
#ifndef DSA_SELFCHECK
#define DSA_SELFCHECK 0
#endif
__device__ __forceinline__ void dsa_unit(LAS unsigned char* lds, unsigned char* ws, int b, int t0, int wid, int lane, bool do_store) {
    asm volatile("" : "+v"(lane));
    LAS float* sc = (LAS float*)lds;
    LAS int* lists = (LAS int*)(lds + 131072);
    const bf16_t* IQ = (const bf16_t*)(ws + WS_IQ); const bf16_t* IK = (const bf16_t*)(ws + WS_IK);
    const float* MF = (const float*)(ws + WS_MISCF);
    const bf16_t* DK = (const bf16_t*)(ws + WS_DK); const bf16_t* DV = (const bf16_t*)(ws + WS_DV);
    const bf16_t* GD = (const bf16_t*)(ws + WS_GD); bf16_t* QD = (bf16_t*)(ws + WS_QD);
    const size_t tokb = (size_t)b * SEQ;
    const int r32 = lane & 31, hi = lane >> 5;
    for (int ra_ = 0; ra_ < REP_DA; ++ra_) {
        const int a_ = r32 >> 3, uu = (r32 >> 2) & 1, bb = r32 & 3; const int qq = 2 * uu + (a_ >> 1), hd = 4 * (a_ & 1) + bb;
        bf16x8 af[2][4];
#pragma unroll
        for (int rt = 0; rt < 2; ++rt)
#pragma unroll
            for (int d0 = 0; d0 < 4; ++d0) af[rt][d0] = *(const bf16x8*)(IQ + (tokb + t0 + 4 * rt + qq) * 512 + hd * 64 + d0 * 16 + hi * 8);
        const float WSC = 0.35355339059327373f * 0.125f;
        float w[2][16];
#pragma unroll
        for (int rt = 0; rt < 2; ++rt)
#pragma unroll
            for (int qh = 0; qh < 2; ++qh) { const float* wp = MF + (tokb + t0 + 4 * rt + 2 * hi + qh) * 128 + 72; const f32x4 wa = *(const f32x4*)wp, wb = *(const f32x4*)(wp + 4);
#pragma unroll
                for (int e = 0; e < 4; ++e) { w[rt][8 * qh + e] = wa[e] * WSC; w[rt][8 * qh + 4 + e] = wb[e] * WSC; } }
        const int nkt = (t0 + 8 + 31) >> 5;
        bf16x8 bfr[4];
#pragma unroll
        for (int d0 = 0; d0 < 4; ++d0) bfr[d0] = *(const bf16x8*)(IK + (((size_t)b * 128 + (wid < nkt ? wid : 0)) * 4 + d0) * 512 + lane * 8);
        for (int kt = wid; kt < nkt; kt += 8) {
            const int key = kt * 32 + r32;
            bf16x8 bnx[4];
            { const int ktn = (kt + 8 < nkt) ? kt + 8 : kt;
#pragma unroll
              for (int d0 = 0; d0 < 4; ++d0) bnx[d0] = *(const bf16x8*)(IK + (((size_t)b * 128 + ktn) * 4 + d0) * 512 + lane * 8); }
            asm volatile("" ::: "memory");
            f32x16 c0, c1;
#pragma unroll
            for (int r = 0; r < 16; ++r) { c0[r] = 0.f; c1[r] = 0.f; }
#pragma unroll
            for (int d0 = 0; d0 < 4; ++d0) { c0 = mfma32(af[0][d0], bfr[d0], c0); c1 = mfma32(af[1][d0], bfr[d0], c1); }
            float s00 = 0.f, s01 = 0.f, s10 = 0.f, s11 = 0.f;
#pragma unroll
            for (int r = 0; r < 8; ++r) { s00 += w[0][r] * fmaxf(c0[r], 0.f); s01 += w[0][8 + r] * fmaxf(c0[8 + r], 0.f); s10 += w[1][r] * fmaxf(c1[r], 0.f); s11 += w[1][8 + r] * fmaxf(c1[8 + r], 0.f); }
            const int q00 = 2 * hi, q01 = 2 * hi + 1, q10 = 4 + 2 * hi, q11 = 5 + 2 * hi;
            sc[q00 * 4096 + key] = (key > t0 + q00) ? -INFINITY : s00;
            sc[q01 * 4096 + key] = (key > t0 + q01) ? -INFINITY : s01;
            sc[q10 * 4096 + key] = (key > t0 + q10) ? -INFINITY : s10;
            sc[q11 * 4096 + key] = (key > t0 + q11) ? -INFINITY : s11;
#pragma unroll
            for (int d0 = 0; d0 < 4; ++d0) bfr[d0] = bnx[d0];
        }
    }
    __syncthreads();
    const int t = t0 + wid, n = t + 1;
    int count; bool badsel = false; (void)badsel;
    for (int rb_ = 0; rb_ < REP_DB; ++rb_) {
        unsigned key[64];
        const LAS float* row = sc + wid * 4096;
#pragma unroll
        for (int j = 0; j < 64; ++j) { const int idx = j * 64 + lane; const int idc = idx < n ? idx : n - 1;
            const unsigned bits = __float_as_uint(row[idc]); const unsigned k = bits ^ (unsigned)(((int)bits >> 31) | (int)0x80000000);
            key[j] = idx < n ? k : 0u; }
        unsigned T = 0u; int cT = 0;
        const int nb8 = (n + 511) >> 9;
        bool bad = false; (void)bad;
#define DSA_COUNT(CAND, OUT) do { int cl_ = 0; _Pragma("unroll") for (int jb = 0; jb < 8; ++jb) { if (jb < nb8) { _Pragma("unroll") for (int j = 8 * jb; j < 8 * jb + 8; ++j) cl_ += (key[j] >= (CAND)) ? 1 : 0; } } \
            OUT = wave_total(cl_); \
            if (DSA_SELFCHECK) { int c2_ = 0; _Pragma("unroll") for (int j = 0; j < 64; ++j) c2_ += __builtin_popcountll(__ballot(key[j] >= (CAND))); if (c2_ != OUT) bad = true; } } while (0)
        if (n > 256) {
            int bit = 30, c;
            DSA_COUNT(0x80000000u, c);
            if (c >= 256) { T = 0x80000000u; cT = c;
                if (c > 256) {
                    unsigned mxk = 0u;
#pragma unroll
                    for (int jb = 0; jb < 8; ++jb) { if (jb < nb8) {
#pragma unroll
                        for (int j = 8 * jb; j < 8 * jb + 8; ++j) mxk = key[j] > mxk ? key[j] : mxk; } }
#pragma unroll
                    for (int o = 1; o < 64; o <<= 1) { const unsigned ov = (unsigned)__builtin_amdgcn_ds_bpermute((lane ^ o) << 2, (int)mxk); mxk = ov > mxk ? ov : mxk; }
                    unsigned cand = mxk & 0xFF800000u;
                    for (int tr_ = 0; tr_ < 4; ++tr_) { DSA_COUNT(cand, c); if (c >= 256) { T = cand; cT = c; bit = 22; break; } if (cand <= 0x80800000u) break; cand -= 0x00800000u; }
                }
            }
            for (; bit >= 0 && cT != 256; --bit) { const unsigned cand = T | (1u << bit); DSA_COUNT(cand, c); if (c >= 256) { T = cand; cT = c; } }
            if (DSA_SELFCHECK) {
                unsigned Tr = 0u; int cr = 0;
                for (int b2 = 31; b2 >= 0; --b2) { const unsigned cand = Tr | (1u << b2); int c2 = 0;
#pragma unroll
                    for (int j = 0; j < 64; ++j) c2 += __builtin_popcountll(__ballot(key[j] >= cand));
                    if (c2 >= 256) { Tr = cand; cr = c2; if (c2 == 256) break; } }
                if (cT == 256 || cr == 256) { if (cT != cr) bad = true; } else if (T != Tr) bad = true;
            }
        }
        if (n <= 256) {
            for (int p2 = lane; p2 < 256; p2 += 64) lists[wid * 256 + p2] = p2;
        } else if (cT == 256) {
            int cl = 0;
#pragma unroll
            for (int jb = 0; jb < 8; ++jb) { if (jb < nb8) {
#pragma unroll
                for (int j = 8 * jb; j < 8 * jb + 8; ++j) cl += (key[j] >= T) ? 1 : 0; } }
            int incl = cl;
#pragma unroll
            for (int o = 1; o < 64; o <<= 1) { const int nbv = __builtin_amdgcn_ds_bpermute(((lane >= o) ? (lane - o) : lane) << 2, incl); if (lane >= o) incl += nbv; }
            int off = wid * 256 + incl - cl;
#pragma unroll
            for (int jb = 0; jb < 8; ++jb) { if (jb < nb8) {
#pragma unroll
                for (int j = 8 * jb; j < 8 * jb + 8; ++j) { if (key[j] >= T) { lists[off] = j * 64 + lane; ++off; } } } }
        } else {
        int eqbase = 0;
#pragma unroll
        for (int j = 0; j < 64; ++j) { const int idx = j * 64 + lane;
            const bool eq = (key[j] == T); const unsigned long long meq = __ballot(eq); const int r = eqbase + mbcnt64(meq);
            if (eq && r < 256) lists[wid * 256 + 255 - r] = idx;
            eqbase += __builtin_popcountll(meq); __builtin_amdgcn_sched_barrier(0); }
        int base = 0;
#pragma unroll
        for (int j = 0; j < 64; ++j) { const int idx = j * 64 + lane;
            const bool gt = (key[j] > T); const unsigned long long mg = __ballot(gt); const int pos = base + mbcnt64(mg);
            if (gt) lists[wid * 256 + pos] = idx;
            base += __builtin_popcountll(mg); __builtin_amdgcn_sched_barrier(0); }
        }
        count = n < 256 ? n : 256; badsel = badsel || bad;
    }
    asm volatile("s_waitcnt lgkmcnt(0)" ::: "memory");
    __builtin_amdgcn_wave_barrier();
    for (int rc_ = 0; rc_ < REP_DC; ++rc_) {
        const bool do_store_c = do_store && (rc_ == REP_DC - 1);
        const int hh = lane & 15, g = lane >> 4;
        bf16x8 qb[2];
#pragma unroll
        for (int ks = 0; ks < 2; ++ks) { if (hh < 8) qb[ks] = *(const bf16x8*)(QD + (tokb + t) * 512 + hh * 64 + ks * 32 + g * 8); else qb[ks] = (bf16x8){0, 0, 0, 0, 0, 0, 0, 0}; }
        const LAS int* lw = lists + wid * 256;
        const int cg = count - 4 * g;
        float s[64];
        const int nhalf = (count > 128) ? 2 : 1;
        u32x4 vr[16];
        {
            bf16x8 ka[16][2];
#pragma unroll
            for (int tile = 0; tile < 16; ++tile) { const int idx = lw[tile * 16 + hh];
                ka[tile][0] = *(const bf16x8*)(DK + (tokb + idx) * 64 + g * 8); ka[tile][1] = *(const bf16x8*)(DK + (tokb + idx) * 64 + 32 + g * 8); }
#pragma unroll
            for (int i = 0; i < 16; ++i) { const int row = i * 8 + (lane >> 3); const int idx = lw[row]; vr[i] = *(const u32x4*)(DV + (tokb + idx) * 64 + (lane & 7) * 8); }
            asm volatile("" ::: "memory");
#pragma unroll
            for (int tile = 0; tile < 16; ++tile) {
                f32x4 c = (f32x4){0.f, 0.f, 0.f, 0.f}; c = mfma16(ka[tile][0], qb[0], c); c = mfma16(ka[tile][1], qb[1], c);
#pragma unroll
                for (int j = 0; j < 4; ++j) s[4 * tile + j] = (tile * 16 + j < cg) ? c[j] : -INFINITY; }
        }
        float mx = s[0];
#pragma unroll
        for (int j = 1; j < 64; ++j) mx = fmaxf(mx, s[j]);
        mx = fmaxf(mx, shx(mx, 16, lane)); mx = fmaxf(mx, shx32(mx, lane));
        float sum = 0.f;
#pragma unroll
        for (int j = 0; j < 64; ++j) { s[j] = ex2(s[j] - mx); sum += s[j]; }
        sum += shx(sum, 16, lane); sum += shx32(sum, lane);
        LAS unsigned char* vs = (LAS unsigned char*)(sc + wid * 4096);
        f32x4 oacc[4];
#pragma unroll
        for (int dt = 0; dt < 4; ++dt) oacc[dt] = (f32x4){0.f, 0.f, 0.f, 0.f};
        u32x2 ggv[4];
#pragma unroll
        for (int dt = 0; dt < 4; ++dt) ggv[dt] = *(const u32x2*)(GD + (tokb + t) * 512 + (hh & 7) * 64 + dt * 16 + 4 * g);
#pragma unroll
        for (int half = 0; half < 2; ++half) {
            if (half < nhalf) {
#pragma unroll
                for (int i = 0; i < 16; ++i) { const int row = i * 8 + (lane >> 3); const int phys = (lane & 7) ^ (2 * ((row >> 2) & 1) + 4 * ((row >> 1) & 1)); *(LAS u32x4*)(vs + row * 128 + phys * 16) = vr[i]; }
                asm volatile("s_waitcnt lgkmcnt(0)" ::: "memory");
                __builtin_amdgcn_wave_barrier();
                if (half == 0 && nhalf == 2) {
#pragma unroll
                    for (int i = 0; i < 16; ++i) { const int row = i * 8 + (lane >> 3); const int idx = lw[128 + row]; vr[i] = *(const u32x4*)(DV + (tokb + idx) * 64 + (lane & 7) * 8); }
                    asm volatile("" ::: "memory");
                }
                const int q_ = (lane >> 2) & 3, p_ = lane & 3;
#pragma unroll
                for (int ks = 0; ks < 4; ++ks) {
                    const int ta = 2 * (half * 4 + ks), tb = ta + 1;
                    const bf16x8 pb = pack8(s[4 * ta], s[4 * ta + 1], s[4 * ta + 2], s[4 * ta + 3], s[4 * tb], s[4 * tb + 1], s[4 * tb + 2], s[4 * tb + 3]);
#pragma unroll
                    for (int dt = 0; dt < 4; ++dt) {
                        const int phys = (2 * dt + (p_ >> 1)) ^ (2 * (g & 1) + 4 * (q_ >> 1));
                        LAS unsigned char* ap = vs + (4 * g + q_) * 128 + phys * 16 + 8 * (p_ & 1) + ks * 4096;
                        const bf16x4 lo = __builtin_bit_cast(bf16x4, __builtin_amdgcn_ds_read_tr16_b64_v4i16((LAS bf16x4*)ap));
                        const bf16x4 hi4 = __builtin_bit_cast(bf16x4, __builtin_amdgcn_ds_read_tr16_b64_v4i16((LAS bf16x4*)(ap + 2048)));
                        const bf16x8 va = (bf16x8){lo[0], lo[1], lo[2], lo[3], hi4[0], hi4[1], hi4[2], hi4[3]};
                        oacc[dt] = mfma16(va, pb, oacc[dt]);
                    }
                }
                asm volatile("s_waitcnt lgkmcnt(0)" ::: "memory");
                __builtin_amdgcn_wave_barrier();
            }
        }
        if (hh < 8 && do_store_c) {
            float inv = 1.0f / sum;
            if (DSA_SELFCHECK && badsel) inv = __builtin_nanf("");
#pragma unroll
            for (int dt = 0; dt < 4; ++dt) { const size_t off = (tokb + t) * 512 + hh * 64 + dt * 16 + 4 * g;
                const u32x2 gg = ggv[dt];
                u32x2 w; w.x = cvt_pk(oacc[dt][0] * inv * bflo(gg.x), oacc[dt][1] * inv * bfhi(gg.x)); w.y = cvt_pk(oacc[dt][2] * inv * bflo(gg.y), oacc[dt][3] * inv * bfhi(gg.y));
                *(u32x2*)(QD + off) = w; }
        }
    }
    __syncthreads();
}

#define XB_TMO      128
#define XB_XCNT(j)  (256  + 64 * (j))
#define XB_XSUB(j)  (1280 + 64 * (j))
#define XB_XGEN(j)  (2304 + 64 * (j))
#define XB_TOP      3328
#define XB_TOPGEN   3392
#define XCD_BAR_WORDS 3456
#define XB_SPIN_CAP (1u << 22)
__device__ __forceinline__ unsigned xb_ld(unsigned* p)              { return __hip_atomic_load(p, __ATOMIC_RELAXED, __HIP_MEMORY_SCOPE_AGENT); }
__device__ __forceinline__ unsigned xb_add(unsigned* p, unsigned v) { return __hip_atomic_fetch_add(p, v, __ATOMIC_RELAXED, __HIP_MEMORY_SCOPE_AGENT); }
__device__ __forceinline__ unsigned xb_xcc_id() { return (unsigned)__builtin_amdgcn_s_getreg((3 << 11) | 20) & 0xFu; }
#define XB_SPIN(cond, bar) do { unsigned _sp = 0; while (cond) { __builtin_amdgcn_s_sleep(1); \
    if ((++_sp & 255u) == 0u) { if (xb_ld(&(bar)[XB_TMO])) break; if (_sp > XB_SPIN_CAP) { atomicAdd(&(bar)[XB_TMO], 1u); break; } } } } while (0)
__device__ __forceinline__ void xcd_barrier_complete(unsigned* bar, unsigned x, unsigned G, unsigned& nloc, unsigned& nx) {
    unsigned sum, cnt, mine, sp = 0u;
    for (;;) {
        sum = 0u; cnt = 0u; mine = 0u;
#pragma unroll
        for (unsigned j = 0; j < 16; ++j) { const unsigned c = xb_ld(&bar[XB_XCNT(j)]); sum += c; cnt += (c > 0u) ? 1u : 0u; mine = (j == x) ? c : mine; }
        if (sum == G) break;
        __builtin_amdgcn_s_sleep(1);
        if ((++sp & 255u) == 0u) { if (xb_ld(&bar[XB_TMO])) break; if (sp > XB_SPIN_CAP) { atomicAdd(&bar[XB_TMO], 1u); break; } }
    }
    nloc = mine > 0u ? mine : 1u; nx = cnt > 0u ? cnt : 1u;
}
__device__ __forceinline__ void xcd_barrier(unsigned* bar, unsigned x, unsigned G, volatile LAS unsigned* st, bool leader) {
    asm volatile("s_waitcnt vmcnt(0)" ::: "memory");
    __syncthreads();
    if (leader) {
        __builtin_amdgcn_s_waitcnt(0);
        unsigned nloc = st[0], nx = st[1];
        if (nloc == 0u) { xcd_barrier_complete(bar, x, G, nloc, nx); st[0] = nloc; st[1] = nx; }
        const unsigned old = xb_add(&bar[XB_XSUB(x)], 1u);
        const unsigned gen = old / nloc;
        if (old + 1u == (gen + 1u) * nloc) {
            __builtin_amdgcn_fence(__ATOMIC_RELEASE, "agent");
            asm volatile("s_waitcnt vmcnt(0)" ::: "memory");
            const unsigned og = xb_add(&bar[XB_TOP], 1u);
            const unsigned tg = og / nx;
            if (og + 1u == (tg + 1u) * nx) xb_add(&bar[XB_TOPGEN], 1u);
            else XB_SPIN(xb_ld(&bar[XB_TOPGEN]) == tg, bar);
            __builtin_amdgcn_fence(__ATOMIC_ACQUIRE, "agent");
            xb_add(&bar[XB_XGEN(x)], 1u);
            asm volatile("s_waitcnt vmcnt(0)" ::: "memory");
        } else {
            XB_SPIN(xb_ld(&bar[XB_XGEN(x)]) == gen, bar);
            __builtin_amdgcn_fence(__ATOMIC_ACQUIRE, "agent");
            asm volatile("s_waitcnt vmcnt(0)" ::: "memory");
        }
    }
    __syncthreads();
}
__device__ __forceinline__ void grid_bar(unsigned* bar, unsigned target, unsigned gen, bool leader) {
    asm volatile("s_waitcnt vmcnt(0) lgkmcnt(0)" ::: "memory");
    __syncthreads();
    if (leader) {
        __builtin_amdgcn_fence(__ATOMIC_RELEASE, "agent");
        asm volatile("s_waitcnt vmcnt(0)" ::: "memory");
        const unsigned old = __hip_atomic_fetch_add(&bar[0], 1u, __ATOMIC_RELAXED, __HIP_MEMORY_SCOPE_AGENT);
        if (old + 1u == target) __hip_atomic_fetch_add(&bar[64], 1u, __ATOMIC_RELAXED, __HIP_MEMORY_SCOPE_AGENT);
        else while (__hip_atomic_load(&bar[64], __ATOMIC_RELAXED, __HIP_MEMORY_SCOPE_AGENT) <= gen) __builtin_amdgcn_s_sleep(1);
        __builtin_amdgcn_fence(__ATOMIC_ACQUIRE, "agent");
        asm volatile("s_waitcnt vmcnt(0)" ::: "memory");
    }
    __syncthreads();
}
#ifndef DBG
#define DBG 0
#endif
#ifndef REP_P2
#define REP_P2 1
#endif
#ifndef REP_FOX
#define REP_FOX 1
#endif
#ifndef REP_SB
#define REP_SB 1
#endif
#ifndef REP_DSA
#define REP_DSA 1
#endif
#ifndef REP_P0
#define REP_P0 1
#endif
#ifndef REP_P1
#define REP_P1 1
#endif
#ifndef REP_P3
#define REP_P3 1
#endif
#ifndef REP_P5A
#define REP_P5A 1
#endif
#ifndef REP_P5B
#define REP_P5B 1
#endif
#ifndef REP_BAR
#define REP_BAR 1
#endif
#ifndef REP_P6
#define REP_P6 1
#endif
#ifndef REP_FIN
#define REP_FIN 1
#endif
__device__ __forceinline__ float dbg_value(const unsigned char* ws, int m, int c) {
    auto B = [&](size_t off, size_t idx) { return bf2f(((const bf16_t*)(ws + off))[idx]); };
    const size_t r512 = (size_t)m * 512;
    if (DBG == 1) return B(WS_H, (size_t)m * 1024 + c);
    if (DBG == 2) {
        if (c < 512) return B(WS_QF, r512 + c) + B(WS_KF, r512 + c) + B(WS_GF, r512 + c) + B(WS_QD, r512 + c) + B(WS_IQ, r512 + c) + B(WS_GD, r512 + c) + B(WS_QS, r512 + c) + B(WS_KS, r512 + c) + B(WS_GS, r512 + c);
        if (c < 640) return B(WS_DCKV, (size_t)m * 128 + (c - 512));
        if (c < 768) return ((const float*)(ws + WS_MISCF))[(size_t)m * 128 + (c - 640)];
        { const int cc = c - 768; float v = 0.f; for (int q = 0; q < 4; ++q) v += B(WS_VT, (size_t)(4 * cc + q) * NTOK + m); return v; }
    }
    if (DBG == 3) {
        if (c < 64) return B(WS_DK, (size_t)m * 64 + c);
        if (c < 128) return B(WS_DV, (size_t)m * 64 + c - 64);
        if (c < 192) return B(WS_IK, (size_t)m * 64 + c - 128);
        if (c < 200) return ((const float*)(ws + WS_F2))[(size_t)((m >> 12) * 8 + (c - 192)) * SEQ + (m & 4095)];
        return 0.f;
    }
    if (DBG == 4 || DBG == 41 || DBG == 42 || DBG == 43) { if (c < 512) return B(WS_QF, r512 + c); return B(WS_QD, r512 + c - 512) + B(WS_QS, r512 + c - 512); }
    if (DBG == 5) return B(WS_M3, (size_t)m * 3072 + c) + B(WS_M3, (size_t)m * 3072 + 1024 + c) + B(WS_M3, (size_t)m * 3072 + 2048 + c);
    if (DBG == 6) return B(WS_MIX, (size_t)m * 1024 + c);
    return 0.f;
}
#define DBG_DUMP(k) if (DBG != 0 && (DBG == (k) || DBG / 10 == (k)) && l == 0) { KArgP ap2_ = (KArgP)__builtin_amdgcn_kernarg_segment_ptr(); float* o_ = ap2_->out; const unsigned char* w_ = ap2_->ws; \
        for (size_t e = (size_t)bx0 * NTHR + wid0 * 64 + lane_id_fresh(); e < (size_t)NTOK * 1024; e += (size_t)G0 * NTHR) o_[e] = dbg_value(w_, (int)(e >> 10), (int)(e & 1023)); return; }
#ifndef ONLY
#define ONLY -1
#endif
#define PH(k) (ONLY < 0 || ONLY == (k))
struct Args { const float* x; const float* c; const int* pos; const float* w_ada; const float* b_ada; const float* g_norm; const float* w_in; const float* b_fgt;
              const float* g_kv; const float* w_kv_up; const float* w_br[3]; const float* w_out; const float* g_final; float* out; unsigned char* ws; };

typedef const __attribute__((address_space(4))) Args* KArgP;
__global__ void __launch_bounds__(NTHR, 2) fwd_megakernel(Args A_kernarg) {
    extern __shared__ __attribute__((aligned(16))) unsigned char lds_raw[];
    LAS unsigned char* lds = (LAS unsigned char*)lds_raw;
    cg::grid_group grid = cg::this_grid();
    const int G0 = gridDim.x, bx0 = blockIdx.x;
    const int wid0 = __builtin_amdgcn_readfirstlane((int)threadIdx.x >> 6);
    const unsigned xcc_id = xb_xcc_id();
    unsigned* const barp = (unsigned*)(((KArgP)__builtin_amdgcn_kernarg_segment_ptr())->ws + 4096);
    if (threadIdx.x == 0) { ((volatile LAS unsigned*)(lds + 147000))[0] = 0u; ((volatile LAS unsigned*)(lds + 147000))[1] = 0u;
        (void)xb_add(barp + XB_XCNT(xcc_id), 1u); }
    __syncthreads();
#define LOAD_ARGS KArgP ap_ = (KArgP)__builtin_amdgcn_kernarg_segment_ptr(); int G = G0, bx = bx0; asm volatile("" : "+s"(ap_), "+s"(G), "+s"(bx)); const int NGW = G * NWAVES; (void)NGW; unsigned char* ws = A.ws; float* MOD = (float*)(ws + WS_MOD); (void)MOD;
#define A (*ap_)
#define PHASE_VARS LOAD_ARGS int lane = lane_id_fresh(); asm volatile("" : "+v"(lane)); const int wid = wid0; const int tid = wid * 64 + lane; (void)tid; const int gw = bx * NWAVES + wid; LAS float* scr = (LAS float*)(lds + wid * 16384); (void)scr; (void)gw; (void)lane;

    if constexpr (PH(0)) for (int rep_ = 0; rep_ < REP_P0; ++rep_) {
        PHASE_VARS
        LAS float* red = (LAS float*)lds;
        LAS float* sl = (LAS float*)(lds + 32768);
        if (bx < 96) {
#pragma unroll
            for (int i = 0; i < 16; ++i) { const float cv = A.c[tid + i * NTHR]; sl[tid + i * NTHR] = cv / (1.0f + __expf(-cv)); } }
        __syncthreads();
        for (int it = bx; it < 96; it += G) {
            const int l = it / 48, cgp = it % 48, cc = tid & 63, kp = tid >> 6; const int col = cgp * 64 + cc;
            float acc[8];
#pragma unroll
            for (int b = 0; b < 8; ++b) acc[b] = 0.f;
            const float* wp = A.w_ada + ((size_t)l * 1024 + kp * 128) * 3072 + col;
#pragma unroll 32
            for (int k = 0; k < 128; ++k) { const float w = wp[(size_t)k * 3072];
#pragma unroll
                for (int b = 0; b < 8; ++b) acc[b] += sl[b * 1024 + kp * 128 + k] * w; }
#pragma unroll
            for (int b = 0; b < 8; ++b) red[(kp * 8 + b) * 64 + cc] = acc[b];
            __syncthreads();
            { const int b = tid >> 6; float s = 0.f;
#pragma unroll
              for (int k2 = 0; k2 < 8; ++k2) s += red[(k2 * 8 + b) * 64 + cc];
              MOD[((size_t)l * 8 + b) * 3072 + col] = s + A.b_ada[l * 3072 + col]; }
            __syncthreads();
        }
        f32x2* CS = (f32x2*)(ws + WS_CS);
        for (int e = bx * NTHR + tid; e < NTOK * 32; e += G * NTHR) { const int tok = e >> 5, i = e & 31;
            const double rev = (double)A.pos[tok] * INVF[i] * 0.15915494309189535; const double fr = rev - floor(rev); const float f = (float)fr;
            CS[e] = (f32x2){__builtin_amdgcn_cosf(f), __builtin_amdgcn_sinf(f)}; }
        __syncthreads();
        for (int it = gw; it < 2 * (3 * 256 + 512); it += NGW) { const int l = it / 1280; int r = it % 1280;
            if (r < 768) { const int br = r / 256; transpose_item<false>(A.w_br[br] + (size_t)l * 512 * 1024, 512, 1024, 1024, (bf16_t*)(ws + WS_WTBR) + ((size_t)l * 3 + br) * 1024 * 512, scr, r % 256, lane); }
            else { r -= 768; transpose_item<false>(A.w_out + (size_t)l * 1024 * 1024, 1024, 1024, 1024, (bf16_t*)(ws + WS_WTOUT) + (size_t)l * 1024 * 1024, scr, r, lane); } }
    }
    if (G0 == 0x7fffff01) grid.sync();
    { const int ln_ = lane_id_fresh(); unsigned* bp_ = barp; unsigned xc_ = xcc_id; asm volatile("" : "+s"(bp_), "+s"(xc_)); xcd_barrier(bp_, xc_, (unsigned)G0, (volatile LAS unsigned*)(lds + 147000), wid0 == 0 && ln_ == 0); }

    for (int l = 0; l < DEPTH; ++l) {
        if constexpr (PH(1)) for (int rep_ = 0; rep_ < REP_P1; ++rep_) {
            PHASE_VARS
            const float* xsrc = (l == 0) ? A.x : A.out;
            for (int it = gw; it < 16 * (NPAD / 32); it += NGW) transpose_item<true>(A.w_in + (size_t)l * 1024 * NIN, 1024, NIN, NPAD, (bf16_t*)(ws + WS_WTIN), scr, it, lane);
            bf16_t* H = (bf16_t*)(ws + WS_H); const float* gn = A.g_norm + l * 1024;
            for (int m0 = gw * 4; m0 < NTOK; m0 += NGW * 4) {
                f32x4 v[4][4]; float ss[4];
#pragma unroll
                for (int r = 0; r < 4; ++r) { const f32x4* xr = (const f32x4*)(xsrc + (size_t)(m0 + r) * 1024) + lane; ss[r] = 0.f;
#pragma unroll
                    for (int j = 0; j < 4; ++j) v[r][j] = xr[64 * j]; }
#pragma unroll
                for (int r = 0; r < 4; ++r)
#pragma unroll
                    for (int j = 0; j < 4; ++j) ss[r] += (v[r][j][0] * v[r][j][0] + v[r][j][1] * v[r][j][1]) + (v[r][j][2] * v[r][j][2] + v[r][j][3] * v[r][j][3]);
#pragma unroll
                for (int o = 1; o < 64; o <<= 1) {
#pragma unroll
                    for (int r = 0; r < 4; ++r) ss[r] += shx(ss[r], o, lane); }
                const float* mp = MOD + ((size_t)l * 8 + (m0 >> 12)) * 3072;
#pragma unroll
                for (int j = 0; j < 4; ++j) { const int col = 4 * lane + 256 * j;
                    const f32x4 gg = *(const f32x4*)(gn + col), sh = *(const f32x4*)(mp + col), scl = *(const f32x4*)(mp + 1024 + col);
                    const f32x4 gs = gg * (scl + 1.0f);
#pragma unroll
                    for (int r = 0; r < 4; ++r) { const float rstd = 1.0f / sqrtf(ss[r] * (1.0f / 1024.f) + EPS);
                        const f32x4 hv = v[r][j] * rstd * gs + sh;
                        u32x2 w; w.x = cvt_pk(hv[0], hv[1]); w.y = cvt_pk(hv[2], hv[3]);
                        *(u32x2*)(H + (size_t)(m0 + r) * 1024 + col) = w; } }
            }
        }
        { const int ln_ = lane_id_fresh(); unsigned* bp_ = barp; unsigned xc_ = xcc_id; asm volatile("" : "+s"(bp_), "+s"(xc_)); xcd_barrier(bp_, xc_, (unsigned)G0, (volatile LAS unsigned*)(lds + 147000), wid0 == 0 && ln_ == 0); }
        DBG_DUMP(1)
        if constexpr (PH(2)) {
            LOAD_ARGS
            for (int rep_ = 0; rep_ < REP_P2; ++rep_) {
            pg8::SchedStd S; S.init(ws + WS_H, ws + WS_WTIN, NTOK, 19 * 256, 1024, G, bx);
            EpiIn E{ws};
            pg8::gemm_phase<EpiIn, pg8::SchedStd>(lds, 1024, S, E, wid0);
            pg8::SchedStd S2; S2.init(ws + WS_WTIN + (size_t)31 * 256 * 1024 * 2, ws + WS_H, 1024, NTOK, 1024, G, bx);
            EpiPlain E2{(bf16_t*)(ws + WS_VT), (size_t)NTOK};
            pg8::gemm_phase<EpiPlain, pg8::SchedStd>(lds, 1024, S2, E2, wid0);
            }
        }
        { const int ln_ = lane_id_fresh(); unsigned* bp_ = barp; unsigned xc_ = xcc_id; asm volatile("" : "+s"(bp_), "+s"(xc_)); xcd_barrier(bp_, xc_, (unsigned)G0, (volatile LAS unsigned*)(lds + 147000), wid0 == 0 && ln_ == 0); }
        DBG_DUMP(2)
        if constexpr (PH(3)) for (int rep_ = 0; rep_ < REP_P3; ++rep_) {
            PHASE_VARS
            const float* MF = (const float*)(ws + WS_MISCF);
            if (bx < 64) {
                const int b = bx >> 3, h = bx & 7; const float bf = A.b_fgt[l * 8 + h];
                const float* mfp = MF + ((size_t)b * SEQ + tid * 8) * 128 + 64 + h;
                float v[8]; float run = 0.f;
#pragma unroll
                for (int i = 0; i < 8; ++i) { const float xx = mfp[(size_t)i * 128] + bf; run += -lg2(1.0f + ex2(-xx * LOG2E)); v[i] = run; }
                float incl = run;
#pragma unroll
                for (int o = 1; o < 64; o <<= 1) { const float nb = __int_as_float(__builtin_amdgcn_ds_bpermute(((lane >= o) ? (lane - o) : lane) << 2, __float_as_int(incl))); if (lane >= o) incl += nb; }
                LAS float* wt = (LAS float*)(lds + 70000);
                if (lane == 63) wt[wid] = incl;
                __syncthreads();
                float off = 0.f;
#pragma unroll
                for (int w2 = 0; w2 < 8; ++w2) { const float tv = wt[w2]; if (w2 < wid) off += tv; }
                const float excl = incl - run + off;
                float* Fo = (float*)(ws + WS_F2) + (size_t)bx * SEQ + tid * 8;
                *(f32x4*)Fo = (f32x4){v[0] + excl, v[1] + excl, v[2] + excl, v[3] + excl}; *(f32x4*)(Fo + 4) = (f32x4){v[4] + excl, v[5] + excl, v[6] + excl, v[7] + excl};
            }
            for (int blk = gw; blk < 8 * 8 * 64; blk += NGW) {
                const bf16_t* kb = (const bf16_t*)(ws + WS_KF) + (size_t)blk * 4096; float mxk = 0.f;
#pragma unroll
                for (int hf = 0; hf < 2; ++hf) { float ss = 0.f;
#pragma unroll
                    for (int d0 = 0; d0 < 4; ++d0) { const bf16x8 v = *(const bf16x8*)(kb + ((hf * 4 + d0) * 64 + lane) * 8);
#pragma unroll
                        for (int e = 0; e < 8; ++e) { const float f = bf2f((bf16_t)v[e]); ss += f * f; } }
                    ss += shx32(ss, lane); mxk = fmaxf(mxk, ss); }
#pragma unroll
                for (int o = 1; o < 32; o <<= 1) mxk = fmaxf(mxk, shx(mxk, o, lane));
                if (lane == 0) __hip_atomic_fetch_max((unsigned*)ws + 128 + l * 64 + (blk >> 6), __float_as_uint(mxk), __ATOMIC_RELAXED, __HIP_MEMORY_SCOPE_AGENT);
            }
            LAS float* Wl = (LAS float*)lds;
            { const f32x4* wsrc = (const f32x4*)(A.w_kv_up + (size_t)l * 128 * 128);
#pragma unroll
              for (int i = 0; i < 8; ++i) ((LAS f32x4*)Wl)[tid + i * NTHR] = wsrc[tid + i * NTHR]; }
            __syncthreads();
            const bf16_t* DC = (const bf16_t*)(ws + WS_DCKV); const f32x2* CS = (const f32x2*)(ws + WS_CS);
            bf16_t* DK = (bf16_t*)(ws + WS_DK); bf16_t* DV = (bf16_t*)(ws + WS_DV); bf16_t* IKo = (bf16_t*)(ws + WS_IK);
            const float gk0 = A.g_kv[l * 128 + lane], gk1 = A.g_kv[l * 128 + 64 + lane];
            for (int t4 = gw; t4 < NTOK / 4; t4 += NGW) {
                float n0[4], n1[4], a0[4], a1[4];
#pragma unroll
                for (int q = 0; q < 4; ++q) { const size_t tok = (size_t)t4 * 4 + q; const float x0 = bf2f(DC[tok * 128 + lane]), x1 = bf2f(DC[tok * 128 + 64 + lane]);
                    const float rstd = 1.0f / sqrtf(wave_sum(x0 * x0 + x1 * x1, lane) * (1.0f / 128.f) + EPS);
                    n0[q] = x0 * rstd * gk0; n1[q] = x1 * rstd * gk1; a0[q] = 0.f; a1[q] = 0.f; }
#pragma unroll 4
                for (int k = 0; k < 64; ++k) { const float w0 = Wl[k * 128 + lane], w1 = Wl[k * 128 + 64 + lane];
#pragma unroll
                    for (int q = 0; q < 4; ++q) { const float nk = __builtin_bit_cast(float, __builtin_amdgcn_readlane(__builtin_bit_cast(int, n0[q]), k)); a0[q] += nk * w0; a1[q] += nk * w1; } }
#pragma unroll 4
                for (int k = 0; k < 64; ++k) { const float w0 = Wl[(64 + k) * 128 + lane], w1 = Wl[(64 + k) * 128 + 64 + lane];
#pragma unroll
                    for (int q = 0; q < 4; ++q) { const float nk = __builtin_bit_cast(float, __builtin_amdgcn_readlane(__builtin_bit_cast(int, n1[q]), k)); a0[q] += nk * w0; a1[q] += nk * w1; } }
#pragma unroll
                for (int q = 0; q < 4; ++q) { const size_t tok = (size_t)t4 * 4 + q; const f32x2 cs = CS[tok * 32 + (lane & 31)];
                    const float pk = shx32(a0[q], lane);
                    const float kr = (lane < 32) ? (a0[q] * cs[0] - pk * cs[1]) : (a0[q] * cs[0] + pk * cs[1]);
                    DK[tok * 64 + lane] = (bf16_t)(cvt_pk(kr, 0.f) & 0xffffu); DV[tok * 64 + lane] = (bf16_t)(cvt_pk(a1[q], 0.f) & 0xffffu);
                    const float xi = MF[tok * 128 + lane]; const float pi = shx32(xi, lane);
                    const float ir = (lane < 32) ? (xi * cs[0] - pi * cs[1]) : (xi * cs[0] + pi * cs[1]);
                    IKo[(((tok >> 5) * 4 + (lane >> 4)) * 64 + ((lane >> 3) & 1) * 32 + (tok & 31)) * 8 + (lane & 7)] = (bf16_t)(cvt_pk(ir, 0.f) & 0xffffu); }
            }
            __syncthreads();
        }
        { const int ln_ = lane_id_fresh(); unsigned* bp_ = barp; unsigned xc_ = xcc_id; asm volatile("" : "+s"(bp_), "+s"(xc_)); xcd_barrier(bp_, xc_, (unsigned)G0, (volatile LAS unsigned*)(lds + 147000), wid0 == 0 && ln_ == 0); }
        DBG_DUMP(3)
        if constexpr (PH(4) || PH(8) || PH(9)) {
            PHASE_VARS
            const int b = bx & 7, w = bx >> 3, GW = (G + 7) >> 3;
            if constexpr (PH(4) && (DBG != 42 && DBG != 43)) for (int rep_ = 0; rep_ < REP_FOX; ++rep_) for (int u = w; u < 128; u += GW) { const int qb = u >> 3, h = (u + 2 * (u / GW)) & 7; const bool st_ = (rep_ == REP_FOX - 1) || (G0 == 0x7fffff01);
                attn_fs_wave<false>((const bf16_t*)(ws + WS_QF), (const bf16_t*)(ws + WS_KF), (const bf16_t*)(ws + WS_VT), (const float*)(ws + WS_F2), (const bf16_t*)(ws + WS_GF), (bf16_t*)(ws + WS_QF), b, h, qb * 256 + wid * 32, lane, st_, (const unsigned*)ws + 128 + l * 64); }
            if constexpr (PH(8) && (DBG != 41 && DBG != 43)) for (int rep_ = 0; rep_ < REP_SB; ++rep_) for (int u = w; u < 128; u += GW) { const int qb = u >> 3, h = (u + 2 * (u / GW)) & 7; const bool st_ = (rep_ == REP_SB - 1) || (G0 == 0x7fffff01);
                attn_fs_wave<true>((const bf16_t*)(ws + WS_QS), (const bf16_t*)(ws + WS_KS), (const bf16_t*)(ws + WS_VT) + (size_t)512 * NTOK, nullptr, (const bf16_t*)(ws + WS_GS), (bf16_t*)(ws + WS_QS), b, h, qb * 256 + wid * 32, lane, st_, nullptr); }
            __syncthreads();
            if constexpr (PH(9) && (DBG != 41 && DBG != 42)) {
                unsigned* qcnt = (unsigned*)ws + 256 + l * 8 + b; LAS int* ubox = (LAS int*)(lds + 147008);
                for (;;) {
                    if (tid == 0) *ubox = (int)__hip_atomic_fetch_add(qcnt, 1u, __ATOMIC_RELAXED, __HIP_MEMORY_SCOPE_AGENT);
                    __syncthreads();
                    const int k = *ubox;
                    if (k >= 512) break;
                    dsa_unit(lds, ws, b, (511 - k) * 8, wid, lane, true);
                }
            }
        }
        { const int ln_ = lane_id_fresh(); unsigned* bp_ = barp; unsigned xc_ = xcc_id; asm volatile("" : "+s"(bp_), "+s"(xc_)); xcd_barrier(bp_, xc_, (unsigned)G0, (volatile LAS unsigned*)(lds + 147000), wid0 == 0 && ln_ == 0); }
        DBG_DUMP(4)
        if constexpr (PH(5)) for (int rep_ = 0; rep_ < REP_P5A; ++rep_) {
            LOAD_ARGS
            pg8::SchedStd S; S.init(ws + WS_H, ws + WS_WTIN + (size_t)19 * 256 * 1024 * 2, NTOK, 3072, 1024, G, bx);
            EpiMerge E{(bf16_t*)(ws + WS_M3)};
            pg8::gemm_phase<EpiMerge, pg8::SchedStd>(lds, 1024, S, E, wid0);
        }
        { const int ln_ = lane_id_fresh(); unsigned* bp_ = barp; unsigned xc_ = xcc_id; asm volatile("" : "+s"(bp_), "+s"(xc_)); xcd_barrier(bp_, xc_, (unsigned)G0, (volatile LAS unsigned*)(lds + 147000), wid0 == 0 && ln_ == 0); }
        DBG_DUMP(5)
        if constexpr (PH(6)) for (int rep_ = 0; rep_ < REP_P5B; ++rep_) {
            LOAD_ARGS
            pg8::SchedMix S{(const char*)(ws + WS_QF), (const char*)(ws + WS_WTBR) + (size_t)l * 3 * 1024 * 512 * 2, G, bx};
            EpiMix E{(const bf16_t*)(ws + WS_M3), (bf16_t*)(ws + WS_MIX)};
            pg8::gemm_phase<EpiMix, pg8::SchedMix>(lds, 512, S, E, wid0);
        }
        { const int ln_ = lane_id_fresh(); unsigned* bp_ = barp; unsigned xc_ = xcc_id; asm volatile("" : "+s"(bp_), "+s"(xc_)); xcd_barrier(bp_, xc_, (unsigned)G0, (volatile LAS unsigned*)(lds + 147000), wid0 == 0 && ln_ == 0); }
        DBG_DUMP(6)
        if constexpr (PH(7)) for (int rep_ = 0; rep_ < (l == 0 ? REP_P6 : 1); ++rep_) {
            LOAD_ARGS
            const float* xsrc = (l == 0) ? A.x : A.out;
            pg8::SchedStd S; S.init(ws + WS_MIX, ws + WS_WTOUT + (size_t)l * 1024 * 1024 * 2, NTOK, 1024, 1024, G, bx);
            EpiOut E{xsrc, A.out, MOD + (size_t)l * 8 * 3072 + 2048};
            pg8::gemm_phase<EpiOut, pg8::SchedStd>(lds, 1024, S, E, wid0);
        }
        { const int ln_ = lane_id_fresh(); unsigned* bp_ = barp; unsigned xc_ = xcc_id; asm volatile("" : "+s"(bp_), "+s"(xc_)); xcd_barrier(bp_, xc_, (unsigned)G0, (volatile LAS unsigned*)(lds + 147000), wid0 == 0 && ln_ == 0); }
        DBG_DUMP(7)
        for (int rb_ = 1; rb_ < REP_BAR; ++rb_) { const int ln_ = lane_id_fresh(); unsigned* bp_ = barp; unsigned xc_ = xcc_id; asm volatile("" : "+s"(bp_), "+s"(xc_)); xcd_barrier(bp_, xc_, (unsigned)G0, (volatile LAS unsigned*)(lds + 147000), wid0 == 0 && ln_ == 0); }
    }
    PHASE_VARS
    for (int rep_ = 0; rep_ < REP_FIN; ++rep_)
    for (int m0 = gw * 4; m0 < NTOK; m0 += NGW * 4) {
        f32x4 v[4][4]; float ss[4];
#pragma unroll
        for (int r = 0; r < 4; ++r) { const f32x4* xr = (const f32x4*)(A.out + (size_t)(m0 + r) * 1024) + lane; ss[r] = 0.f;
#pragma unroll
            for (int j = 0; j < 4; ++j) v[r][j] = xr[64 * j]; }
        f32x4 gg[4];
#pragma unroll
        for (int j = 0; j < 4; ++j) gg[j] = *(const f32x4*)(A.g_final + 4 * lane + 256 * j);
#pragma unroll
        for (int r = 0; r < 4; ++r)
#pragma unroll
            for (int j = 0; j < 4; ++j) ss[r] += (v[r][j][0] * v[r][j][0] + v[r][j][1] * v[r][j][1]) + (v[r][j][2] * v[r][j][2] + v[r][j][3] * v[r][j][3]);
#pragma unroll
        for (int o = 1; o < 64; o <<= 1) {
#pragma unroll
            for (int r = 0; r < 4; ++r) ss[r] += shx(ss[r], o, lane); }
#pragma unroll
        for (int r = 0; r < 4; ++r) { const float rstd = 1.0f / sqrtf(ss[r] * (1.0f / 1024.f) + EPS); f32x4* xo = (f32x4*)(A.out + (size_t)(m0 + r) * 1024) + lane;
#pragma unroll
            for (int j = 0; j < 4; ++j) { if (rep_ == REP_FIN - 1 || G0 == 0x7fffff01) xo[64 * j] = v[r][j] * rstd * gg[j]; } }
    }
}

#undef A
extern "C" void kernel_launch(void* const* d_in, const int* in_sizes, int n_in, void* d_out, int out_size, void* d_ws, size_t ws_size, hipStream_t stream) {
    static int grid = 0;
    if (grid == 0) {
        if (n_in != 15 || ws_size < WS_END) { fprintf(stderr, "kernel_launch: unexpected n_in %d / ws %zu\n", n_in, ws_size); grid = -1; return; }
        int dev = 0, cus = 0, per_cu = 0;
        hipGetDevice(&dev);
        hipDeviceGetAttribute(&cus, hipDeviceAttributeMultiprocessorCount, dev);
        hipFuncSetAttribute((const void*)fwd_megakernel, hipFuncAttributeMaxDynamicSharedMemorySize, LDS_BYTES);
        hipOccupancyMaxActiveBlocksPerMultiprocessor(&per_cu, (const void*)fwd_megakernel, NTHR, LDS_BYTES);
        if (per_cu < 1) per_cu = 1;
        grid = cus * per_cu;
    }
    if (grid < 0) return;
    Args a{};
    a.x = (const float*)d_in[0]; a.c = (const float*)d_in[1]; a.pos = (const int*)d_in[2]; a.w_ada = (const float*)d_in[3]; a.b_ada = (const float*)d_in[4];
    a.g_norm = (const float*)d_in[5]; a.w_in = (const float*)d_in[6]; a.b_fgt = (const float*)d_in[7]; a.g_kv = (const float*)d_in[8]; a.w_kv_up = (const float*)d_in[9];
    a.w_br[0] = (const float*)d_in[10]; a.w_br[1] = (const float*)d_in[11]; a.w_br[2] = (const float*)d_in[12]; a.w_out = (const float*)d_in[13]; a.g_final = (const float*)d_in[14];
    a.out = (float*)d_out; a.ws = (unsigned char*)d_ws;
    hipMemsetAsync(d_ws, 0, 32768, stream);
    void* args[] = {&a};
    hipError_t e = hipLaunchCooperativeKernel((const void*)fwd_megakernel, dim3(grid), dim3(NTHR), args, LDS_BYTES, stream);
    if (e != hipSuccess) fprintf(stderr, "cooperative launch failed: %s (grid %d)\n", hipGetErrorString(e), grid);
}
```

```cpp
#include <hip/hip_runtime.h>
#include <hip/hip_cooperative_groups.h>
#include <cstdio>
#include <cstdint>
namespace cg = cooperative_groups;
#ifndef REP_DA
#define REP_DA 1
#endif
#ifndef REP_DB
#define REP_DB 1
#endif
#ifndef REP_DC
#define REP_DC 1
#endif

#define LAS __attribute__((address_space(3)))
typedef unsigned short bf16_t;
typedef short bf16x8 __attribute__((ext_vector_type(8)));
typedef short bf16x4 __attribute__((ext_vector_type(4)));
typedef float f32x4 __attribute__((ext_vector_type(4)));
typedef float f32x2 __attribute__((ext_vector_type(2)));
typedef float f32x16 __attribute__((ext_vector_type(16)));
typedef unsigned u32x4 __attribute__((ext_vector_type(4)));
typedef unsigned u32x2 __attribute__((ext_vector_type(2)));

constexpr int DM = 1024, NB = 8, SEQ = 4096, NTOK = NB * SEQ, DEPTH = 2;
constexpr int NIN = 8912, NPAD = 8960;
constexpr float LOG2E = 1.4426950408889634f;
constexpr float C2 = 0.125f * LOG2E;
constexpr float EPS = 1e-6f;
constexpr int NWAVES = 8, NTHR = 512;
constexpr int LDS_BYTES = 147456;

constexpr size_t MiB = 1u << 20;
constexpr size_t WS_MOD = 1 * MiB;
constexpr size_t WS_F2 = 2 * MiB;
constexpr size_t WS_CS = 8 * MiB;
constexpr size_t WS_WTBR = 16 * MiB;
constexpr size_t WS_WTOUT = 22 * MiB;
constexpr size_t WS_WTIN = 28 * MiB;
constexpr size_t WS_H = 46 * MiB;
constexpr size_t WS_QF = 110 * MiB;
constexpr size_t WS_QD = 142 * MiB;
constexpr size_t WS_QS = 174 * MiB;
constexpr size_t WS_GF = 206 * MiB;
constexpr size_t WS_GD = 238 * MiB;
constexpr size_t WS_GS = 270 * MiB;
constexpr size_t WS_MIX = 206 * MiB;
constexpr size_t WS_KF = 302 * MiB;
constexpr size_t WS_KS = 334 * MiB;
constexpr size_t WS_VT = 366 * MiB;
constexpr size_t WS_IQ = 430 * MiB;
constexpr size_t WS_DCKV = 462 * MiB;
constexpr size_t WS_MISCF = 470 * MiB;
constexpr size_t WS_DK = 486 * MiB;
constexpr size_t WS_DV = 490 * MiB;
constexpr size_t WS_M3 = 302 * MiB;
constexpr size_t WS_IK = 494 * MiB;
constexpr size_t WS_END = 498 * MiB;

__device__ const double INVF[32] = {1.0, 0.7498942093324559, 0.5623413251903491, 0.4216965034285822, 0.31622776601683794, 0.23713737056616552, 0.1778279410038923, 0.1333521432163324, 0.1, 0.07498942093324558, 0.05623413251903491, 0.042169650342858224, 0.03162277660168379, 0.023713737056616554, 0.01778279410038923, 0.01333521432163324, 0.01, 0.007498942093324558, 0.005623413251903491, 0.004216965034285823, 0.0031622776601683794, 0.0023713737056616554, 0.0017782794100389228, 0.001333521432163324, 0.001, 0.0007498942093324559, 0.0005623413251903491, 0.00042169650342858224, 0.00031622776601683794, 0.00023713737056616554, 0.00017782794100389227, 0.0001333521432163324};

typedef __bf16 bf16x2_t __attribute__((ext_vector_type(2)));
__device__ __forceinline__ unsigned cvt_pk(float lo, float hi) { f32x2 v = {lo, hi}; bf16x2_t b = __builtin_convertvector(v, bf16x2_t); return __builtin_bit_cast(unsigned, b); }
__device__ __forceinline__ float bf2f(bf16_t v) { return __uint_as_float((unsigned)v << 16); }
__device__ __forceinline__ float bflo(unsigned w) { return __uint_as_float(w << 16); }
__device__ __forceinline__ float bfhi(unsigned w) { return __uint_as_float(w & 0xffff0000u); }
__device__ __forceinline__ float ex2(float x) { return __builtin_amdgcn_exp2f(x); }
__device__ __forceinline__ float lg2(float x) { return __builtin_amdgcn_logf(x); }
__device__ __forceinline__ float sigmoidf_(float x) { return __builtin_amdgcn_rcpf(1.0f + ex2(-x * LOG2E)); }
__device__ __forceinline__ int lane_id_fresh() { unsigned ones = ~0u; asm volatile("" : "+s"(ones)); return __builtin_amdgcn_mbcnt_hi(ones, __builtin_amdgcn_mbcnt_lo(ones, 0u)); }
__device__ __forceinline__ float shx(float v, int o, int lane) { return __int_as_float(__builtin_amdgcn_ds_bpermute((lane ^ o) << 2, __float_as_int(v))); }
__device__ __forceinline__ float shx32(float v, int lane) {
    const auto rr = __builtin_amdgcn_permlane32_swap(__float_as_uint(v), __float_as_uint(v), false, false);
    return __uint_as_float((lane & 32) ? rr[0] : rr[1]);
}
__device__ __forceinline__ float wave_sum(float v, int lane) {
#pragma unroll
    for (int o = 1; o < 64; o <<= 1) v += shx(v, o, lane);
    return v;
}
__device__ __forceinline__ int crow(int r, int hi) { return (r & 3) + 8 * (r >> 2) + 4 * hi; }
__device__ __forceinline__ f32x16 mfma32(bf16x8 a, bf16x8 b, f32x16 c) { return __builtin_amdgcn_mfma_f32_32x32x16_bf16(a, b, c, 0, 0, 0); }
__device__ __forceinline__ f32x4 mfma16(bf16x8 a, bf16x8 b, f32x4 c) { return __builtin_amdgcn_mfma_f32_16x16x32_bf16(a, b, c, 0, 0, 0); }
__device__ __forceinline__ bf16x8 pack8(float a0, float a1, float a2, float a3, float a4, float a5, float a6, float a7) {
    u32x4 w; w.x = cvt_pk(a0, a1); w.y = cvt_pk(a2, a3); w.z = cvt_pk(a4, a5); w.w = cvt_pk(a6, a7); return __builtin_bit_cast(bf16x8, w);
}
__device__ __forceinline__ int mbcnt64(unsigned long long m) { return __builtin_amdgcn_mbcnt_hi((unsigned)(m >> 32), __builtin_amdgcn_mbcnt_lo((unsigned)m, 0u)); }

namespace pg8 {
constexpr int BM = 256, BK = 64, HALF = 128, HTB = HALF * BK * 2, STAGE_BYTES = 8 * HTB, NXCD = 8, WGM = 8;
__device__ __forceinline__ int lds_byte(int r, int c) { const int st = (r >> 4) * 2 + (c >> 5), rr = r & 15, cc = c & 31, ob = rr * 64 + cc * 2; return st * 1024 + (ob ^ (((ob >> 9) & 1) << 5)); }
__device__ __forceinline__ void stage_rc(int b, int& R, int& C) { const int st = b / 1024, sb = b % 1024, swz = sb ^ (((sb >> 9) & 1) << 5); R = (st >> 1) * 16 + swz / 64; C = (st & 1) * 32 + (swz % 64) / 2; }
__device__ __forceinline__ int perm32(int rho) { const int n = rho >> 4, i = rho & 15; return 8 * (i >> 2) + 4 * n + (i & 3); }
struct Unit { int pm, pn, aux; };

struct StaticOrder {
    int nM, nN, nwg, G, c;
    __device__ void init(int M, int N, int G_, int c_) { nM = M / BM; nN = N / BM; nwg = nM * nN; G = G_; c = c_; }
    __device__ bool next(int i, Unit& u) const {
        const long L = (long)i * G + c; if (L >= nwg) return false;
        int wgid = (int)L; { const int q = nwg / NXCD, r = nwg % NXCD, xcd = wgid % NXCD, off = wgid / NXCD; wgid = (xcd < r ? xcd * (q + 1) : r * (q + 1) + (xcd - r) * q) + off; }
        const int nig = WGM * nN, gid = wgid / nig, fm = gid * WGM, gsz = (nM - fm) < WGM ? (nM - fm) : WGM;
        u.pm = fm + ((wgid % nig) % gsz); u.pn = (wgid % nig) / gsz; u.aux = 0; return true;
    }
};
struct SchedStd {
    const char* A; const char* B; size_t tstep; StaticOrder so;
    __device__ void init(const void* A_, const void* B_, int M, int N, int K, int G, int c) { A = (const char*)A_; B = (const char*)B_; tstep = (size_t)BM * K * 2; so.init(M, N, G, c); }
    __device__ __forceinline__ bool next(int i, Unit& u) const { return so.next(i, u); }
    __device__ __forceinline__ const char* a_base(const Unit& u) const { return A + (size_t)u.pm * tstep; }
    __device__ __forceinline__ const char* b_base(const Unit& u) const { return B + (size_t)u.pn * tstep; }
};
struct SchedMix {
    const char* Y; const char* W; int G, c;
    __device__ __forceinline__ bool next(int i, Unit& u) const { const int tl = c + G * (i / 3); if (tl >= 512) return false; u.pm = tl >> 2; u.pn = tl & 3; u.aux = i % 3; return true; }
    __device__ __forceinline__ const char* a_base(const Unit& u) const { return Y + (size_t)u.aux * (32 * MiB) + (size_t)u.pm * (256 * 512 * 2); }
    __device__ __forceinline__ const char* b_base(const Unit& u) const { return W + (size_t)u.aux * (1024 * 512 * 2) + (size_t)u.pn * (256 * 512 * 2); }
};

template <class Epi, class Sched>
__device__ __forceinline__ void gemm_phase(LAS unsigned char* lds, const int K, const Sched& S, const Epi& E, const int wid) {
    int lane = lane_id_fresh(); asm volatile("" : "+v"(lane));
    const int tid = wid * 64 + lane, wr = wid >> 2, wc = wid & 3, fr = lane & 15, fq = lane >> 4;
    const int nt = K / BK;
    unsigned voffA[2], voffB[2];
#pragma unroll
    for (int i = 0; i < 2; ++i) { int R, C; stage_rc(tid * 16 + i * 8192, R, C); const int Rb = (R & ~31) + perm32(R & 31);
        voffA[i] = (unsigned)(R * K + C) * 2u; voffB[i] = (unsigned)(Rb * K + C) * 2u; }
    const size_t kstep = (size_t)(BK * 2);
    const size_t hstep = (size_t)HALF * K * 2;
    const unsigned ldsw = (unsigned)wid * 1024u;
    const int aoff = lds_byte(wr * 64 + fr, fq * 8), boff = lds_byte(wc * 32 + fr, fq * 8);
#define PG8_SA(b, h) (((b) * 2 + (h)) * HTB)
#define PG8_SB(b, h) ((4 + (b) * 2 + (h)) * HTB)
#define PG8_STAGE(bufoff, gbase, voff) do { _Pragma("unroll") for (int _i = 0; _i < 2; ++_i) \
        __builtin_amdgcn_global_load_lds((const unsigned*)((const char*)(gbase) + (voff)[_i]), (LAS unsigned*)(lds + (bufoff) + ldsw + _i * 8192), 16, 0, 0); } while (0)
#define PG8_LDA(dst, b, h) do { _Pragma("unroll") for (int m = 0; m < 4; ++m) _Pragma("unroll") for (int k = 0; k < 2; ++k) dst[m][k] = *(const LAS bf16x8*)(lds + PG8_SA(b, h) + aoff + m * 2048 + k * 1024); } while (0)
#define PG8_LDB(dst, b, h) do { _Pragma("unroll") for (int n = 0; n < 2; ++n) _Pragma("unroll") for (int k = 0; k < 2; ++k) dst[n][k] = *(const LAS bf16x8*)(lds + PG8_SB(b, h) + boff + n * 2048 + k * 1024); } while (0)
#define PG8_MMA(ai, bj, At, Bt) do { __builtin_amdgcn_s_setprio(1); _Pragma("unroll") for (int m = 0; m < 4; ++m) _Pragma("unroll") for (int n = 0; n < 2; ++n) _Pragma("unroll") for (int k = 0; k < 2; ++k) \
        acc[ai][bj][m][n] = __builtin_amdgcn_mfma_f32_16x16x32_bf16(Bt[n][k], At[m][k], acc[ai][bj][m][n], 0, 0, 0); __builtin_amdgcn_s_setprio(0); } while (0)
#define PG8_WAIT_V(n) asm volatile("s_waitcnt vmcnt(" #n ")" ::: "memory")
#define PG8_WAIT_L(n) asm volatile("s_waitcnt lgkmcnt(" #n ")" ::: "memory")
#define PG8_BAR __builtin_amdgcn_s_barrier()
#define PG8_SCHED __builtin_amdgcn_sched_barrier(0)
    Unit cur, nxt; int ui = 0;
    if (!S.next(0, cur)) return;
    f32x4 acc[2][2][4][2];
#pragma unroll
    for (int a = 0; a < 2; ++a)
#pragma unroll
        for (int b = 0; b < 2; ++b)
#pragma unroll
            for (int m = 0; m < 4; ++m)
#pragma unroll
                for (int n = 0; n < 2; ++n) acc[a][b][m][n] = (f32x4){0.f, 0.f, 0.f, 0.f};
    bf16x8 At[4][2], B0[2][2], B1[2][2];
    const char* cA = S.a_base(cur); const char* cB = S.b_base(cur);
    PG8_STAGE(PG8_SB(0, 0), cB, voffB); PG8_STAGE(PG8_SB(0, 1), cB + hstep, voffB); PG8_STAGE(PG8_SA(0, 0), cA, voffA); PG8_STAGE(PG8_SA(0, 1), cA + hstep, voffA);
    if (wr == 1) PG8_BAR;
    PG8_WAIT_V(2); PG8_BAR;
    PG8_STAGE(PG8_SB(1, 0), cB + kstep, voffB); PG8_STAGE(PG8_SA(1, 0), cA + kstep, voffA); PG8_STAGE(PG8_SB(1, 1), cB + hstep + kstep, voffB);
    PG8_WAIT_V(6); PG8_BAR;
    for (;;) {
        const bool has_next = S.next(ui + 1, nxt);
        const char* nA = has_next ? S.a_base(nxt) : cA; const char* nB = has_next ? S.b_base(nxt) : cB;
        for (int t = 0; t < nt; t += 2) {
            const bool last = (t == nt - 2);
            const char* a1 = cA + (size_t)(t + 1) * kstep;
            const char* a2 = last ? nA : cA + (size_t)(t + 2) * kstep; const char* b2 = last ? nB : cB + (size_t)(t + 2) * kstep;
            const char* a3 = a2 + kstep; const char* b3 = b2 + kstep;
            PG8_LDB(B0, 0, 0); PG8_LDB(B1, 0, 1); PG8_SCHED; PG8_LDA(At, 0, 0); PG8_STAGE(PG8_SA(1, 1), a1 + hstep, voffA);
            PG8_WAIT_V(8); PG8_WAIT_L(0); PG8_BAR; PG8_MMA(0, 0, At, B0); PG8_MMA(0, 1, At, B1); PG8_BAR; PG8_SCHED;
            PG8_LDA(At, 0, 1); PG8_STAGE(PG8_SB(0, 0), b2, voffB); PG8_STAGE(PG8_SB(0, 1), b2 + hstep, voffB); PG8_STAGE(PG8_SA(0, 0), a2, voffA);
            PG8_WAIT_V(8); PG8_WAIT_L(0); PG8_BAR; PG8_MMA(1, 0, At, B0); PG8_MMA(1, 1, At, B1); PG8_BAR; PG8_SCHED;
            PG8_LDB(B0, 1, 0); PG8_LDB(B1, 1, 1); PG8_SCHED; PG8_LDA(At, 1, 0); PG8_STAGE(PG8_SA(0, 1), a2 + hstep, voffA);
            PG8_WAIT_V(8); PG8_WAIT_L(0); PG8_BAR; PG8_MMA(0, 0, At, B0); PG8_MMA(0, 1, At, B1); PG8_BAR; PG8_SCHED;
            PG8_LDA(At, 1, 1); PG8_STAGE(PG8_SB(1, 0), b3, voffB); PG8_STAGE(PG8_SB(1, 1), b3 + hstep, voffB); PG8_STAGE(PG8_SA(1, 0), a3, voffA);
            PG8_WAIT_V(8); PG8_WAIT_L(0); PG8_BAR; PG8_MMA(1, 0, At, B0); PG8_MMA(1, 1, At, B1); PG8_BAR; PG8_SCHED;
        }
        if (wr == 0) PG8_BAR;
        E(acc, cur, wr, wc, fr, fq);
        if (!has_next) break;
#pragma unroll
        for (int a = 0; a < 2; ++a)
#pragma unroll
            for (int b = 0; b < 2; ++b)
#pragma unroll
                for (int m = 0; m < 4; ++m)
#pragma unroll
                    for (int n = 0; n < 2; ++n) acc[a][b][m][n] = (f32x4){0.f, 0.f, 0.f, 0.f};
        cur = nxt; cA = nA; cB = nB; ++ui;
        if (wr == 1) PG8_BAR;
    }
    PG8_WAIT_V(0);
    PG8_BAR;
#undef PG8_SA
#undef PG8_SB
#undef PG8_STAGE
#undef PG8_LDA
#undef PG8_LDB
#undef PG8_MMA
#undef PG8_WAIT_V
#undef PG8_WAIT_L
#undef PG8_BAR
#undef PG8_SCHED
}
}
using pg8::Unit;

__device__ __forceinline__ u32x4 pack_f8(const f32x4& v0, const f32x4& v1) { u32x4 w; w.x = cvt_pk(v0[0], v0[1]); w.y = cvt_pk(v0[2], v0[3]); w.z = cvt_pk(v1[0], v1[1]); w.w = cvt_pk(v1[2], v1[3]); return w; }

struct EpiIn {
    unsigned char* ws;
    __device__ __forceinline__ void operator()(const f32x4 (&acc)[2][2][4][2], const Unit& u, int wr, int wc, int fr, int fq) const {
        const int pn = u.pn; const int row0 = u.pm * 256 + wr * 64 + fr;
        if (pn == 18) {
            bf16_t* dc = (bf16_t*)(ws + WS_DCKV); float* mf = (float*)(ws + WS_MISCF);
            const int col = wc * 32 + 8 * fq;
#pragma unroll
            for (int ai = 0; ai < 2; ++ai)
#pragma unroll
                for (int m = 0; m < 4; ++m) { const size_t row = (size_t)(row0 + ai * 128 + m * 16);
                    *(u32x4*)(dc + row * 128 + col) = pack_f8(acc[ai][0][m][0], acc[ai][0][m][1]);
                    *(f32x4*)(mf + row * 128 + col) = acc[ai][1][m][0]; *(f32x4*)(mf + row * 128 + col + 4) = acc[ai][1][m][1]; asm volatile("" ::: "memory"); }
            return;
        }
        const int grp = pn >> 1, half = pn & 1;
        size_t boff; int mode = 0; float sc = 1.f;
        switch (grp) {
            case 0: boff = WS_QF; sc = C2; break;
            case 1: boff = WS_KF; mode = 3; break;
            case 2: boff = WS_GF; mode = 1; break;
            case 3: boff = WS_QD; mode = 2; sc = C2; break;
            case 4: boff = WS_IQ; mode = 2; break;
            case 5: boff = WS_GD; mode = 1; break;
            case 6: boff = WS_QS; sc = C2; break;
            case 7: boff = WS_KS; mode = 3; break;
            default: boff = WS_GS; mode = 1; break;
        }
        bf16_t* base = (bf16_t*)(ws + boff);
        if (mode == 2) {
            const f32x4* cs = (const f32x4*)(ws + WS_CS);
            const int head = half * 4 + wc, i0 = 8 * fq;
#pragma unroll
            for (int ai = 0; ai < 2; ++ai)
#pragma unroll
                for (int m = 0; m < 4; ++m) { const size_t row = (size_t)(row0 + ai * 128 + m * 16);
                    const f32x4* cp = cs + (row * 32 + i0) / 2;
                    f32x4 y1[2], y2[2];
#pragma unroll
                    for (int n = 0; n < 2; ++n) { const f32x4 ca = cp[2 * n], cb = cp[2 * n + 1];
                        const f32x4 x1 = acc[ai][0][m][n], x2 = acc[ai][1][m][n];
                        y1[n][0] = (x1[0] * ca[0] - x2[0] * ca[1]) * sc; y2[n][0] = (x2[0] * ca[0] + x1[0] * ca[1]) * sc;
                        y1[n][1] = (x1[1] * ca[2] - x2[1] * ca[3]) * sc; y2[n][1] = (x2[1] * ca[2] + x1[1] * ca[3]) * sc;
                        y1[n][2] = (x1[2] * cb[0] - x2[2] * cb[1]) * sc; y2[n][2] = (x2[2] * cb[0] + x1[2] * cb[1]) * sc;
                        y1[n][3] = (x1[3] * cb[2] - x2[3] * cb[3]) * sc; y2[n][3] = (x2[3] * cb[2] + x1[3] * cb[3]) * sc; }
                    bf16_t* rp = base + row * 512 + head * 64 + i0;
                    *(u32x4*)rp = pack_f8(y1[0], y1[1]); *(u32x4*)(rp + 32) = pack_f8(y2[0], y2[1]); if (m & 1) asm volatile("" ::: "memory"); }
            return;
        }
        if (mode == 3) {
#pragma unroll
            for (int ai = 0; ai < 2; ++ai)
#pragma unroll
                for (int m = 0; m < 4; ++m) { const int tok = row0 + ai * 128 + m * 16; const int b = tok >> 12, sq = tok & 4095, kv = sq & 63;
#pragma unroll
                    for (int bj = 0; bj < 2; ++bj) { const int head = half * 4 + bj * 2 + (wc >> 1), d0 = (wc & 1) * 2 + (fq >> 1);
                        bf16_t* bp = base + (((size_t)(b * 8 + head) * 64 + (sq >> 6)) * 4096) + (((kv >> 5) * 4 + d0) * 64 + (fq & 1) * 32 + (kv & 31)) * 8;
                        *(u32x4*)bp = pack_f8(acc[ai][bj][m][0], acc[ai][bj][m][1]); }
                    asm volatile("" ::: "memory"); }
            return;
        }
        const int col0 = half * 256 + wc * 32 + 8 * fq;
#pragma unroll
        for (int ai = 0; ai < 2; ++ai)
#pragma unroll
            for (int m = 0; m < 4; ++m) { bf16_t* rowp = base + (size_t)(row0 + ai * 128 + m * 16) * 512 + col0;
#pragma unroll
                for (int bj = 0; bj < 2; ++bj) { f32x4 v0 = acc[ai][bj][m][0], v1 = acc[ai][bj][m][1];
                    if (mode == 1) {
#pragma unroll
                        for (int e = 0; e < 4; ++e) { v0[e] = v0[e] * sigmoidf_(v0[e]); v1[e] = v1[e] * sigmoidf_(v1[e]); } }
                    else { v0 = v0 * sc; v1 = v1 * sc; }
                    *(u32x4*)(rowp + bj * 128) = pack_f8(v0, v1); asm volatile("" ::: "memory"); } }
    }
};
struct EpiPlain {
    bf16_t* O; size_t ldc;
    __device__ __forceinline__ void operator()(const f32x4 (&acc)[2][2][4][2], const Unit& u, int wr, int wc, int fr, int fq) const {
        const int row0 = u.pm * 256 + wr * 64 + fr, col0 = u.pn * 256 + wc * 32 + 8 * fq;
#pragma unroll
        for (int ai = 0; ai < 2; ++ai)
#pragma unroll
            for (int m = 0; m < 4; ++m) { const int r = row0 + ai * 128 + m * 16; const int hb = r >> 6, d = r & 63;
#pragma unroll
                for (int bj = 0; bj < 2; ++bj) { const int tok = col0 + bj * 128; const int b = tok >> 12, sq = tok & 4095, j = sq >> 6, kv0 = sq & 63;
                    bf16_t* bp = O + (((size_t)(hb * 8 + b) * 64 + j) * 4096) + (((kv0 >> 4) * 2 + (d >> 5)) * 64 + (d & 31)) * 8 + ((kv0 & 8) >> 1);
                    const u32x4 w = pack_f8(acc[ai][bj][m][0], acc[ai][bj][m][1]);
                    *(u32x2*)bp = (u32x2){w.x, w.y}; *(u32x2*)(bp + 32 * 8) = (u32x2){w.z, w.w}; }
                asm volatile("" ::: "memory"); }
    }
};
struct EpiMerge {
    bf16_t* O;
    __device__ __forceinline__ void operator()(const f32x4 (&acc)[2][2][4][2], const Unit& u, int wr, int wc, int fr, int fq) const {
        const int row0 = u.pm * 256 + wr * 64 + fr, col0 = u.pn * 256 + wc * 32 + 8 * fq;
#pragma unroll
        for (int ai = 0; ai < 2; ++ai)
#pragma unroll
            for (int m = 0; m < 4; ++m) { bf16_t* rowp = O + (size_t)(row0 + ai * 128 + m * 16) * 3072 + col0;
#pragma unroll
                for (int bj = 0; bj < 2; ++bj) { f32x4 v0 = acc[ai][bj][m][0], v1 = acc[ai][bj][m][1];
#pragma unroll
                    for (int e = 0; e < 4; ++e) { v0[e] = sigmoidf_(v0[e]); v1[e] = sigmoidf_(v1[e]); }
                    *(u32x4*)(rowp + bj * 128) = pack_f8(v0, v1); asm volatile("" ::: "memory"); } }
    }
};
struct EpiMix {
    const bf16_t* M3; bf16_t* MIX;
    __device__ __forceinline__ void operator()(const f32x4 (&acc)[2][2][4][2], const Unit& u, int wr, int wc, int fr, int fq) const {
        const int row0 = u.pm * 256 + wr * 64 + fr, col0 = u.pn * 256 + wc * 32 + 8 * fq; const int br = u.aux;
#pragma unroll
        for (int ai = 0; ai < 2; ++ai) {
            u32x4 g[2][4], o[2][4];
#pragma unroll
            for (int bj = 0; bj < 2; ++bj)
#pragma unroll
                for (int m = 0; m < 4; ++m) { const size_t row = (size_t)(row0 + ai * 128 + m * 16); const int col = col0 + bj * 128;
                    g[bj][m] = *(const u32x4*)(M3 + row * 3072 + br * 1024 + col);
                    if (br != 0) o[bj][m] = *(const u32x4*)(MIX + row * 1024 + col); else o[bj][m] = (u32x4){0u, 0u, 0u, 0u}; }
#pragma unroll
            for (int bj = 0; bj < 2; ++bj)
#pragma unroll
                for (int m = 0; m < 4; ++m) { const size_t row = (size_t)(row0 + ai * 128 + m * 16); const int col = col0 + bj * 128;
                    const u32x4 gg = g[bj][m], oo = o[bj][m];
                    f32x4 v0 = acc[ai][bj][m][0], v1 = acc[ai][bj][m][1];
                    v0[0] = v0[0] * bflo(gg.x) + bflo(oo.x); v0[1] = v0[1] * bfhi(gg.x) + bfhi(oo.x); v0[2] = v0[2] * bflo(gg.y) + bflo(oo.y); v0[3] = v0[3] * bfhi(gg.y) + bfhi(oo.y);
                    v1[0] = v1[0] * bflo(gg.z) + bflo(oo.z); v1[1] = v1[1] * bfhi(gg.z) + bfhi(oo.z); v1[2] = v1[2] * bflo(gg.w) + bflo(oo.w); v1[3] = v1[3] * bfhi(gg.w) + bfhi(oo.w);
                    *(u32x4*)(MIX + row * 1024 + col) = pack_f8(v0, v1); }
            asm volatile("" ::: "memory"); }
    }
};
struct EpiOut {
    const float* xold; float* xnew; const float* gate;
    __device__ __forceinline__ void operator()(const f32x4 (&acc)[2][2][4][2], const Unit& u, int wr, int wc, int fr, int fq) const {
        const int row0 = u.pm * 256 + wr * 64 + fr, col0 = u.pn * 256 + wc * 32 + 8 * fq; const int b = u.pm >> 4;
        const float* gp = gate + (size_t)b * 3072;
#pragma unroll
        for (int bj = 0; bj < 2; ++bj) { const int col = col0 + bj * 128; const f32x4 g0 = *(const f32x4*)(gp + col), g1 = *(const f32x4*)(gp + col + 4);
#pragma unroll
            for (int ai = 0; ai < 2; ++ai) {
                f32x4 a0[4], a1[4];
#pragma unroll
                for (int m = 0; m < 4; ++m) { const size_t off = (size_t)(row0 + ai * 128 + m * 16) * 1024 + col; a0[m] = *(const f32x4*)(xold + off); a1[m] = *(const f32x4*)(xold + off + 4); }
#pragma unroll
                for (int m = 0; m < 4; ++m) { const size_t off = (size_t)(row0 + ai * 128 + m * 16) * 1024 + col;
                    *(f32x4*)(xnew + off) = a0[m] + g0 * acc[ai][bj][m][0]; *(f32x4*)(xnew + off + 4) = a1[m] + g1 * acc[ai][bj][m][1]; }
                asm volatile("" ::: "memory"); } }
    }
};

__device__ __forceinline__ int in_src_col(int np) {
    const int tile = np >> 8, cp = np & 255;
    const int rp = 64 * ((cp & 127) >> 5) + 32 * (cp >> 7) + (cp & 31);
    if (tile < 2) return np;
    if (tile < 4) return 512 + (np - 2 * 256);
    if (tile < 6) return 1544 + (np - 4 * 256);
    if (tile < 8) return 2056 + (tile - 6) * 256 + rp;
    if (tile < 10) return 2696 + (tile - 8) * 256 + rp;
    if (tile < 12) return 3280 + (np - 10 * 256);
    if (tile < 14) return 3792 + (np - 12 * 256);
    if (tile < 16) return 4304 + (np - 14 * 256);
    if (tile < 18) return 5328 + (np - 16 * 256);
    if (tile == 18) { if (cp < 128) return 2568 + cp; if (cp < 192) return 3208 + cp - 128; if (cp < 200) return 1536 + cp - 192; if (cp < 208) return 3272 + cp - 200; return -1; }
    if (tile < 31) return 5840 + (np - 19 * 256);
    if (tile < 33) return 1024 + (np - 31 * 256);
    return 4816 + (np - 33 * 256);
}
template <bool MAP>
__device__ __forceinline__ void transpose_item(const float* W, int K, int N, int NP, bf16_t* WT, LAS float* scr, int item, int lane) {
    const int nblk = NP / 32, kb = item / nblk, nb = item % nblk, k0 = 64 * kb, n0 = 32 * nb;
    int src = n0 + (lane & 31); if (MAP) src = in_src_col(src);
#pragma unroll
    for (int i = 0; i < 32; ++i) { const int kk = 2 * i + (lane >> 5); scr[kk * 33 + (lane & 31)] = (src >= 0) ? W[(size_t)(k0 + kk) * N + src] : 0.f; }
    asm volatile("s_waitcnt lgkmcnt(0)" ::: "memory");
    const int c = lane & 7;
#pragma unroll
    for (int j = 0; j < 4; ++j) { const int n = (lane >> 3) + 8 * j; const LAS float* s = scr + (8 * c) * 33 + n;
        u32x4 o; o.x = cvt_pk(s[0 * 33], s[1 * 33]); o.y = cvt_pk(s[2 * 33], s[3 * 33]); o.z = cvt_pk(s[4 * 33], s[5 * 33]); o.w = cvt_pk(s[6 * 33], s[7 * 33]);
        *(u32x4*)(WT + (size_t)(n0 + n) * K + k0 + 8 * c) = o; }
    asm volatile("s_waitcnt lgkmcnt(0)" ::: "memory");
}

template <bool SB>
__device__ __forceinline__ void attn_fs_wave(const bf16_t* Q, const bf16_t* Kb, const bf16_t* VT, const float* F2, const bf16_t* G, bf16_t* Y, int b, int h, int q0w, int lane, bool do_store, const unsigned* kmaxw) {
    asm volatile("" : "+v"(lane));
    const int r32 = lane & 31, hi = lane >> 5;
    const int tq = q0w + r32;
    const size_t rowQ = (size_t)b * SEQ + tq;
    bf16x8 qf[4];
#pragma unroll
    for (int d0 = 0; d0 < 4; ++d0) qf[d0] = *(const bf16x8*)(Q + rowQ * 512 + h * 64 + d0 * 16 + hi * 8);
    f32x16 o0, o1;
#pragma unroll
    for (int r = 0; r < 16; ++r) { o0[r] = 0.f; o1[r] = 0.f; }
    float m = -INFINITY, l = 0.f, carry = 0.f, Ft = 0.f;
    const float* F2b = F2 + (size_t)(b * 8 + h) * SEQ;
    float qk = 0.f;
    if (!SB) { Ft = F2b[tq];
        float ss = 0.f;
#pragma unroll
        for (int d0 = 0; d0 < 4; ++d0)
#pragma unroll
            for (int e = 0; e < 8; ++e) { const float f = bf2f((bf16_t)qf[d0][e]); ss += f * f; }
        ss += shx32(ss, lane);
        qk = sqrtf(ss * __uint_as_float(kmaxw[b * 8 + h])) * 1.001f; }
    const bf16_t* Kh = Kb + (size_t)(b * 8 + h) * 64 * 4096;
    const bf16_t* VTh = VT + (size_t)(h * 8 + b) * 64 * 4096;
    const int jmax = (q0w + 31) >> 6;
    bf16x8 kf[2][4];
#pragma unroll
    for (int hf = 0; hf < 2; ++hf)
#pragma unroll
        for (int d0 = 0; d0 < 4; ++d0) kf[hf][d0] = *(const bf16x8*)(Kh + (size_t)jmax * 4096 + ((hf * 4 + d0) * 64 + lane) * 8);
    for (int j = jmax; j >= 0; --j) {
        const int kv0 = j * 64;
        bf16x8 vf[4][2];
#pragma unroll
        for (int ks = 0; ks < 4; ++ks)
#pragma unroll
            for (int dd = 0; dd < 2; ++dd) vf[ks][dd] = *(const bf16x8*)(VTh + (size_t)j * 4096 + ((ks * 2 + dd) * 64 + lane) * 8);
        bf16x8 kn[2][4];
        { const int jn = (j > 0 ? j - 1 : 0);
#pragma unroll
          for (int hf = 0; hf < 2; ++hf)
#pragma unroll
              for (int d0 = 0; d0 < 4; ++d0) kn[hf][d0] = *(const bf16x8*)(Kh + (size_t)jn * 4096 + ((hf * 4 + d0) * 64 + lane) * 8); }
        f32x4 fa4[4], fb4[4]; float fs_next = 0.f;
        if (!SB) {
#pragma unroll
            for (int g = 0; g < 4; ++g) { fa4[g] = *(const f32x4*)(F2b + kv0 + 8 * g + 4 * hi); fb4[g] = *(const f32x4*)(F2b + kv0 + 32 + 8 * g + 4 * hi); }
            fs_next = F2b[j > 0 ? 64 * j - 1 : 0];
        }
        asm volatile("" ::: "memory");
        f32x16 p0, p1;
#pragma unroll
        for (int r = 0; r < 16; ++r) { p0[r] = 0.f; p1[r] = 0.f; }
#pragma unroll
        for (int d0 = 0; d0 < 4; ++d0) { p0 = mfma32(kf[0][d0], qf[d0], p0); p1 = mfma32(kf[1][d0], qf[d0], p1); }
        if (!SB) {
#pragma unroll
            for (int g = 0; g < 4; ++g) { const f32x4 fa = fa4[g], fb = fb4[g];
#pragma unroll
                for (int e = 0; e < 4; ++e) { p0[4 * g + e] += Ft - fa[e]; p1[4 * g + e] += Ft - fb[e]; } }
            if (j == jmax) {
#pragma unroll
                for (int r = 0; r < 16; ++r) { const int kv = kv0 + crow(r, hi); if (kv > tq) p0[r] = -INFINITY; if (kv + 32 > tq) p1[r] = -INFINITY; } }
            float mx = p0[0];
#pragma unroll
            for (int r = 1; r < 16; ++r) mx = fmaxf(mx, p0[r]);
#pragma unroll
            for (int r = 0; r < 16; ++r) mx = fmaxf(mx, p1[r]);
            mx = fmaxf(mx, shx32(mx, lane));
            const float mnew = fmaxf(m, mx); const float alpha = ex2(m - mnew); m = mnew;
            l *= alpha;
#pragma unroll
            for (int r = 0; r < 16; ++r) { o0[r] *= alpha; o1[r] *= alpha; }
            float s = 0.f;
#pragma unroll
            for (int r = 0; r < 16; ++r) { p0[r] = ex2(p0[r] - m); p1[r] = ex2(p1[r] - m); s += p0[r] + p1[r]; }
            l += s;
        } else {
            float lm0[16], lm1[16];
#pragma unroll
            for (int r = 0; r < 16; ++r) {
                const int kv = kv0 + crow(r, hi);
                const float z0 = p0[r], z1 = p1[r];
                const float sp0 = (z0 > 40.f) ? z0 : lg2(1.0f + ex2(z0)), sp1 = (z1 > 40.f) ? z1 : lg2(1.0f + ex2(z1));
                const bool v0 = kv < tq, v1 = (kv + 32) < tq;
                lm0[r] = v0 ? sp0 : 0.f; lm1[r] = v1 ? sp1 : 0.f;
                p0[r] = v0 ? (z0 - sp0) : -INFINITY; p1[r] = v1 ? (z1 - sp1) : -INFINITY;
            }
            float gs0[4], gs1[4], ps0[4], ps1[4];
#pragma unroll
            for (int a = 0; a < 4; ++a) { gs0[a] = (lm0[4 * a] + lm0[4 * a + 1]) + (lm0[4 * a + 2] + lm0[4 * a + 3]); gs1[a] = (lm1[4 * a] + lm1[4 * a + 1]) + (lm1[4 * a + 2] + lm1[4 * a + 3]); }
#pragma unroll
            for (int a = 0; a < 4; ++a) { ps0[a] = shx32(gs0[a], lane); ps1[a] = shx32(gs1[a], lane); }
            float run = carry;
            float ex0[4], ex1[4];
#pragma unroll
            for (int a = 3; a >= 0; --a) { const float odd = hi ? gs1[a] : ps1[a]; const float pair = gs1[a] + ps1[a]; ex1[a] = run + (hi ? 0.f : odd); run += pair; }
#pragma unroll
            for (int a = 3; a >= 0; --a) { const float odd = hi ? gs0[a] : ps0[a]; const float pair = gs0[a] + ps0[a]; ex0[a] = run + (hi ? 0.f : odd); run += pair; }
            carry = run;
#pragma unroll
            for (int a = 0; a < 4; ++a) {
                float w = ex0[a];
                p0[4 * a + 3] = ex2(p0[4 * a + 3] - w); w += lm0[4 * a + 3];
                p0[4 * a + 2] = ex2(p0[4 * a + 2] - w); w += lm0[4 * a + 2];
                p0[4 * a + 1] = ex2(p0[4 * a + 1] - w); w += lm0[4 * a + 1];
                p0[4 * a + 0] = ex2(p0[4 * a + 0] - w);
                w = ex1[a];
                p1[4 * a + 3] = ex2(p1[4 * a + 3] - w); w += lm1[4 * a + 3];
                p1[4 * a + 2] = ex2(p1[4 * a + 2] - w); w += lm1[4 * a + 2];
                p1[4 * a + 1] = ex2(p1[4 * a + 1] - w); w += lm1[4 * a + 1];
                p1[4 * a + 0] = ex2(p1[4 * a + 0] - w);
            }
        }
        bf16x8 pw[4];
        pw[0] = pack8(p0[0], p0[1], p0[2], p0[3], p0[4], p0[5], p0[6], p0[7]);
        pw[1] = pack8(p0[8], p0[9], p0[10], p0[11], p0[12], p0[13], p0[14], p0[15]);
        pw[2] = pack8(p1[0], p1[1], p1[2], p1[3], p1[4], p1[5], p1[6], p1[7]);
        pw[3] = pack8(p1[8], p1[9], p1[10], p1[11], p1[12], p1[13], p1[14], p1[15]);
#pragma unroll
        for (int ks = 0; ks < 4; ++ks) { o0 = mfma32(vf[ks][0], pw[ks], o0); o1 = mfma32(vf[ks][1], pw[ks], o1); }
#pragma unroll
        for (int hf = 0; hf < 2; ++hf)
#pragma unroll
            for (int d0 = 0; d0 < 4; ++d0) kf[hf][d0] = kn[hf][d0];
        if (SB) { if (__all(carry > 160.f)) break; }
        else if (j > 0) {
            const float fs = fs_next;
            if (__all(qk + Ft - m + 64.f < fs)) break; }
    }
    float inv = 1.f;
    if (!SB) { const float lt = l + shx32(l, lane); inv = 1.0f / lt; }
    if (do_store)
#pragma unroll
    for (int g = 0; g < 4; ++g)
#pragma unroll
        for (int dd = 0; dd < 2; ++dd) {
            const size_t off = rowQ * 512 + h * 64 + dd * 32 + 8 * g + 4 * hi;
            const u32x2 gg = *(const u32x2*)(G + off);
            const f32x16& o = dd ? o1 : o0;
            u32x2 w; w.x = cvt_pk(o[4 * g] * inv * bflo(gg.x), o[4 * g + 1] * inv * bfhi(gg.x)); w.y = cvt_pk(o[4 * g + 2] * inv * bflo(gg.y), o[4 * g + 3] * inv * bfhi(gg.y));
            *(u32x2*)(Y + off) = w;
        }
}

__device__ __forceinline__ int wave_total(int v) {
    v += __builtin_amdgcn_update_dpp(0, v, 0x111, 0xf, 0xf, false);
    v += __builtin_amdgcn_update_dpp(0, v, 0x112, 0xf, 0xf, false);
    v += __builtin_amdgcn_update_dpp(0, v, 0x114, 0xf, 0xf, false);
    v += __builtin_amdgcn_update_dpp(0, v, 0x118, 0xf, 0xf, false);
    v += __builtin_amdgcn_update_dpp(0, v, 0x142, 0xa, 0xf, false);
    v += __builtin_amdgcn_update_dpp(0, v, 0x143, 0xc, 0xf, false);
    return __builtin_amdgcn_readlane(v, 63);
}
#ifndef DSA_SELFCHECK
#define DSA_SELFCHECK 0
#endif
__device__ __forceinline__ void dsa_unit(LAS unsigned char* lds, unsigned char* ws, int b, int t0, int wid, int lane, bool do_store) {
    asm volatile("" : "+v"(lane));
    LAS float* sc = (LAS float*)lds;
    LAS int* lists = (LAS int*)(lds + 131072);
    const bf16_t* IQ = (const bf16_t*)(ws + WS_IQ); const bf16_t* IK = (const bf16_t*)(ws + WS_IK);
    const float* MF = (const float*)(ws + WS_MISCF);
    const bf16_t* DK = (const bf16_t*)(ws + WS_DK); const bf16_t* DV = (const bf16_t*)(ws + WS_DV);
    const bf16_t* GD = (const bf16_t*)(ws + WS_GD); bf16_t* QD = (bf16_t*)(ws + WS_QD);
    const size_t tokb = (size_t)b * SEQ;
    const int r32 = lane & 31, hi = lane >> 5;
    for (int ra_ = 0; ra_ < REP_DA; ++ra_) {
        const int a_ = r32 >> 3, uu = (r32 >> 2) & 1, bb = r32 & 3; const int qq = 2 * uu + (a_ >> 1), hd = 4 * (a_ & 1) + bb;
        bf16x8 af[2][4];
#pragma unroll
        for (int rt = 0; rt < 2; ++rt)
#pragma unroll
            for (int d0 = 0; d0 < 4; ++d0) af[rt][d0] = *(const bf16x8*)(IQ + (tokb + t0 + 4 * rt + qq) * 512 + hd * 64 + d0 * 16 + hi * 8);
        const float WSC = 0.35355339059327373f * 0.125f;
        float w[2][16];
#pragma unroll
        for (int rt = 0; rt < 2; ++rt)
#pragma unroll
            for (int qh = 0; qh < 2; ++qh) { const float* wp = MF + (tokb + t0 + 4 * rt + 2 * hi + qh) * 128 + 72; const f32x4 wa = *(const f32x4*)wp, wb = *(const f32x4*)(wp + 4);
#pragma unroll
                for (int e = 0; e < 4; ++e) { w[rt][8 * qh + e] = wa[e] * WSC; w[rt][8 * qh + 4 + e] = wb[e] * WSC; } }
        const int nkt = (t0 + 8 + 31) >> 5;
        bf16x8 bfr[4];
#pragma unroll
        for (int d0 = 0; d0 < 4; ++d0) bfr[d0] = *(const bf16x8*)(IK + (((size_t)b * 128 + (wid < nkt ? wid : 0)) * 4 + d0) * 512 + lane * 8);
        for (int kt = wid; kt < nkt; kt += 8) {
            const int key = kt * 32 + r32;
            bf16x8 bnx[4];
            { const int ktn = (kt + 8 < nkt) ? kt + 8 : kt;
#pragma unroll
              for (int d0 = 0; d0 < 4; ++d0) bnx[d0] = *(const bf16x8*)(IK + (((size_t)b * 128 + ktn) * 4 + d0) * 512 + lane * 8); }
            asm volatile("" ::: "memory");
            f32x16 c0, c1;
#pragma unroll
            for (int r = 0; r < 16; ++r) { c0[r] = 0.f; c1[r] = 0.f; }
#pragma unroll
            for (int d0 = 0; d0 < 4; ++d0) { c0 = mfma32(af[0][d0], bfr[d0], c0); c1 = mfma32(af[1][d0], bfr[d0], c1); }
            float s00 = 0.f, s01 = 0.f, s10 = 0.f, s11 = 0.f;
#pragma unroll
            for (int r = 0; r < 8; ++r) { s00 += w[0][r] * fmaxf(c0[r], 0.f); s01 += w[0][8 + r] * fmaxf(c0[8 + r], 0.f); s10 += w[1][r] * fmaxf(c1[r], 0.f); s11 += w[1][8 + r] * fmaxf(c1[8 + r], 0.f); }
            const int q00 = 2 * hi, q01 = 2 * hi + 1, q10 = 4 + 2 * hi, q11 = 5 + 2 * hi;
            sc[q00 * 4096 + key] = (key > t0 + q00) ? -INFINITY : s00;
            sc[q01 * 4096 + key] = (key > t0 + q01) ? -INFINITY : s01;
            sc[q10 * 4096 + key] = (key > t0 + q10) ? -INFINITY : s10;
            sc[q11 * 4096 + key] = (key > t0 + q11) ? -INFINITY : s11;
#pragma unroll
            for (int d0 = 0; d0 < 4; ++d0) bfr[d0] = bnx[d0];
        }
    }
    __syncthreads();
    const int t = t0 + wid, n = t + 1;
    int count; bool badsel = false; (void)badsel;
    for (int rb_ = 0; rb_ < REP_DB; ++rb_) {
        unsigned key[64];
        const LAS float* row = sc + wid * 4096;
#pragma unroll
        for (int j = 0; j < 64; ++j) { const int idx = j * 64 + lane; const int idc = idx < n ? idx : n - 1;
            const unsigned bits = __float_as_uint(row[idc]); const unsigned k = bits ^ (unsigned)(((int)bits >> 31) | (int)0x80000000);
            key[j] = idx < n ? k : 0u; }
        unsigned T = 0u; int cT = 0;
        const int nb8 = (n + 511) >> 9;
        bool bad = false; (void)bad;
#define DSA_COUNT(CAND, OUT) do { int cl_ = 0; _Pragma("unroll") for (int jb = 0; jb < 8; ++jb) { if (jb < nb8) { _Pragma("unroll") for (int j = 8 * jb; j < 8 * jb + 8; ++j) cl_ += (key[j] >= (CAND)) ? 1 : 0; } } \
            OUT = wave_total(cl_); \
            if (DSA_SELFCHECK) { int c2_ = 0; _Pragma("unroll") for (int j = 0; j < 64; ++j) c2_ += __builtin_popcountll(__ballot(key[j] >= (CAND))); if (c2_ != OUT) bad = true; } } while (0)
        if (n > 256) {
            int bit = 30, c;
            DSA_COUNT(0x80000000u, c);
            if (c >= 256) { T = 0x80000000u; cT = c;
                if (c > 256) {
                    unsigned mxk = 0u;
#pragma unroll
                    for (int jb = 0; jb < 8; ++jb) { if (jb < nb8) {
#pragma unroll
                        for (int j = 8 * jb; j < 8 * jb + 8; ++j) mxk = key[j] > mxk ? key[j] : mxk; } }
#pragma unroll
                    for (int o = 1; o < 64; o <<= 1) { const unsigned ov = (unsigned)__builtin_amdgcn_ds_bpermute((lane ^ o) << 2, (int)mxk); mxk = ov > mxk ? ov : mxk; }
                    unsigned cand = mxk & 0xFF800000u;
                    for (int tr_ = 0; tr_ < 4; ++tr_) { DSA_COUNT(cand, c); if (c >= 256) { T = cand; cT = c; bit = 22; break; } if (cand <= 0x80800000u) break; cand -= 0x00800000u; }
                }
            }
            for (; bit >= 0 && cT != 256; --bit) { const unsigned cand = T | (1u << bit); DSA_COUNT(cand, c); if (c >= 256) { T = cand; cT = c; } }
            if (DSA_SELFCHECK) {
                unsigned Tr = 0u; int cr = 0;
                for (int b2 = 31; b2 >= 0; --b2) { const unsigned cand = Tr | (1u << b2); int c2 = 0;
#pragma unroll
                    for (int j = 0; j < 64; ++j) c2 += __builtin_popcountll(__ballot(key[j] >= cand));
                    if (c2 >= 256) { Tr = cand; cr = c2; if (c2 == 256) break; } }
                if (cT == 256 || cr == 256) { if (cT != cr) bad = true; } else if (T != Tr) bad = true;
            }
        }
        if (n <= 256) {
            for (int p2 = lane; p2 < 256; p2 += 64) lists[wid * 256 + p2] = p2;
        } else if (cT == 256) {
            int cl = 0;
#pragma unroll
            for (int jb = 0; jb < 8; ++jb) { if (jb < nb8) {
#pragma unroll
                for (int j = 8 * jb; j < 8 * jb + 8; ++j) cl += (key[j] >= T) ? 1 : 0; } }
            int incl = cl;
#pragma unroll
            for (int o = 1; o < 64; o <<= 1) { const int nbv = __builtin_amdgcn_ds_bpermute(((lane >= o) ? (lane - o) : lane) << 2, incl); if (lane >= o) incl += nbv; }
            int off = wid * 256 + incl - cl;
#pragma unroll
            for (int jb = 0; jb < 8; ++jb) { if (jb < nb8) {
#pragma unroll
                for (int j = 8 * jb; j < 8 * jb + 8; ++j) { if (key[j] >= T) { lists[off] = j * 64 + lane; ++off; } } } }
        } else {
        int eqbase = 0;
#pragma unroll
        for (int j = 0; j < 64; ++j) { const int idx = j * 64 + lane;
            const bool eq = (key[j] == T); const unsigned long long meq = __ballot(eq); const int r = eqbase + mbcnt64(meq);
            if (eq && r < 256) lists[wid * 256 + 255 - r] = idx;
            eqbase += __builtin_popcountll(meq); __builtin_amdgcn_sched_barrier(0); }
        int base = 0;
#pragma unroll
        for (int j = 0; j < 64; ++j) { const int idx = j * 64 + lane;
            const bool gt = (key[j] > T); const unsigned long long mg = __ballot(gt); const int pos = base + mbcnt64(mg);
            if (gt) lists[wid * 256 + pos] = idx;
            base += __builtin_popcountll(mg); __builtin_amdgcn_sched_barrier(0); }
        }
        count = n < 256 ? n : 256; badsel = badsel || bad;
    }
    asm volatile("s_waitcnt lgkmcnt(0)" ::: "memory");
    __builtin_amdgcn_wave_barrier();
    for (int rc_ = 0; rc_ < REP_DC; ++rc_) {
        const bool do_store_c = do_store && (rc_ == REP_DC - 1);
        const int hh = lane & 15, g = lane >> 4;
        bf16x8 qb[2];
#pragma unroll
        for (int ks = 0; ks < 2; ++ks) { if (hh < 8) qb[ks] = *(const bf16x8*)(QD + (tokb + t) * 512 + hh * 64 + ks * 32 + g * 8); else qb[ks] = (bf16x8){0, 0, 0, 0, 0, 0, 0, 0}; }
        const LAS int* lw = lists + wid * 256;
        const int cg = count - 4 * g;
        float s[64];
        const int nhalf = (count > 128) ? 2 : 1;
        u32x4 vr[16];
        {
            bf16x8 ka[16][2];
#pragma unroll
            for (int tile = 0; tile < 16; ++tile) { const int idx = lw[tile * 16 + hh];
                ka[tile][0] = *(const bf16x8*)(DK + (tokb + idx) * 64 + g * 8); ka[tile][1] = *(const bf16x8*)(DK + (tokb + idx) * 64 + 32 + g * 8); }
#pragma unroll
            for (int i = 0; i < 16; ++i) { const int row = i * 8 + (lane >> 3); const int idx = lw[row]; vr[i] = *(const u32x4*)(DV + (tokb + idx) * 64 + (lane & 7) * 8); }
            asm volatile("" ::: "memory");
#pragma unroll
            for (int tile = 0; tile < 16; ++tile) {
                f32x4 c = (f32x4){0.f, 0.f, 0.f, 0.f}; c = mfma16(ka[tile][0], qb[0], c); c = mfma16(ka[tile][1], qb[1], c);
#pragma unroll
                for (int j = 0; j < 4; ++j) s[4 * tile + j] = (tile * 16 + j < cg) ? c[j] : -INFINITY; }
        }
        float mx = s[0];
#pragma unroll
        for (int j = 1; j < 64; ++j) mx = fmaxf(mx, s[j]);
        mx = fmaxf(mx, shx(mx, 16, lane)); mx = fmaxf(mx, shx32(mx, lane));
        float sum = 0.f;
#pragma unroll
        for (int j = 0; j < 64; ++j) { s[j] = ex2(s[j] - mx); sum += s[j]; }
        sum += shx(sum, 16, lane); sum += shx32(sum, lane);
        LAS unsigned char* vs = (LAS unsigned char*)(sc + wid * 4096);
        f32x4 oacc[4];
#pragma unroll
        for (int dt = 0; dt < 4; ++dt) oacc[dt] = (f32x4){0.f, 0.f, 0.f, 0.f};
        u32x2 ggv[4];
#pragma unroll
        for (int dt = 0; dt < 4; ++dt) ggv[dt] = *(const u32x2*)(GD + (tokb + t) * 512 + (hh & 7) * 64 + dt * 16 + 4 * g);
#pragma unroll
        for (int half = 0; half < 2; ++half) {
            if (half < nhalf) {
#pragma unroll
                for (int i = 0; i < 16; ++i) { const int row = i * 8 + (lane >> 3); const int phys = (lane & 7) ^ (2 * ((row >> 2) & 1) + 4 * ((row >> 1) & 1)); *(LAS u32x4*)(vs + row * 128 + phys * 16) = vr[i]; }
                asm volatile("s_waitcnt lgkmcnt(0)" ::: "memory");
                __builtin_amdgcn_wave_barrier();
                if (half == 0 && nhalf == 2) {
#pragma unroll
                    for (int i = 0; i < 16; ++i) { const int row = i * 8 + (lane >> 3); const int idx = lw[128 + row]; vr[i] = *(const u32x4*)(DV + (tokb + idx) * 64 + (lane & 7) * 8); }
                    asm volatile("" ::: "memory");
                }
                const int q_ = (lane >> 2) & 3, p_ = lane & 3;
#pragma unroll
                for (int ks = 0; ks < 4; ++ks) {
                    const int ta = 2 * (half * 4 + ks), tb = ta + 1;
                    const bf16x8 pb = pack8(s[4 * ta], s[4 * ta + 1], s[4 * ta + 2], s[4 * ta + 3], s[4 * tb], s[4 * tb + 1], s[4 * tb + 2], s[4 * tb + 3]);
#pragma unroll
                    for (int dt = 0; dt < 4; ++dt) {
                        const int phys = (2 * dt + (p_ >> 1)) ^ (2 * (g & 1) + 4 * (q_ >> 1));
                        LAS unsigned char* ap = vs + (4 * g + q_) * 128 + phys * 16 + 8 * (p_ & 1) + ks * 4096;
                        const bf16x4 lo = __builtin_bit_cast(bf16x4, __builtin_amdgcn_ds_read_tr16_b64_v4i16((LAS bf16x4*)ap));
                        const bf16x4 hi4 = __builtin_bit_cast(bf16x4, __builtin_amdgcn_ds_read_tr16_b64_v4i16((LAS bf16x4*)(ap + 2048)));
                        const bf16x8 va = (bf16x8){lo[0], lo[1], lo[2], lo[3], hi4[0], hi4[1], hi4[2], hi4[3]};
                        oacc[dt] = mfma16(va, pb, oacc[dt]);
                    }
                }
                asm volatile("s_waitcnt lgkmcnt(0)" ::: "memory");
                __builtin_amdgcn_wave_barrier();
            }
        }
        if (hh < 8 && do_store_c) {
            float inv = 1.0f / sum;
            if (DSA_SELFCHECK && badsel) inv = __builtin_nanf("");
#pragma unroll
            for (int dt = 0; dt < 4; ++dt) { const size_t off = (tokb + t) * 512 + hh * 64 + dt * 16 + 4 * g;
                const u32x2 gg = ggv[dt];
                u32x2 w; w.x = cvt_pk(oacc[dt][0] * inv * bflo(gg.x), oacc[dt][1] * inv * bfhi(gg.x)); w.y = cvt_pk(oacc[dt][2] * inv * bflo(gg.y), oacc[dt][3] * inv * bfhi(gg.y));
                *(u32x2*)(QD + off) = w; }
        }
    }
    __syncthreads();
}

#define XB_TMO      128
#define XB_XCNT(j)  (256  + 64 * (j))
#define XB_XSUB(j)  (1280 + 64 * (j))
#define XB_XGEN(j)  (2304 + 64 * (j))
#define XB_TOP      3328
#define XB_TOPGEN   3392
#define XCD_BAR_WORDS 3456
#define XB_SPIN_CAP (1u << 22)
__device__ __forceinline__ unsigned xb_ld(unsigned* p)              { return __hip_atomic_load(p, __ATOMIC_RELAXED, __HIP_MEMORY_SCOPE_AGENT); }
__device__ __forceinline__ unsigned xb_add(unsigned* p, unsigned v) { return __hip_atomic_fetch_add(p, v, __ATOMIC_RELAXED, __HIP_MEMORY_SCOPE_AGENT); }
__device__ __forceinline__ unsigned xb_xcc_id() { return (unsigned)__builtin_amdgcn_s_getreg((3 << 11) | 20) & 0xFu; }
#define XB_SPIN(cond, bar) do { unsigned _sp = 0; while (cond) { __builtin_amdgcn_s_sleep(1); \
    if ((++_sp & 255u) == 0u) { if (xb_ld(&(bar)[XB_TMO])) break; if (_sp > XB_SPIN_CAP) { atomicAdd(&(bar)[XB_TMO], 1u); break; } } } } while (0)
__device__ __forceinline__ void xcd_barrier_complete(unsigned* bar, unsigned x, unsigned G, unsigned& nloc, unsigned& nx) {
    unsigned sum, cnt, mine, sp = 0u;
    for (;;) {
        sum = 0u; cnt = 0u; mine = 0u;
#pragma unroll
        for (unsigned j = 0; j < 16; ++j) { const unsigned c = xb_ld(&bar[XB_XCNT(j)]); sum += c; cnt += (c > 0u) ? 1u : 0u; mine = (j == x) ? c : mine; }
        if (sum == G) break;
        __builtin_amdgcn_s_sleep(1);
        if ((++sp & 255u) == 0u) { if (xb_ld(&bar[XB_TMO])) break; if (sp > XB_SPIN_CAP) { atomicAdd(&bar[XB_TMO], 1u); break; } }
    }
    nloc = mine > 0u ? mine : 1u; nx = cnt > 0u ? cnt : 1u;
}
__device__ __forceinline__ void xcd_barrier(unsigned* bar, unsigned x, unsigned G, volatile LAS unsigned* st, bool leader) {
    asm volatile("s_waitcnt vmcnt(0)" ::: "memory");
    __syncthreads();
    if (leader) {
        __builtin_amdgcn_s_waitcnt(0);
        unsigned nloc = st[0], nx = st[1];
        if (nloc == 0u) { xcd_barrier_complete(bar, x, G, nloc, nx); st[0] = nloc; st[1] = nx; }
        const unsigned old = xb_add(&bar[XB_XSUB(x)], 1u);
        const unsigned gen = old / nloc;
        if (old + 1u == (gen + 1u) * nloc) {
            __builtin_amdgcn_fence(__ATOMIC_RELEASE, "agent");
            asm volatile("s_waitcnt vmcnt(0)" ::: "memory");
            const unsigned og = xb_add(&bar[XB_TOP], 1u);
            const unsigned tg = og / nx;
            if (og + 1u == (tg + 1u) * nx) xb_add(&bar[XB_TOPGEN], 1u);
            else XB_SPIN(xb_ld(&bar[XB_TOPGEN]) == tg, bar);
            __builtin_amdgcn_fence(__ATOMIC_ACQUIRE, "agent");
            xb_add(&bar[XB_XGEN(x)], 1u);
            asm volatile("s_waitcnt vmcnt(0)" ::: "memory");
        } else {
            XB_SPIN(xb_ld(&bar[XB_XGEN(x)]) == gen, bar);
            __builtin_amdgcn_fence(__ATOMIC_ACQUIRE, "agent");
            asm volatile("s_waitcnt vmcnt(0)" ::: "memory");
        }
    }
    __syncthreads();
}
__device__ __forceinline__ void grid_bar(unsigned* bar, unsigned target, unsigned gen, bool leader) {
    asm volatile("s_waitcnt vmcnt(0) lgkmcnt(0)" ::: "memory");
    __syncthreads();
    if (leader) {
        __builtin_amdgcn_fence(__ATOMIC_RELEASE, "agent");
        asm volatile("s_waitcnt vmcnt(0)" ::: "memory");
        const unsigned old = __hip_atomic_fetch_add(&bar[0], 1u, __ATOMIC_RELAXED, __HIP_MEMORY_SCOPE_AGENT);
        if (old + 1u == target) __hip_atomic_fetch_add(&bar[64], 1u, __ATOMIC_RELAXED, __HIP_MEMORY_SCOPE_AGENT);
        else while (__hip_atomic_load(&bar[64], __ATOMIC_RELAXED, __HIP_MEMORY_SCOPE_AGENT) <= gen) __builtin_amdgcn_s_sleep(1);
        __builtin_amdgcn_fence(__ATOMIC_ACQUIRE, "agent");
        asm volatile("s_waitcnt vmcnt(0)" ::: "memory");
    }
    __syncthreads();
}
#ifndef DBG
#define DBG 0
#endif
#ifndef REP_P2
#define REP_P2 1
#endif
#ifndef REP_FOX
#define REP_FOX 1
#endif
#ifndef REP_SB
#define REP_SB 1
#endif
#ifndef REP_DSA
#define REP_DSA 1
#endif
#ifndef REP_P0
#define REP_P0 1
#endif
#ifndef REP_P1
#define REP_P1 1
#endif
#ifndef REP_P3
#define REP_P3 1
#endif
#ifndef REP_P5A
#define REP_P5A 1
#endif
#ifndef REP_P5B
#define REP_P5B 1
#endif
#ifndef REP_BAR
#define REP_BAR 1
#endif
#ifndef REP_P6
#define REP_P6 1
#endif
#ifndef REP_FIN
#define REP_FIN 1
#endif
__device__ __forceinline__ float dbg_value(const unsigned char* ws, int m, int c) {
    auto B = [&](size_t off, size_t idx) { return bf2f(((const bf16_t*)(ws + off))[idx]); };
    const size_t r512 = (size_t)m * 512;
    if (DBG == 1) return B(WS_H, (size_t)m * 1024 + c);
    if (DBG == 2) {
        if (c < 512) return B(WS_QF, r512 + c) + B(WS_KF, r512 + c) + B(WS_GF, r512 + c) + B(WS_QD, r512 + c) + B(WS_IQ, r512 + c) + B(WS_GD, r512 + c) + B(WS_QS, r512 + c) + B(WS_KS, r512 + c) + B(WS_GS, r512 + c);
        if (c < 640) return B(WS_DCKV, (size_t)m * 128 + (c - 512));
        if (c < 768) return ((const float*)(ws + WS_MISCF))[(size_t)m * 128 + (c - 640)];
        { const int cc = c - 768; float v = 0.f; for (int q = 0; q < 4; ++q) v += B(WS_VT, (size_t)(4 * cc + q) * NTOK + m); return v; }
    }
    if (DBG == 3) {
        if (c < 64) return B(WS_DK, (size_t)m * 64 + c);
        if (c < 128) return B(WS_DV, (size_t)m * 64 + c - 64);
        if (c < 192) return B(WS_IK, (size_t)m * 64 + c - 128);
        if (c < 200) return ((const float*)(ws + WS_F2))[(size_t)((m >> 12) * 8 + (c - 192)) * SEQ + (m & 4095)];
        return 0.f;
    }
    if (DBG == 4 || DBG == 41 || DBG == 42 || DBG == 43) { if (c < 512) return B(WS_QF, r512 + c); return B(WS_QD, r512 + c - 512) + B(WS_QS, r512 + c - 512); }
    if (DBG == 5) return B(WS_M3, (size_t)m * 3072 + c) + B(WS_M3, (size_t)m * 3072 + 1024 + c) + B(WS_M3, (size_t)m * 3072 + 2048 + c);
    if (DBG == 6) return B(WS_MIX, (size_t)m * 1024 + c);
    return 0.f;
}
#define DBG_DUMP(k) if (DBG != 0 && (DBG == (k) || DBG / 10 == (k)) && l == 0) { KArgP ap2_ = (KArgP)__builtin_amdgcn_kernarg_segment_ptr(); float* o_ = ap2_->out; const unsigned char* w_ = ap2_->ws; \
        for (size_t e = (size_t)bx0 * NTHR + wid0 * 64 + lane_id_fresh(); e < (size_t)NTOK * 1024; e += (size_t)G0 * NTHR) o_[e] = dbg_value(w_, (int)(e >> 10), (int)(e & 1023)); return; }
#ifndef ONLY
#define ONLY -1
#endif
#define PH(k) (ONLY < 0 || ONLY == (k))
struct Args { const float* x; const float* c; const int* pos; const float* w_ada; const float* b_ada; const float* g_norm; const float* w_in; const float* b_fgt;
              const float* g_kv; const float* w_kv_up; const float* w_br[3]; const float* w_out; const float* g_final; float* out; unsigned char* ws; };

typedef const __attribute__((address_space(4))) Args* KArgP;
__global__ void __launch_bounds__(NTHR, 2) fwd_megakernel(Args A_kernarg) {
    extern __shared__ __attribute__((aligned(16))) unsigned char lds_raw[];
    LAS unsigned char* lds = (LAS unsigned char*)lds_raw;
    cg::grid_group grid = cg::this_grid();
    const int G0 = gridDim.x, bx0 = blockIdx.x;
    const int wid0 = __builtin_amdgcn_readfirstlane((int)threadIdx.x >> 6);
    const unsigned xcc_id = xb_xcc_id();
    unsigned* const barp = (unsigned*)(((KArgP)__builtin_amdgcn_kernarg_segment_ptr())->ws + 4096);
    if (threadIdx.x == 0) { ((volatile LAS unsigned*)(lds + 147000))[0] = 0u; ((volatile LAS unsigned*)(lds + 147000))[1] = 0u;
        (void)xb_add(barp + XB_XCNT(xcc_id), 1u); }
    __syncthreads();
#define LOAD_ARGS KArgP ap_ = (KArgP)__builtin_amdgcn_kernarg_segment_ptr(); int G = G0, bx = bx0; asm volatile("" : "+s"(ap_), "+s"(G), "+s"(bx)); const int NGW = G * NWAVES; (void)NGW; unsigned char* ws = A.ws; float* MOD = (float*)(ws + WS_MOD); (void)MOD;
#define A (*ap_)
#define PHASE_VARS LOAD_ARGS int lane = lane_id_fresh(); asm volatile("" : "+v"(lane)); const int wid = wid0; const int tid = wid * 64 + lane; (void)tid; const int gw = bx * NWAVES + wid; LAS float* scr = (LAS float*)(lds + wid * 16384); (void)scr; (void)gw; (void)lane;

    if constexpr (PH(0)) for (int rep_ = 0; rep_ < REP_P0; ++rep_) {
        PHASE_VARS
        LAS float* red = (LAS float*)lds;
        LAS float* sl = (LAS float*)(lds + 32768);
        if (bx < 96) {
#pragma unroll
            for (int i = 0; i < 16; ++i) { const float cv = A.c[tid + i * NTHR]; sl[tid + i * NTHR] = cv / (1.0f + __expf(-cv)); } }
        __syncthreads();
        for (int it = bx; it < 96; it += G) {
            const int l = it / 48, cgp = it % 48, cc = tid & 63, kp = tid >> 6; const int col = cgp * 64 + cc;
            float acc[8];
#pragma unroll
            for (int b = 0; b < 8; ++b) acc[b] = 0.f;
            const float* wp = A.w_ada + ((size_t)l * 1024 + kp * 128) * 3072 + col;
#pragma unroll 32
            for (int k = 0; k < 128; ++k) { const float w = wp[(size_t)k * 3072];
#pragma unroll
                for (int b = 0; b < 8; ++b) acc[b] += sl[b * 1024 + kp * 128 + k] * w; }
#pragma unroll
            for (int b = 0; b < 8; ++b) red[(kp * 8 + b) * 64 + cc] = acc[b];
            __syncthreads();
            { const int b = tid >> 6; float s = 0.f;
#pragma unroll
              for (int k2 = 0; k2 < 8; ++k2) s += red[(k2 * 8 + b) * 64 + cc];
              MOD[((size_t)l * 8 + b) * 3072 + col] = s + A.b_ada[l * 3072 + col]; }
            __syncthreads();
        }
        f32x2* CS = (f32x2*)(ws + WS_CS);
        for (int e = bx * NTHR + tid; e < NTOK * 32; e += G * NTHR) { const int tok = e >> 5, i = e & 31;
            const double rev = (double)A.pos[tok] * INVF[i] * 0.15915494309189535; const double fr = rev - floor(rev); const float f = (float)fr;
            CS[e] = (f32x2){__builtin_amdgcn_cosf(f), __builtin_amdgcn_sinf(f)}; }
        __syncthreads();
        for (int it = gw; it < 2 * (3 * 256 + 512); it += NGW) { const int l = it / 1280; int r = it % 1280;
            if (r < 768) { const int br = r / 256; transpose_item<false>(A.w_br[br] + (size_t)l * 512 * 1024, 512, 1024, 1024, (bf16_t*)(ws + WS_WTBR) + ((size_t)l * 3 + br) * 1024 * 512, scr, r % 256, lane); }
            else { r -= 768; transpose_item<false>(A.w_out + (size_t)l * 1024 * 1024, 1024, 1024, 1024, (bf16_t*)(ws + WS_WTOUT) + (size_t)l * 1024 * 1024, scr, r, lane); } }
    }
    if (G0 == 0x7fffff01) grid.sync();
    { const int ln_ = lane_id_fresh(); unsigned* bp_ = barp; unsigned xc_ = xcc_id; asm volatile("" : "+s"(bp_), "+s"(xc_)); xcd_barrier(bp_, xc_, (unsigned)G0, (volatile LAS unsigned*)(lds + 147000), wid0 == 0 && ln_ == 0); }

    for (int l = 0; l < DEPTH; ++l) {
        if constexpr (PH(1)) for (int rep_ = 0; rep_ < REP_P1; ++rep_) {
            PHASE_VARS
            const float* xsrc = (l == 0) ? A.x : A.out;
            for (int it = gw; it < 16 * (NPAD / 32); it += NGW) transpose_item<true>(A.w_in + (size_t)l * 1024 * NIN, 1024, NIN, NPAD, (bf16_t*)(ws + WS_WTIN), scr, it, lane);
            bf16_t* H = (bf16_t*)(ws + WS_H); const float* gn = A.g_norm + l * 1024;
            for (int m0 = gw * 4; m0 < NTOK; m0 += NGW * 4) {
                f32x4 v[4][4]; float ss[4];
#pragma unroll
                for (int r = 0; r < 4; ++r) { const f32x4* xr = (const f32x4*)(xsrc + (size_t)(m0 + r) * 1024) + lane; ss[r] = 0.f;
#pragma unroll
                    for (int j = 0; j < 4; ++j) v[r][j] = xr[64 * j]; }
#pragma unroll
                for (int r = 0; r < 4; ++r)
#pragma unroll
                    for (int j = 0; j < 4; ++j) ss[r] += (v[r][j][0] * v[r][j][0] + v[r][j][1] * v[r][j][1]) + (v[r][j][2] * v[r][j][2] + v[r][j][3] * v[r][j][3]);
#pragma unroll
                for (int o = 1; o < 64; o <<= 1) {
#pragma unroll
                    for (int r = 0; r < 4; ++r) ss[r] += shx(ss[r], o, lane); }
                const float* mp = MOD + ((size_t)l * 8 + (m0 >> 12)) * 3072;
#pragma unroll
                for (int j = 0; j < 4; ++j) { const int col = 4 * lane + 256 * j;
                    const f32x4 gg = *(const f32x4*)(gn + col), sh = *(const f32x4*)(mp + col), scl = *(const f32x4*)(mp + 1024 + col);
                    const f32x4 gs = gg * (scl + 1.0f);
#pragma unroll
                    for (int r = 0; r < 4; ++r) { const float rstd = 1.0f / sqrtf(ss[r] * (1.0f / 1024.f) + EPS);
                        const f32x4 hv = v[r][j] * rstd * gs + sh;
                        u32x2 w; w.x = cvt_pk(hv[0], hv[1]); w.y = cvt_pk(hv[2], hv[3]);
                        *(u32x2*)(H + (size_t)(m0 + r) * 1024 + col) = w; } }
            }
        }
        { const int ln_ = lane_id_fresh(); unsigned* bp_ = barp; unsigned xc_ = xcc_id; asm volatile("" : "+s"(bp_), "+s"(xc_)); xcd_barrier(bp_, xc_, (unsigned)G0, (volatile LAS unsigned*)(lds + 147000), wid0 == 0 && ln_ == 0); }
        DBG_DUMP(1)
        if constexpr (PH(2)) {
            LOAD_ARGS
            for (int rep_ = 0; rep_ < REP_P2; ++rep_) {
            pg8::SchedStd S; S.init(ws + WS_H, ws + WS_WTIN, NTOK, 19 * 256, 1024, G, bx);
            EpiIn E{ws};
            pg8::gemm_phase<EpiIn, pg8::SchedStd>(lds, 1024, S, E, wid0);
            pg8::SchedStd S2; S2.init(ws + WS_WTIN + (size_t)31 * 256 * 1024 * 2, ws + WS_H, 1024, NTOK, 1024, G, bx);
            EpiPlain E2{(bf16_t*)(ws + WS_VT), (size_t)NTOK};
            pg8::gemm_phase<EpiPlain, pg8::SchedStd>(lds, 1024, S2, E2, wid0);
            }
        }
        { const int ln_ = lane_id_fresh(); unsigned* bp_ = barp; unsigned xc_ = xcc_id; asm volatile("" : "+s"(bp_), "+s"(xc_)); xcd_barrier(bp_, xc_, (unsigned)G0, (volatile LAS unsigned*)(lds + 147000), wid0 == 0 && ln_ == 0); }
        DBG_DUMP(2)
        if constexpr (PH(3)) for (int rep_ = 0; rep_ < REP_P3; ++rep_) {
            PHASE_VARS
            const float* MF = (const float*)(ws + WS_MISCF);
            if (bx < 64) {
                const int b = bx >> 3, h = bx & 7; const float bf = A.b_fgt[l * 8 + h];
                const float* mfp = MF + ((size_t)b * SEQ + tid * 8) * 128 + 64 + h;
                float v[8]; float run = 0.f;
#pragma unroll
                for (int i = 0; i < 8; ++i) { const float xx = mfp[(size_t)i * 128] + bf; run += -lg2(1.0f + ex2(-xx * LOG2E)); v[i] = run; }
                float incl = run;
#pragma unroll
                for (int o = 1; o < 64; o <<= 1) { const float nb = __int_as_float(__builtin_amdgcn_ds_bpermute(((lane >= o) ? (lane - o) : lane) << 2, __float_as_int(incl))); if (lane >= o) incl += nb; }
                LAS float* wt = (LAS float*)(lds + 70000);
                if (lane == 63) wt[wid] = incl;
                __syncthreads();
                float off = 0.f;
#pragma unroll
                for (int w2 = 0; w2 < 8; ++w2) { const float tv = wt[w2]; if (w2 < wid) off += tv; }
                const float excl = incl - run + off;
                float* Fo = (float*)(ws + WS_F2) + (size_t)bx * SEQ + tid * 8;
                *(f32x4*)Fo = (f32x4){v[0] + excl, v[1] + excl, v[2] + excl, v[3] + excl}; *(f32x4*)(Fo + 4) = (f32x4){v[4] + excl, v[5] + excl, v[6] + excl, v[7] + excl};
            }
            for (int blk = gw; blk < 8 * 8 * 64; blk += NGW) {
                const bf16_t* kb = (const bf16_t*)(ws + WS_KF) + (size_t)blk * 4096; float mxk = 0.f;
#pragma unroll
                for (int hf = 0; hf < 2; ++hf) { float ss = 0.f;
#pragma unroll
                    for (int d0 = 0; d0 < 4; ++d0) { const bf16x8 v = *(const bf16x8*)(kb + ((hf * 4 + d0) * 64 + lane) * 8);
#pragma unroll
                        for (int e = 0; e < 8; ++e) { const float f = bf2f((bf16_t)v[e]); ss += f * f; } }
                    ss += shx32(ss, lane); mxk = fmaxf(mxk, ss); }
#pragma unroll
                for (int o = 1; o < 32; o <<= 1) mxk = fmaxf(mxk, shx(mxk, o, lane));
                if (lane == 0) __hip_atomic_fetch_max((unsigned*)ws + 128 + l * 64 + (blk >> 6), __float_as_uint(mxk), __ATOMIC_RELAXED, __HIP_MEMORY_SCOPE_AGENT);
            }
            LAS float* Wl = (LAS float*)lds;
            { const f32x4* wsrc = (const f32x4*)(A.w_kv_up + (size_t)l * 128 * 128);
#pragma unroll
              for (int i = 0; i < 8; ++i) ((LAS f32x4*)Wl)[tid + i * NTHR] = wsrc[tid + i * NTHR]; }
            __syncthreads();
            const bf16_t* DC = (const bf16_t*)(ws + WS_DCKV); const f32x2* CS = (const f32x2*)(ws + WS_CS);
            bf16_t* DK = (bf16_t*)(ws + WS_DK); bf16_t* DV = (bf16_t*)(ws + WS_DV); bf16_t* IKo = (bf16_t*)(ws + WS_IK);
            const float gk0 = A.g_kv[l * 128 + lane], gk1 = A.g_kv[l * 128 + 64 + lane];
            for (int t4 = gw; t4 < NTOK / 4; t4 += NGW) {
                float n0[4], n1[4], a0[4], a1[4];
#pragma unroll
                for (int q = 0; q < 4; ++q) { const size_t tok = (size_t)t4 * 4 + q; const float x0 = bf2f(DC[tok * 128 + lane]), x1 = bf2f(DC[tok * 128 + 64 + lane]);
                    const float rstd = 1.0f / sqrtf(wave_sum(x0 * x0 + x1 * x1, lane) * (1.0f / 128.f) + EPS);
                    n0[q] = x0 * rstd * gk0; n1[q] = x1 * rstd * gk1; a0[q] = 0.f; a1[q] = 0.f; }
#pragma unroll 4
                for (int k = 0; k < 64; ++k) { const float w0 = Wl[k * 128 + lane], w1 = Wl[k * 128 + 64 + lane];
#pragma unroll
                    for (int q = 0; q < 4; ++q) { const float nk = __builtin_bit_cast(float, __builtin_amdgcn_readlane(__builtin_bit_cast(int, n0[q]), k)); a0[q] += nk * w0; a1[q] += nk * w1; } }
#pragma unroll 4
                for (int k = 0; k < 64; ++k) { const float w0 = Wl[(64 + k) * 128 + lane], w1 = Wl[(64 + k) * 128 + 64 + lane];
#pragma unroll
                    for (int q = 0; q < 4; ++q) { const float nk = __builtin_bit_cast(float, __builtin_amdgcn_readlane(__builtin_bit_cast(int, n1[q]), k)); a0[q] += nk * w0; a1[q] += nk * w1; } }
#pragma unroll
                for (int q = 0; q < 4; ++q) { const size_t tok = (size_t)t4 * 4 + q; const f32x2 cs = CS[tok * 32 + (lane & 31)];
                    const float pk = shx32(a0[q], lane);
                    const float kr = (lane < 32) ? (a0[q] * cs[0] - pk * cs[1]) : (a0[q] * cs[0] + pk * cs[1]);
                    DK[tok * 64 + lane] = (bf16_t)(cvt_pk(kr, 0.f) & 0xffffu); DV[tok * 64 + lane] = (bf16_t)(cvt_pk(a1[q], 0.f) & 0xffffu);
                    const float xi = MF[tok * 128 + lane]; const float pi = shx32(xi, lane);
                    const float ir = (lane < 32) ? (xi * cs[0] - pi * cs[1]) : (xi * cs[0] + pi * cs[1]);
                    IKo[(((tok >> 5) * 4 + (lane >> 4)) * 64 + ((lane >> 3) & 1) * 32 + (tok & 31)) * 8 + (lane & 7)] = (bf16_t)(cvt_pk(ir, 0.f) & 0xffffu); }
            }
            __syncthreads();
        }
        { const int ln_ = lane_id_fresh(); unsigned* bp_ = barp; unsigned xc_ = xcc_id; asm volatile("" : "+s"(bp_), "+s"(xc_)); xcd_barrier(bp_, xc_, (unsigned)G0, (volatile LAS unsigned*)(lds + 147000), wid0 == 0 && ln_ == 0); }
        DBG_DUMP(3)
        if constexpr (PH(4) || PH(8) || PH(9)) {
            PHASE_VARS
            const int b = bx & 7, w = bx >> 3, GW = (G + 7) >> 3;
            if constexpr (PH(4) && (DBG != 42 && DBG != 43)) for (int rep_ = 0; rep_ < REP_FOX; ++rep_) for (int u = w; u < 128; u += GW) { const int qb = u >> 3, h = (u + 2 * (u / GW)) & 7; const bool st_ = (rep_ == REP_FOX - 1) || (G0 == 0x7fffff01);
                attn_fs_wave<false>((const bf16_t*)(ws + WS_QF), (const bf16_t*)(ws + WS_KF), (const bf16_t*)(ws + WS_VT), (const float*)(ws + WS_F2), (const bf16_t*)(ws + WS_GF), (bf16_t*)(ws + WS_QF), b, h, qb * 256 + wid * 32, lane, st_, (const unsigned*)ws + 128 + l * 64); }
            if constexpr (PH(8) && (DBG != 41 && DBG != 43)) for (int rep_ = 0; rep_ < REP_SB; ++rep_) for (int u = w; u < 128; u += GW) { const int qb = u >> 3, h = (u + 2 * (u / GW)) & 7; const bool st_ = (rep_ == REP_SB - 1) || (G0 == 0x7fffff01);
                attn_fs_wave<true>((const bf16_t*)(ws + WS_QS), (const bf16_t*)(ws + WS_KS), (const bf16_t*)(ws + WS_VT) + (size_t)512 * NTOK, nullptr, (const bf16_t*)(ws + WS_GS), (bf16_t*)(ws + WS_QS), b, h, qb * 256 + wid * 32, lane, st_, nullptr); }
            __syncthreads();
            if constexpr (PH(9) && (DBG != 41 && DBG != 42)) {
                unsigned* qcnt = (unsigned*)ws + 256 + l * 8 + b; LAS int* ubox = (LAS int*)(lds + 147008);
                if (tid == 0) *ubox = (int)__hip_atomic_fetch_add(qcnt, 1u, __ATOMIC_RELAXED, __HIP_MEMORY_SCOPE_AGENT);
                __syncthreads();
                int k = *ubox;
                while (k < 512) {
                    int nxt = 0;
                    if (tid == 0) nxt = (int)__hip_atomic_fetch_add(qcnt, 1u, __ATOMIC_RELAXED, __HIP_MEMORY_SCOPE_AGENT);
                    dsa_unit(lds, ws, b, (511 - k) * 8, wid, lane, true);
                    if (tid == 0) *ubox = nxt;
                    __syncthreads();
                    k = *ubox;
                }
            }
        }
        { const int ln_ = lane_id_fresh(); unsigned* bp_ = barp; unsigned xc_ = xcc_id; asm volatile("" : "+s"(bp_), "+s"(xc_)); xcd_barrier(bp_, xc_, (unsigned)G0, (volatile LAS unsigned*)(lds + 147000), wid0 == 0 && ln_ == 0); }
        DBG_DUMP(4)
        if constexpr (PH(5)) for (int rep_ = 0; rep_ < REP_P5A; ++rep_) {
            LOAD_ARGS
            pg8::SchedStd S; S.init(ws + WS_H, ws + WS_WTIN + (size_t)19 * 256 * 1024 * 2, NTOK, 3072, 1024, G, bx);
            EpiMerge E{(bf16_t*)(ws + WS_M3)};
            pg8::gemm_phase<EpiMerge, pg8::SchedStd>(lds, 1024, S, E, wid0);
        }
        { const int ln_ = lane_id_fresh(); unsigned* bp_ = barp; unsigned xc_ = xcc_id; asm volatile("" : "+s"(bp_), "+s"(xc_)); xcd_barrier(bp_, xc_, (unsigned)G0, (volatile LAS unsigned*)(lds + 147000), wid0 == 0 && ln_ == 0); }
        DBG_DUMP(5)
        if constexpr (PH(6)) for (int rep_ = 0; rep_ < REP_P5B; ++rep_) {
            LOAD_ARGS
            pg8::SchedMix S{(const char*)(ws + WS_QF), (const char*)(ws + WS_WTBR) + (size_t)l * 3 * 1024 * 512 * 2, G, bx};
            EpiMix E{(const bf16_t*)(ws + WS_M3), (bf16_t*)(ws + WS_MIX)};
            pg8::gemm_phase<EpiMix, pg8::SchedMix>(lds, 512, S, E, wid0);
        }
        { const int ln_ = lane_id_fresh(); unsigned* bp_ = barp; unsigned xc_ = xcc_id; asm volatile("" : "+s"(bp_), "+s"(xc_)); xcd_barrier(bp_, xc_, (unsigned)G0, (volatile LAS unsigned*)(lds + 147000), wid0 == 0 && ln_ == 0); }
        DBG_DUMP(6)
        if constexpr (PH(7)) for (int rep_ = 0; rep_ < (l == 0 ? REP_P6 : 1); ++rep_) {
            LOAD_ARGS
            const float* xsrc = (l == 0) ? A.x : A.out;
            pg8::SchedStd S; S.init(ws + WS_MIX, ws + WS_WTOUT + (size_t)l * 1024 * 1024 * 2, NTOK, 1024, 1024, G, bx);
            EpiOut E{xsrc, A.out, MOD + (size_t)l * 8 * 3072 + 2048};
            pg8::gemm_phase<EpiOut, pg8::SchedStd>(lds, 1024, S, E, wid0);
        }
        { const int ln_ = lane_id_fresh(); unsigned* bp_ = barp; unsigned xc_ = xcc_id; asm volatile("" : "+s"(bp_), "+s"(xc_)); xcd_barrier(bp_, xc_, (unsigned)G0, (volatile LAS unsigned*)(lds + 147000), wid0 == 0 && ln_ == 0); }
        DBG_DUMP(7)
        for (int rb_ = 1; rb_ < REP_BAR; ++rb_) { const int ln_ = lane_id_fresh(); unsigned* bp_ = barp; unsigned xc_ = xcc_id; asm volatile("" : "+s"(bp_), "+s"(xc_)); xcd_barrier(bp_, xc_, (unsigned)G0, (volatile LAS unsigned*)(lds + 147000), wid0 == 0 && ln_ == 0); }
    }
    PHASE_VARS
    for (int rep_ = 0; rep_ < REP_FIN; ++rep_)
    for (int m0 = gw * 4; m0 < NTOK; m0 += NGW * 4) {
        f32x4 v[4][4]; float ss[4];
#pragma unroll
        for (int r = 0; r < 4; ++r) { const f32x4* xr = (const f32x4*)(A.out + (size_t)(m0 + r) * 1024) + lane; ss[r] = 0.f;
#pragma unroll
            for (int j = 0; j < 4; ++j) v[r][j] = xr[64 * j]; }
        f32x4 gg[4];
#pragma unroll
        for (int j = 0; j < 4; ++j) gg[j] = *(const f32x4*)(A.g_final + 4 * lane + 256 * j);
#pragma unroll
        for (int r = 0; r < 4; ++r)
#pragma unroll
            for (int j = 0; j < 4; ++j) ss[r] += (v[r][j][0] * v[r][j][0] + v[r][j][1] * v[r][j][1]) + (v[r][j][2] * v[r][j][2] + v[r][j][3] * v[r][j][3]);
#pragma unroll
        for (int o = 1; o < 64; o <<= 1) {
#pragma unroll
            for (int r = 0; r < 4; ++r) ss[r] += shx(ss[r], o, lane); }
#pragma unroll
        for (int r = 0; r < 4; ++r) { const float rstd = 1.0f / sqrtf(ss[r] * (1.0f / 1024.f) + EPS); f32x4* xo = (f32x4*)(A.out + (size_t)(m0 + r) * 1024) + lane;
#pragma unroll
            for (int j = 0; j < 4; ++j) { if (rep_ == REP_FIN - 1 || G0 == 0x7fffff01) xo[64 * j] = v[r][j] * rstd * gg[j]; } }
    }
}

#undef A
extern "C" void kernel_launch(void* const* d_in, const int* in_sizes, int n_in, void* d_out, int out_size, void* d_ws, size_t ws_size, hipStream_t stream) {
    static int grid = 0;
    if (grid == 0) {
        if (n_in != 15 || ws_size < WS_END) { fprintf(stderr, "kernel_launch: unexpected n_in %d / ws %zu\n", n_in, ws_size); grid = -1; return; }
        int dev = 0, cus = 0, per_cu = 0;
        hipGetDevice(&dev);
        hipDeviceGetAttribute(&cus, hipDeviceAttributeMultiprocessorCount, dev);
        hipFuncSetAttribute((const void*)fwd_megakernel, hipFuncAttributeMaxDynamicSharedMemorySize, LDS_BYTES);
        hipOccupancyMaxActiveBlocksPerMultiprocessor(&per_cu, (const void*)fwd_megakernel, NTHR, LDS_BYTES);
        if (per_cu < 1) per_cu = 1;
        grid = cus * per_cu;
    }
    if (grid < 0) return;
    Args a{};
    a.x = (const float*)d_in[0]; a.c = (const float*)d_in[1]; a.pos = (const int*)d_in[2]; a.w_ada = (const float*)d_in[3]; a.b_ada = (const float*)d_in[4];
    a.g_norm = (const float*)d_in[5]; a.w_in = (const float*)d_in[6]; a.b_fgt = (const float*)d_in[7]; a.g_kv = (const float*)d_in[8]; a.w_kv_up = (const float*)d_in[9];
    a.w_br[0] = (const float*)d_in[10]; a.w_br[1] = (const float*)d_in[11]; a.w_br[2] = (const float*)d_in[12]; a.w_out = (const float*)d_in[13]; a.g_final = (const float*)d_in[14];
    a.out = (float*)d_out; a.ws = (unsigned char*)d_ws;
    hipMemsetAsync(d_ws, 0, 32768, stream);
    void* args[] = {&a};
    hipError_t e = hipLaunchCooperativeKernel((const void*)fwd_megakernel, dim3(grid), dim3(NTHR), args, LDS_BYTES, stream);
    if (e != hipSuccess) fprintf(stderr, "cooperative launch failed: %s (grid %d)\n", hipGetErrorString(e), grid);
}
```

```cpp
#include <hip/hip_runtime.h>
#include <hip/hip_cooperative_groups.h>
#include <cstdio>
#include <cstdint>
namespace cg = cooperative_groups;
#ifndef REP_DA
#define REP_DA 1
#endif
#ifndef REP_DB
#define REP_DB 1
#endif
#ifndef REP_DC
#define REP_DC 1
#endif

#define LAS __attribute__((address_space(3)))
typedef unsigned short bf16_t;
typedef short bf16x8 __attribute__((ext_vector_type(8)));
typedef short bf16x4 __attribute__((ext_vector_type(4)));
typedef float f32x4 __attribute__((ext_vector_type(4)));
typedef float f32x2 __attribute__((ext_vector_type(2)));
typedef float f32x16 __attribute__((ext_vector_type(16)));
typedef unsigned u32x4 __attribute__((ext_vector_type(4)));
typedef unsigned u32x2 __attribute__((ext_vector_type(2)));

constexpr int DM = 1024, NB = 8, SEQ = 4096, NTOK = NB * SEQ, DEPTH = 2;
constexpr int NIN = 8912, NPAD = 8960;
constexpr float LOG2E = 1.4426950408889634f;
constexpr float C2 = 0.125f * LOG2E;
constexpr float EPS = 1e-6f;
constexpr int NWAVES = 8, NTHR = 512;
constexpr int LDS_BYTES = 147456;

constexpr size_t MiB = 1u << 20;
constexpr size_t WS_MOD = 1 * MiB;
constexpr size_t WS_F2 = 2 * MiB;
constexpr size_t WS_CS = 8 * MiB;
constexpr size_t WS_WTBR = 16 * MiB;
constexpr size_t WS_WTOUT = 22 * MiB;
constexpr size_t WS_WTIN = 28 * MiB;
constexpr size_t WS_H = 46 * MiB;
constexpr size_t WS_QF = 110 * MiB;
constexpr size_t WS_QD = 142 * MiB;
constexpr size_t WS_QS = 174 * MiB;
constexpr size_t WS_GF = 206 * MiB;
constexpr size_t WS_GD = 238 * MiB;
constexpr size_t WS_GS = 270 * MiB;
constexpr size_t WS_MIX = 206 * MiB;
constexpr size_t WS_KF = 302 * MiB;
constexpr size_t WS_KS = 334 * MiB;
constexpr size_t WS_VT = 366 * MiB;
constexpr size_t WS_IQ = 430 * MiB;
constexpr size_t WS_DCKV = 462 * MiB;
constexpr size_t WS_MISCF = 470 * MiB;
constexpr size_t WS_DK = 486 * MiB;
constexpr size_t WS_DV = 490 * MiB;
constexpr size_t WS_M3 = 302 * MiB;
constexpr size_t WS_IK = 494 * MiB;
constexpr size_t WS_END = 498 * MiB;

__device__ const double INVF[32] = {1.0, 0.7498942093324559, 0.5623413251903491, 0.4216965034285822, 0.31622776601683794, 0.23713737056616552, 0.1778279410038923, 0.1333521432163324, 0.1, 0.07498942093324558, 0.05623413251903491, 0.042169650342858224, 0.03162277660168379, 0.023713737056616554, 0.01778279410038923, 0.01333521432163324, 0.01, 0.007498942093324558, 0.005623413251903491, 0.004216965034285823, 0.0031622776601683794, 0.0023713737056616554, 0.0017782794100389228, 0.001333521432163324, 0.001, 0.0007498942093324559, 0.0005623413251903491, 0.00042169650342858224, 0.00031622776601683794, 0.00023713737056616554, 0.00017782794100389227, 0.0001333521432163324};

typedef __bf16 bf16x2_t __attribute__((ext_vector_type(2)));
__device__ __forceinline__ unsigned cvt_pk(float lo, float hi) { f32x2 v = {lo, hi}; bf16x2_t b = __builtin_convertvector(v, bf16x2_t); return __builtin_bit_cast(unsigned, b); }
__device__ __forceinline__ float bf2f(bf16_t v) { return __uint_as_float((unsigned)v << 16); }
__device__ __forceinline__ float bflo(unsigned w) { return __uint_as_float(w << 16); }
__device__ __forceinline__ float bfhi(unsigned w) { return __uint_as_float(w & 0xffff0000u); }
__device__ __forceinline__ float ex2(float x) { return __builtin_amdgcn_exp2f(x); }
__device__ __forceinline__ float lg2(float x) { return __builtin_amdgcn_logf(x); }
__device__ __forceinline__ float sigmoidf_(float x) { return __builtin_amdgcn_rcpf(1.0f + ex2(-x * LOG2E)); }
__device__ __forceinline__ int lane_id_fresh() { unsigned ones = ~0u; asm volatile("" : "+s"(ones)); return __builtin_amdgcn_mbcnt_hi(ones, __builtin_amdgcn_mbcnt_lo(ones, 0u)); }
__device__ __forceinline__ float shx(float v, int o, int lane) { return __int_as_float(__builtin_amdgcn_ds_bpermute((lane ^ o) << 2, __float_as_int(v))); }
__device__ __forceinline__ float shx32(float v, int lane) {
    const auto rr = __builtin_amdgcn_permlane32_swap(__float_as_uint(v), __float_as_uint(v), false, false);
    return __uint_as_float((lane & 32) ? rr[0] : rr[1]);
}
__device__ __forceinline__ float wave_sum(float v, int lane) {
#pragma unroll
    for (int o = 1; o < 64; o <<= 1) v += shx(v, o, lane);
    return v;
}
__device__ __forceinline__ int crow(int r, int hi) { return (r & 3) + 8 * (r >> 2) + 4 * hi; }
__device__ __forceinline__ f32x16 mfma32(bf16x8 a, bf16x8 b, f32x16 c) { return __builtin_amdgcn_mfma_f32_32x32x16_bf16(a, b, c, 0, 0, 0); }
__device__ __forceinline__ f32x4 mfma16(bf16x8 a, bf16x8 b, f32x4 c) { return __builtin_amdgcn_mfma_f32_16x16x32_bf16(a, b, c, 0, 0, 0); }
__device__ __forceinline__ bf16x8 pack8(float a0, float a1, float a2, float a3, float a4, float a5, float a6, float a7) {
    u32x4 w; w.x = cvt_pk(a0, a1); w.y = cvt_pk(a2, a3); w.z = cvt_pk(a4, a5); w.w = cvt_pk(a6, a7); return __builtin_bit_cast(bf16x8, w);
}
__device__ __forceinline__ int mbcnt64(unsigned long long m) { return __builtin_amdgcn_mbcnt_hi((unsigned)(m >> 32), __builtin_amdgcn_mbcnt_lo((unsigned)m, 0u)); }

namespace pg8 {
constexpr int BM = 256, BK = 64, HALF = 128, HTB = HALF * BK * 2, STAGE_BYTES = 8 * HTB, NXCD = 8, WGM = 8;
__device__ __forceinline__ int lds_byte(int r, int c) { const int st = (r >> 4) * 2 + (c >> 5), rr = r & 15, cc = c & 31, ob = rr * 64 + cc * 2; return st * 1024 + (ob ^ (((ob >> 9) & 1) << 5)); }
__device__ __forceinline__ void stage_rc(int b, int& R, int& C) { const int st = b / 1024, sb = b % 1024, swz = sb ^ (((sb >> 9) & 1) << 5); R = (st >> 1) * 16 + swz / 64; C = (st & 1) * 32 + (swz % 64) / 2; }
__device__ __forceinline__ int perm32(int rho) { const int n = rho >> 4, i = rho & 15; return 8 * (i >> 2) + 4 * n + (i & 3); }
struct Unit { int pm, pn, aux; };

struct StaticOrder {
    int nM, nN, nwg, G, c;
    __device__ void init(int M, int N, int G_, int c_) { nM = M / BM; nN = N / BM; nwg = nM * nN; G = G_; c = c_; }
    __device__ bool next(int i, Unit& u) const {
        const long L = (long)i * G + c; if (L >= nwg) return false;
        int wgid = (int)L; { const int q = nwg / NXCD, r = nwg % NXCD, xcd = wgid % NXCD, off = wgid / NXCD; wgid = (xcd < r ? xcd * (q + 1) : r * (q + 1) + (xcd - r) * q) + off; }
        const int nig = WGM * nN, gid = wgid / nig, fm = gid * WGM, gsz = (nM - fm) < WGM ? (nM - fm) : WGM;
        u.pm = fm + ((wgid % nig) % gsz); u.pn = (wgid % nig) / gsz; u.aux = 0; return true;
    }
};
struct SchedStd {
    const char* A; const char* B; size_t tstep; StaticOrder so;
    __device__ void init(const void* A_, const void* B_, int M, int N, int K, int G, int c) { A = (const char*)A_; B = (const char*)B_; tstep = (size_t)BM * K * 2; so.init(M, N, G, c); }
    __device__ __forceinline__ bool next(int i, Unit& u) const { return so.next(i, u); }
    __device__ __forceinline__ const char* a_base(const Unit& u) const { return A + (size_t)u.pm * tstep; }
    __device__ __forceinline__ const char* b_base(const Unit& u) const { return B + (size_t)u.pn * tstep; }
};
struct SchedMix {
    const char* Y; const char* W; int G, c;
    __device__ __forceinline__ bool next(int i, Unit& u) const { const int tl = c + G * (i / 3); if (tl >= 512) return false; u.pm = tl >> 2; u.pn = tl & 3; u.aux = i % 3; return true; }
    __device__ __forceinline__ const char* a_base(const Unit& u) const { return Y + (size_t)u.aux * (32 * MiB) + (size_t)u.pm * (256 * 512 * 2); }
    __device__ __forceinline__ const char* b_base(const Unit& u) const { return W + (size_t)u.aux * (1024 * 512 * 2) + (size_t)u.pn * (256 * 512 * 2); }
};

template <class Epi, class Sched>
__device__ __forceinline__ void gemm_phase(LAS unsigned char* lds, const int K, const Sched& S, const Epi& E, const int wid) {
    int lane = lane_id_fresh(); asm volatile("" : "+v"(lane));
    const int tid = wid * 64 + lane, wr = wid >> 2, wc = wid & 3, fr = lane & 15, fq = lane >> 4;
    const int nt = K / BK;
    unsigned voffA[2], voffB[2];
#pragma unroll
    for (int i = 0; i < 2; ++i) { int R, C; stage_rc(tid * 16 + i * 8192, R, C); const int Rb = (R & ~31) + perm32(R & 31);
        voffA[i] = (unsigned)(R * K + C) * 2u; voffB[i] = (unsigned)(Rb * K + C) * 2u; }
    const size_t kstep = (size_t)(BK * 2);
    const size_t hstep = (size_t)HALF * K * 2;
    const unsigned ldsw = (unsigned)wid * 1024u;
    const int aoff = lds_byte(wr * 64 + fr, fq * 8), boff = lds_byte(wc * 32 + fr, fq * 8);
#define PG8_SA(b, h) (((b) * 2 + (h)) * HTB)
#define PG8_SB(b, h) ((4 + (b) * 2 + (h)) * HTB)
#define PG8_STAGE(bufoff, gbase, voff) do { _Pragma("unroll") for (int _i = 0; _i < 2; ++_i) \
        __builtin_amdgcn_global_load_lds((const unsigned*)((const char*)(gbase) + (voff)[_i]), (LAS unsigned*)(lds + (bufoff) + ldsw + _i * 8192), 16, 0, 0); } while (0)
#define PG8_LDA(dst, b, h) do { _Pragma("unroll") for (int m = 0; m < 4; ++m) _Pragma("unroll") for (int k = 0; k < 2; ++k) dst[m][k] = *(const LAS bf16x8*)(lds + PG8_SA(b, h) + aoff + m * 2048 + k * 1024); } while (0)
#define PG8_LDB(dst, b, h) do { _Pragma("unroll") for (int n = 0; n < 2; ++n) _Pragma("unroll") for (int k = 0; k < 2; ++k) dst[n][k] = *(const LAS bf16x8*)(lds + PG8_SB(b, h) + boff + n * 2048 + k * 1024); } while (0)
#define PG8_MMA(ai, bj, At, Bt) do { __builtin_amdgcn_s_setprio(1); _Pragma("unroll") for (int m = 0; m < 4; ++m) _Pragma("unroll") for (int n = 0; n < 2; ++n) _Pragma("unroll") for (int k = 0; k < 2; ++k) \
        acc[ai][bj][m][n] = __builtin_amdgcn_mfma_f32_16x16x32_bf16(Bt[n][k], At[m][k], acc[ai][bj][m][n], 0, 0, 0); __builtin_amdgcn_s_setprio(0); } while (0)
#define PG8_WAIT_V(n) asm volatile("s_waitcnt vmcnt(" #n ")" ::: "memory")
#define PG8_WAIT_L(n) asm volatile("s_waitcnt lgkmcnt(" #n ")" ::: "memory")
#define PG8_BAR __builtin_amdgcn_s_barrier()
#define PG8_SCHED __builtin_amdgcn_sched_barrier(0)
    Unit cur, nxt; int ui = 0;
    if (!S.next(0, cur)) return;
    f32x4 acc[2][2][4][2];
#pragma unroll
    for (int a = 0; a < 2; ++a)
#pragma unroll
        for (int b = 0; b < 2; ++b)
#pragma unroll
            for (int m = 0; m < 4; ++m)
#pragma unroll
                for (int n = 0; n < 2; ++n) acc[a][b][m][n] = (f32x4){0.f, 0.f, 0.f, 0.f};
    bf16x8 At[4][2], B0[2][2], B1[2][2];
    const char* cA = S.a_base(cur); const char* cB = S.b_base(cur);
    PG8_STAGE(PG8_SB(0, 0), cB, voffB); PG8_STAGE(PG8_SB(0, 1), cB + hstep, voffB); PG8_STAGE(PG8_SA(0, 0), cA, voffA); PG8_STAGE(PG8_SA(0, 1), cA + hstep, voffA);
    if (wr == 1) PG8_BAR;
    PG8_WAIT_V(2); PG8_BAR;
    PG8_STAGE(PG8_SB(1, 0), cB + kstep, voffB); PG8_STAGE(PG8_SA(1, 0), cA + kstep, voffA); PG8_STAGE(PG8_SB(1, 1), cB + hstep + kstep, voffB);
    PG8_WAIT_V(6); PG8_BAR;
    for (;;) {
        const bool has_next = S.next(ui + 1, nxt);
        const char* nA = has_next ? S.a_base(nxt) : cA; const char* nB = has_next ? S.b_base(nxt) : cB;
        for (int t = 0; t < nt; t += 2) {
            const bool last = (t == nt - 2);
            const char* a1 = cA + (size_t)(t + 1) * kstep;
            const char* a2 = last ? nA : cA + (size_t)(t + 2) * kstep; const char* b2 = last ? nB : cB + (size_t)(t + 2) * kstep;
            const char* a3 = a2 + kstep; const char* b3 = b2 + kstep;
            PG8_LDB(B0, 0, 0); PG8_LDB(B1, 0, 1); PG8_SCHED; PG8_LDA(At, 0, 0); PG8_STAGE(PG8_SA(1, 1), a1 + hstep, voffA);
            PG8_WAIT_V(8); PG8_WAIT_L(0); PG8_BAR; PG8_MMA(0, 0, At, B0); PG8_MMA(0, 1, At, B1); PG8_BAR; PG8_SCHED;
            PG8_LDA(At, 0, 1); PG8_STAGE(PG8_SB(0, 0), b2, voffB); PG8_STAGE(PG8_SB(0, 1), b2 + hstep, voffB); PG8_STAGE(PG8_SA(0, 0), a2, voffA);
            PG8_WAIT_V(8); PG8_WAIT_L(0); PG8_BAR; PG8_MMA(1, 0, At, B0); PG8_MMA(1, 1, At, B1); PG8_BAR; PG8_SCHED;
            PG8_LDB(B0, 1, 0); PG8_LDB(B1, 1, 1); PG8_SCHED; PG8_LDA(At, 1, 0); PG8_STAGE(PG8_SA(0, 1), a2 + hstep, voffA);
            PG8_WAIT_V(8); PG8_WAIT_L(0); PG8_BAR; PG8_MMA(0, 0, At, B0); PG8_MMA(0, 1, At, B1); PG8_BAR; PG8_SCHED;
            PG8_LDA(At, 1, 1); PG8_STAGE(PG8_SB(1, 0), b3, voffB); PG8_STAGE(PG8_SB(1, 1), b3 + hstep, voffB); PG8_STAGE(PG8_SA(1, 0), a3, voffA);
            PG8_WAIT_V(8); PG8_WAIT_L(0); PG8_BAR; PG8_MMA(1, 0, At, B0); PG8_MMA(1, 1, At, B1); PG8_BAR; PG8_SCHED;
        }
        if (wr == 0) PG8_BAR;
        E(acc, cur, wr, wc, fr, fq);
        if (!has_next) break;
#pragma unroll
        for (int a = 0; a < 2; ++a)
#pragma unroll
            for (int b = 0; b < 2; ++b)
#pragma unroll
                for (int m = 0; m < 4; ++m)
#pragma unroll
                    for (int n = 0; n < 2; ++n) acc[a][b][m][n] = (f32x4){0.f, 0.f, 0.f, 0.f};
        cur = nxt; cA = nA; cB = nB; ++ui;
        if (wr == 1) PG8_BAR;
    }
    PG8_WAIT_V(0);
    PG8_BAR;
#undef PG8_SA
#undef PG8_SB
#undef PG8_STAGE
#undef PG8_LDA
#undef PG8_LDB
#undef PG8_MMA
#undef PG8_WAIT_V
#undef PG8_WAIT_L
#undef PG8_BAR
#undef PG8_SCHED
}
}
using pg8::Unit;

__device__ __forceinline__ u32x4 pack_f8(const f32x4& v0, const f32x4& v1) { u32x4 w; w.x = cvt_pk(v0[0], v0[1]); w.y = cvt_pk(v0[2], v0[3]); w.z = cvt_pk(v1[0], v1[1]); w.w = cvt_pk(v1[2], v1[3]); return w; }

struct EpiIn {
    unsigned char* ws;
    __device__ __forceinline__ void operator()(const f32x4 (&acc)[2][2][4][2], const Unit& u, int wr, int wc, int fr, int fq) const {
        const int pn = u.pn; const int row0 = u.pm * 256 + wr * 64 + fr;
        if (pn == 18) {
            bf16_t* dc = (bf16_t*)(ws + WS_DCKV); float* mf = (float*)(ws + WS_MISCF);
            const int col = wc * 32 + 8 * fq;
#pragma unroll
            for (int ai = 0; ai < 2; ++ai)
#pragma unroll
                for (int m = 0; m < 4; ++m) { const size_t row = (size_t)(row0 + ai * 128 + m * 16);
                    *(u32x4*)(dc + row * 128 + col) = pack_f8(acc[ai][0][m][0], acc[ai][0][m][1]);
                    *(f32x4*)(mf + row * 128 + col) = acc[ai][1][m][0]; *(f32x4*)(mf + row * 128 + col + 4) = acc[ai][1][m][1]; asm volatile("" ::: "memory"); }
            return;
        }
        const int grp = pn >> 1, half = pn & 1;
        size_t boff; int mode = 0; float sc = 1.f;
        switch (grp) {
            case 0: boff = WS_QF; sc = C2; break;
            case 1: boff = WS_KF; mode = 3; break;
            case 2: boff = WS_GF; mode = 1; break;
            case 3: boff = WS_QD; mode = 2; sc = C2; break;
            case 4: boff = WS_IQ; mode = 2; break;
            case 5: boff = WS_GD; mode = 1; break;
            case 6: boff = WS_QS; sc = C2; break;
            case 7: boff = WS_KS; mode = 3; break;
            default: boff = WS_GS; mode = 1; break;
        }
        bf16_t* base = (bf16_t*)(ws + boff);
        if (mode == 2) {
            const f32x4* cs = (const f32x4*)(ws + WS_CS);
            const int head = half * 4 + wc, i0 = 8 * fq;
#pragma unroll
            for (int ai = 0; ai < 2; ++ai)
#pragma unroll
                for (int m = 0; m < 4; ++m) { const size_t row = (size_t)(row0 + ai * 128 + m * 16);
                    const f32x4* cp = cs + (row * 32 + i0) / 2;
                    f32x4 y1[2], y2[2];
#pragma unroll
                    for (int n = 0; n < 2; ++n) { const f32x4 ca = cp[2 * n], cb = cp[2 * n + 1];
                        const f32x4 x1 = acc[ai][0][m][n], x2 = acc[ai][1][m][n];
                        y1[n][0] = (x1[0] * ca[0] - x2[0] * ca[1]) * sc; y2[n][0] = (x2[0] * ca[0] + x1[0] * ca[1]) * sc;
                        y1[n][1] = (x1[1] * ca[2] - x2[1] * ca[3]) * sc; y2[n][1] = (x2[1] * ca[2] + x1[1] * ca[3]) * sc;
                        y1[n][2] = (x1[2] * cb[0] - x2[2] * cb[1]) * sc; y2[n][2] = (x2[2] * cb[0] + x1[2] * cb[1]) * sc;
                        y1[n][3] = (x1[3] * cb[2] - x2[3] * cb[3]) * sc; y2[n][3] = (x2[3] * cb[2] + x1[3] * cb[3]) * sc; }
                    bf16_t* rp = base + row * 512 + head * 64 + i0;
                    *(u32x4*)rp = pack_f8(y1[0], y1[1]); *(u32x4*)(rp + 32) = pack_f8(y2[0], y2[1]); if (m & 1) asm volatile("" ::: "memory"); }
            return;
        }
        if (mode == 3) {
#pragma unroll
            for (int ai = 0; ai < 2; ++ai)
#pragma unroll
                for (int m = 0; m < 4; ++m) { const int tok = row0 + ai * 128 + m * 16; const int b = tok >> 12, sq = tok & 4095, kv = sq & 63;
#pragma unroll
                    for (int bj = 0; bj < 2; ++bj) { const int head = half * 4 + bj * 2 + (wc >> 1), d0 = (wc & 1) * 2 + (fq >> 1);
                        bf16_t* bp = base + (((size_t)(b * 8 + head) * 64 + (sq >> 6)) * 4096) + (((kv >> 5) * 4 + d0) * 64 + (fq & 1) * 32 + (kv & 31)) * 8;
                        *(u32x4*)bp = pack_f8(acc[ai][bj][m][0], acc[ai][bj][m][1]); }
                    asm volatile("" ::: "memory"); }
            return;
        }
        const int col0 = half * 256 + wc * 32 + 8 * fq;
#pragma unroll
        for (int ai = 0; ai < 2; ++ai)
#pragma unroll
            for (int m = 0; m < 4; ++m) { bf16_t* rowp = base + (size_t)(row0 + ai * 128 + m * 16) * 512 + col0;
#pragma unroll
                for (int bj = 0; bj < 2; ++bj) { f32x4 v0 = acc[ai][bj][m][0], v1 = acc[ai][bj][m][1];
                    if (mode == 1) {
#pragma unroll
                        for (int e = 0; e < 4; ++e) { v0[e] = v0[e] * sigmoidf_(v0[e]); v1[e] = v1[e] * sigmoidf_(v1[e]); } }
                    else { v0 = v0 * sc; v1 = v1 * sc; }
                    *(u32x4*)(rowp + bj * 128) = pack_f8(v0, v1); asm volatile("" ::: "memory"); } }
    }
};
struct EpiPlain {
    bf16_t* O; size_t ldc;
    __device__ __forceinline__ void operator()(const f32x4 (&acc)[2][2][4][2], const Unit& u, int wr, int wc, int fr, int fq) const {
        const int row0 = u.pm * 256 + wr * 64 + fr, col0 = u.pn * 256 + wc * 32 + 8 * fq;
#pragma unroll
        for (int ai = 0; ai < 2; ++ai)
#pragma unroll
            for (int m = 0; m < 4; ++m) { const int r = row0 + ai * 128 + m * 16; const int hb = r >> 6, d = r & 63;
#pragma unroll
                for (int bj = 0; bj < 2; ++bj) { const int tok = col0 + bj * 128; const int b = tok >> 12, sq = tok & 4095, j = sq >> 6, kv0 = sq & 63;
                    bf16_t* bp = O + (((size_t)(hb * 8 + b) * 64 + j) * 4096) + (((kv0 >> 4) * 2 + (d >> 5)) * 64 + (d & 31)) * 8 + ((kv0 & 8) >> 1);
                    const u32x4 w = pack_f8(acc[ai][bj][m][0], acc[ai][bj][m][1]);
                    *(u32x2*)bp = (u32x2){w.x, w.y}; *(u32x2*)(bp + 32 * 8) = (u32x2){w.z, w.w}; }
                asm volatile("" ::: "memory"); }
    }
};
struct EpiMerge {
    unsigned char* O;
    __device__ __forceinline__ void operator()(const f32x4 (&acc)[2][2][4][2], const Unit& u, int wr, int wc, int fr, int fq) const {
        const int row0 = u.pm * 256 + wr * 64 + fr, col0 = u.pn * 256 + wc * 32 + 8 * fq;
#pragma unroll
        for (int ai = 0; ai < 2; ++ai)
#pragma unroll
            for (int m = 0; m < 4; ++m) { unsigned char* rowp = O + (size_t)(row0 + ai * 128 + m * 16) * 3072 + col0;
#pragma unroll
                for (int bj = 0; bj < 2; ++bj) { const f32x4 v0 = acc[ai][bj][m][0], v1 = acc[ai][bj][m][1];
                    unsigned q0[4], q1[4];
#pragma unroll
                    for (int e = 0; e < 4; ++e) { q0[e] = (unsigned)(sigmoidf_(v0[e]) * 255.0f + 0.5f); q1[e] = (unsigned)(sigmoidf_(v1[e]) * 255.0f + 0.5f); }
                    u32x2 w; w.x = q0[0] | (q0[1] << 8) | (q0[2] << 16) | (q0[3] << 24); w.y = q1[0] | (q1[1] << 8) | (q1[2] << 16) | (q1[3] << 24);
                    *(u32x2*)(rowp + bj * 128) = w; asm volatile("" ::: "memory"); } }
    }
};
struct EpiMix {
    const unsigned char* M3; bf16_t* MIX;
    __device__ __forceinline__ void operator()(const f32x4 (&acc)[2][2][4][2], const Unit& u, int wr, int wc, int fr, int fq) const {
        const int row0 = u.pm * 256 + wr * 64 + fr, col0 = u.pn * 256 + wc * 32 + 8 * fq; const int br = u.aux;
#pragma unroll
        for (int ai = 0; ai < 2; ++ai) {
            u32x2 g[2][4]; u32x4 o[2][4];
#pragma unroll
            for (int bj = 0; bj < 2; ++bj)
#pragma unroll
                for (int m = 0; m < 4; ++m) { const size_t row = (size_t)(row0 + ai * 128 + m * 16); const int col = col0 + bj * 128;
                    g[bj][m] = *(const u32x2*)(M3 + row * 3072 + br * 1024 + col);
                    if (br != 0) o[bj][m] = *(const u32x4*)(MIX + row * 1024 + col); else o[bj][m] = (u32x4){0u, 0u, 0u, 0u}; }
#pragma unroll
            for (int bj = 0; bj < 2; ++bj)
#pragma unroll
                for (int m = 0; m < 4; ++m) { const size_t row = (size_t)(row0 + ai * 128 + m * 16); const int col = col0 + bj * 128;
                    const u32x2 gg = g[bj][m]; const u32x4 oo = o[bj][m]; const float k255 = 1.0f / 255.0f;
                    f32x4 v0 = acc[ai][bj][m][0] * k255, v1 = acc[ai][bj][m][1] * k255;
                    v0[0] = v0[0] * (float)(gg.x & 0xffu) + bflo(oo.x); v0[1] = v0[1] * (float)((gg.x >> 8) & 0xffu) + bfhi(oo.x); v0[2] = v0[2] * (float)((gg.x >> 16) & 0xffu) + bflo(oo.y); v0[3] = v0[3] * (float)(gg.x >> 24) + bfhi(oo.y);
                    v1[0] = v1[0] * (float)(gg.y & 0xffu) + bflo(oo.z); v1[1] = v1[1] * (float)((gg.y >> 8) & 0xffu) + bfhi(oo.z); v1[2] = v1[2] * (float)((gg.y >> 16) & 0xffu) + bflo(oo.w); v1[3] = v1[3] * (float)(gg.y >> 24) + bfhi(oo.w);
                    *(u32x4*)(MIX + row * 1024 + col) = pack_f8(v0, v1); }
            asm volatile("" ::: "memory"); }
    }
};
struct EpiOut {
    const float* xold; float* xnew; const float* gate;
    __device__ __forceinline__ void operator()(const f32x4 (&acc)[2][2][4][2], const Unit& u, int wr, int wc, int fr, int fq) const {
        const int row0 = u.pm * 256 + wr * 64 + fr, col0 = u.pn * 256 + wc * 32 + 8 * fq; const int b = u.pm >> 4;
        const float* gp = gate + (size_t)b * 3072;
#pragma unroll
        for (int bj = 0; bj < 2; ++bj) { const int col = col0 + bj * 128; const f32x4 g0 = *(const f32x4*)(gp + col), g1 = *(const f32x4*)(gp + col + 4);
#pragma unroll
            for (int ai = 0; ai < 2; ++ai) {
                f32x4 a0[4], a1[4];
#pragma unroll
                for (int m = 0; m < 4; ++m) { const size_t off = (size_t)(row0 + ai * 128 + m * 16) * 1024 + col; a0[m] = *(const f32x4*)(xold + off); a1[m] = *(const f32x4*)(xold + off + 4); }
#pragma unroll
                for (int m = 0; m < 4; ++m) { const size_t off = (size_t)(row0 + ai * 128 + m * 16) * 1024 + col;
                    *(f32x4*)(xnew + off) = a0[m] + g0 * acc[ai][bj][m][0]; *(f32x4*)(xnew + off + 4) = a1[m] + g1 * acc[ai][bj][m][1]; }
                asm volatile("" ::: "memory"); } }
    }
};

__device__ __forceinline__ int in_src_col(int np) {
    const int tile = np >> 8, cp = np & 255;
    const int rp = 64 * ((cp & 127) >> 5) + 32 * (cp >> 7) + (cp & 31);
    if (tile < 2) return np;
    if (tile < 4) return 512 + (np - 2 * 256);
    if (tile < 6) return 1544 + (np - 4 * 256);
    if (tile < 8) return 2056 + (tile - 6) * 256 + rp;
    if (tile < 10) return 2696 + (tile - 8) * 256 + rp;
    if (tile < 12) return 3280 + (np - 10 * 256);
    if (tile < 14) return 3792 + (np - 12 * 256);
    if (tile < 16) return 4304 + (np - 14 * 256);
    if (tile < 18) return 5328 + (np - 16 * 256);
    if (tile == 18) { if (cp < 128) return 2568 + cp; if (cp < 192) return 3208 + cp - 128; if (cp < 200) return 1536 + cp - 192; if (cp < 208) return 3272 + cp - 200; return -1; }
    if (tile < 31) return 5840 + (np - 19 * 256);
    if (tile < 33) return 1024 + (np - 31 * 256);
    return 4816 + (np - 33 * 256);
}
template <bool MAP>
__device__ __forceinline__ void transpose_item(const float* W, int K, int N, int NP, bf16_t* WT, LAS float* scr, int item, int lane) {
    const int nblk = NP / 32, kb = item / nblk, nb = item % nblk, k0 = 64 * kb, n0 = 32 * nb;
    int src = n0 + (lane & 31); if (MAP) src = in_src_col(src);
#pragma unroll
    for (int i = 0; i < 32; ++i) { const int kk = 2 * i + (lane >> 5); scr[kk * 33 + (lane & 31)] = (src >= 0) ? W[(size_t)(k0 + kk) * N + src] : 0.f; }
    asm volatile("s_waitcnt lgkmcnt(0)" ::: "memory");
    const int c = lane & 7;
#pragma unroll
    for (int j = 0; j < 4; ++j) { const int n = (lane >> 3) + 8 * j; const LAS float* s = scr + (8 * c) * 33 + n;
        u32x4 o; o.x = cvt_pk(s[0 * 33], s[1 * 33]); o.y = cvt_pk(s[2 * 33], s[3 * 33]); o.z = cvt_pk(s[4 * 33], s[5 * 33]); o.w = cvt_pk(s[6 * 33], s[7 * 33]);
        *(u32x4*)(WT + (size_t)(n0 + n) * K + k0 + 8 * c) = o; }
    asm volatile("s_waitcnt lgkmcnt(0)" ::: "memory");
}

template <bool SB>
__device__ __forceinline__ void attn_fs_wave(const bf16_t* Q, const bf16_t* Kb, const bf16_t* VT, const float* F2, const bf16_t* G, bf16_t* Y, int b, int h, int q0w, int lane, bool do_store, const unsigned* kmaxw) {
    asm volatile("" : "+v"(lane));
    const int r32 = lane & 31, hi = lane >> 5;
    const int tq = q0w + r32;
    const size_t rowQ = (size_t)b * SEQ + tq;
    bf16x8 qf[4];
#pragma unroll
    for (int d0 = 0; d0 < 4; ++d0) qf[d0] = *(const bf16x8*)(Q + rowQ * 512 + h * 64 + d0 * 16 + hi * 8);
    f32x16 o0, o1;
#pragma unroll
    for (int r = 0; r < 16; ++r) { o0[r] = 0.f; o1[r] = 0.f; }
    float m = -INFINITY, l = 0.f, carry = 0.f, Ft = 0.f;
    const float* F2b = F2 + (size_t)(b * 8 + h) * SEQ;
    float qk = 0.f;
    if (!SB) { Ft = F2b[tq];
        float ss = 0.f;
#pragma unroll
        for (int d0 = 0; d0 < 4; ++d0)
#pragma unroll
            for (int e = 0; e < 8; ++e) { const float f = bf2f((bf16_t)qf[d0][e]); ss += f * f; }
        ss += shx32(ss, lane);
        qk = sqrtf(ss * __uint_as_float(kmaxw[b * 8 + h])) * 1.001f; }
    const bf16_t* Kh = Kb + (size_t)(b * 8 + h) * 64 * 4096;
    const bf16_t* VTh = VT + (size_t)(h * 8 + b) * 64 * 4096;
    const int jmax = (q0w + 31) >> 6;
    bf16x8 kf[2][4];
#pragma unroll
    for (int hf = 0; hf < 2; ++hf)
#pragma unroll
        for (int d0 = 0; d0 < 4; ++d0) kf[hf][d0] = *(const bf16x8*)(Kh + (size_t)jmax * 4096 + ((hf * 4 + d0) * 64 + lane) * 8);
    for (int j = jmax; j >= 0; --j) {
        const int kv0 = j * 64;
        bf16x8 vf[4][2];
#pragma unroll
        for (int ks = 0; ks < 4; ++ks)
#pragma unroll
            for (int dd = 0; dd < 2; ++dd) vf[ks][dd] = *(const bf16x8*)(VTh + (size_t)j * 4096 + ((ks * 2 + dd) * 64 + lane) * 8);
        bf16x8 kn[2][4];
        { const int jn = (j > 0 ? j - 1 : 0);
#pragma unroll
          for (int hf = 0; hf < 2; ++hf)
#pragma unroll
              for (int d0 = 0; d0 < 4; ++d0) kn[hf][d0] = *(const bf16x8*)(Kh + (size_t)jn * 4096 + ((hf * 4 + d0) * 64 + lane) * 8); }
        f32x4 fa4[4], fb4[4]; float fs_next = 0.f;
        if (!SB) {
#pragma unroll
            for (int g = 0; g < 4; ++g) { fa4[g] = *(const f32x4*)(F2b + kv0 + 8 * g + 4 * hi); fb4[g] = *(const f32x4*)(F2b + kv0 + 32 + 8 * g + 4 * hi); }
            fs_next = F2b[j > 0 ? 64 * j - 1 : 0];
        }
        asm volatile("" ::: "memory");
        f32x16 p0, p1;
#pragma unroll
        for (int r = 0; r < 16; ++r) { p0[r] = 0.f; p1[r] = 0.f; }
#pragma unroll
        for (int d0 = 0; d0 < 4; ++d0) { p0 = mfma32(kf[0][d0], qf[d0], p0); p1 = mfma32(kf[1][d0], qf[d0], p1); }
        if (!SB) {
#pragma unroll
            for (int g = 0; g < 4; ++g) { const f32x4 fa = fa4[g], fb = fb4[g];
#pragma unroll
                for (int e = 0; e < 4; ++e) { p0[4 * g + e] += Ft - fa[e]; p1[4 * g + e] += Ft - fb[e]; } }
            if (j == jmax) {
#pragma unroll
                for (int r = 0; r < 16; ++r) { const int kv = kv0 + crow(r, hi); if (kv > tq) p0[r] = -INFINITY; if (kv + 32 > tq) p1[r] = -INFINITY; } }
            float mx = p0[0];
#pragma unroll
            for (int r = 1; r < 16; ++r) mx = fmaxf(mx, p0[r]);
#pragma unroll
            for (int r = 0; r < 16; ++r) mx = fmaxf(mx, p1[r]);
            mx = fmaxf(mx, shx32(mx, lane));
            const float mnew = fmaxf(m, mx); const float alpha = ex2(m - mnew); m = mnew;
            l *= alpha;
#pragma unroll
            for (int r = 0; r < 16; ++r) { o0[r] *= alpha; o1[r] *= alpha; }
            float s = 0.f;
#pragma unroll
            for (int r = 0; r < 16; ++r) { p0[r] = ex2(p0[r] - m); p1[r] = ex2(p1[r] - m); s += p0[r] + p1[r]; }
            l += s;
        } else {
            float lm0[16], lm1[16];
#pragma unroll
            for (int r = 0; r < 16; ++r) {
                const int kv = kv0 + crow(r, hi);
                const float z0 = p0[r], z1 = p1[r];
                const float sp0 = (z0 > 40.f) ? z0 : lg2(1.0f + ex2(z0)), sp1 = (z1 > 40.f) ? z1 : lg2(1.0f + ex2(z1));
                const bool v0 = kv < tq, v1 = (kv + 32) < tq;
                lm0[r] = v0 ? sp0 : 0.f; lm1[r] = v1 ? sp1 : 0.f;
                p0[r] = v0 ? (z0 - sp0) : -INFINITY; p1[r] = v1 ? (z1 - sp1) : -INFINITY;
            }
            float gs0[4], gs1[4], ps0[4], ps1[4];
#pragma unroll
            for (int a = 0; a < 4; ++a) { gs0[a] = (lm0[4 * a] + lm0[4 * a + 1]) + (lm0[4 * a + 2] + lm0[4 * a + 3]); gs1[a] = (lm1[4 * a] + lm1[4 * a + 1]) + (lm1[4 * a + 2] + lm1[4 * a + 3]); }
#pragma unroll
            for (int a = 0; a < 4; ++a) { ps0[a] = shx32(gs0[a], lane); ps1[a] = shx32(gs1[a], lane); }
            float run = carry;
            float ex0[4], ex1[4];
#pragma unroll
            for (int a = 3; a >= 0; --a) { const float odd = hi ? gs1[a] : ps1[a]; const float pair = gs1[a] + ps1[a]; ex1[a] = run + (hi ? 0.f : odd); run += pair; }
#pragma unroll
            for (int a = 3; a >= 0; --a) { const float odd = hi ? gs0[a] : ps0[a]; const float pair = gs0[a] + ps0[a]; ex0[a] = run + (hi ? 0.f : odd); run += pair; }
            carry = run;
#pragma unroll
            for (int a = 0; a < 4; ++a) {
                float w = ex0[a];
                p0[4 * a + 3] = ex2(p0[4 * a + 3] - w); w += lm0[4 * a + 3];
                p0[4 * a + 2] = ex2(p0[4 * a + 2] - w); w += lm0[4 * a + 2];
                p0[4 * a + 1] = ex2(p0[4 * a + 1] - w); w += lm0[4 * a + 1];
                p0[4 * a + 0] = ex2(p0[4 * a + 0] - w);
                w = ex1[a];
                p1[4 * a + 3] = ex2(p1[4 * a + 3] - w); w += lm1[4 * a + 3];
                p1[4 * a + 2] = ex2(p1[4 * a + 2] - w); w += lm1[4 * a + 2];
                p1[4 * a + 1] = ex2(p1[4 * a + 1] - w); w += lm1[4 * a + 1];
                p1[4 * a + 0] = ex2(p1[4 * a + 0] - w);
            }
        }
        bf16x8 pw[4];
        pw[0] = pack8(p0[0], p0[1], p0[2], p0[3], p0[4], p0[5], p0[6], p0[7]);
        pw[1] = pack8(p0[8], p0[9], p0[10], p0[11], p0[12], p0[13], p0[14], p0[15]);
        pw[2] = pack8(p1[0], p1[1], p1[2], p1[3], p1[4], p1[5], p1[6], p1[7]);
        pw[3] = pack8(p1[8], p1[9], p1[10], p1[11], p1[12], p1[13], p1[14], p1[15]);
#pragma unroll
        for (int ks = 0; ks < 4; ++ks) { o0 = mfma32(vf[ks][0], pw[ks], o0); o1 = mfma32(vf[ks][1], pw[ks], o1); }
#pragma unroll
        for (int hf = 0; hf < 2; ++hf)
#pragma unroll
            for (int d0 = 0; d0 < 4; ++d0) kf[hf][d0] = kn[hf][d0];
        if (SB) { if (__all(carry > 160.f)) break; }
        else if (j > 0) {
            const float fs = fs_next;
            if (__all(qk + Ft - m + 64.f < fs)) break; }
    }
    float inv = 1.f;
    if (!SB) { const float lt = l + shx32(l, lane); inv = 1.0f / lt; }
    if (do_store)
#pragma unroll
    for (int g = 0; g < 4; ++g)
#pragma unroll
        for (int dd = 0; dd < 2; ++dd) {
            const size_t off = rowQ * 512 + h * 64 + dd * 32 + 8 * g + 4 * hi;
            const u32x2 gg = *(const u32x2*)(G + off);
            const f32x16& o = dd ? o1 : o0;
            u32x2 w; w.x = cvt_pk(o[4 * g] * inv * bflo(gg.x), o[4 * g + 1] * inv * bfhi(gg.x)); w.y = cvt_pk(o[4 * g + 2] * inv * bflo(gg.y), o[4 * g + 3] * inv * bfhi(gg.y));
            *(u32x2*)(Y + off) = w;
        }
}

__device__ __forceinline__ int wave_total(int v) {
    v += __builtin_amdgcn_update_dpp(0, v, 0x111, 0xf, 0xf, false);
    v += __builtin_amdgcn_update_dpp(0, v, 0x112, 0xf, 0xf, false);
    v += __builtin_amdgcn_update_dpp(0, v, 0x114, 0xf, 0xf, false);
    v += __builtin_amdgcn_update_dpp(0, v, 0x118, 0xf, 0xf, false);
    v += __builtin_amdgcn_update_dpp(0, v, 0x142, 0xa, 0xf, false);
    v += __builtin_amdgcn_update_dpp(0, v, 0x143, 0xc, 0xf, false);
    return __builtin_amdgcn_readlane(v, 63);
}
#ifndef DSA_SELFCHECK
#define DSA_SELFCHECK 0
#endif
__device__ __forceinline__ void dsa_unit(LAS unsigned char* lds, unsigned char* ws, int b, int t0, int wid, int lane, bool do_store) {
    asm volatile("" : "+v"(lane));
    LAS float* sc = (LAS float*)lds;
    LAS int* lists = (LAS int*)(lds + 131072);
    const bf16_t* IQ = (const bf16_t*)(ws + WS_IQ); const bf16_t* IK = (const bf16_t*)(ws + WS_IK);
    const float* MF = (const float*)(ws + WS_MISCF);
    const bf16_t* DK = (const bf16_t*)(ws + WS_DK); const bf16_t* DV = (const bf16_t*)(ws + WS_DV);
    const bf16_t* GD = (const bf16_t*)(ws + WS_GD); bf16_t* QD = (bf16_t*)(ws + WS_QD);
    const size_t tokb = (size_t)b * SEQ;
    const int r32 = lane & 31, hi = lane >> 5;
    for (int ra_ = 0; ra_ < REP_DA; ++ra_) {
        const int a_ = r32 >> 3, uu = (r32 >> 2) & 1, bb = r32 & 3; const int qq = 2 * uu + (a_ >> 1), hd = 4 * (a_ & 1) + bb;
        bf16x8 af[2][4];
#pragma unroll
        for (int rt = 0; rt < 2; ++rt)
#pragma unroll
            for (int d0 = 0; d0 < 4; ++d0) af[rt][d0] = *(const bf16x8*)(IQ + (tokb + t0 + 4 * rt + qq) * 512 + hd * 64 + d0 * 16 + hi * 8);
        const float WSC = 0.35355339059327373f * 0.125f;
        float w[2][16];
#pragma unroll
        for (int rt = 0; rt < 2; ++rt)
#pragma unroll
            for (int qh = 0; qh < 2; ++qh) { const float* wp = MF + (tokb + t0 + 4 * rt + 2 * hi + qh) * 128 + 72; const f32x4 wa = *(const f32x4*)wp, wb = *(const f32x4*)(wp + 4);
#pragma unroll
                for (int e = 0; e < 4; ++e) { w[rt][8 * qh + e] = wa[e] * WSC; w[rt][8 * qh + 4 + e] = wb[e] * WSC; } }
        const int nkt = (t0 + 8 + 31) >> 5;
        bf16x8 bfr[4];
#pragma unroll
        for (int d0 = 0; d0 < 4; ++d0) bfr[d0] = *(const bf16x8*)(IK + (((size_t)b * 128 + (wid < nkt ? wid : 0)) * 4 + d0) * 512 + lane * 8);
        for (int kt = wid; kt < nkt; kt += 8) {
            const int key = kt * 32 + r32;
            bf16x8 bnx[4];
            { const int ktn = (kt + 8 < nkt) ? kt + 8 : kt;
#pragma unroll
              for (int d0 = 0; d0 < 4; ++d0) bnx[d0] = *(const bf16x8*)(IK + (((size_t)b * 128 + ktn) * 4 + d0) * 512 + lane * 8); }
            asm volatile("" ::: "memory");
            f32x16 c0, c1;
#pragma unroll
            for (int r = 0; r < 16; ++r) { c0[r] = 0.f; c1[r] = 0.f; }
#pragma unroll
            for (int d0 = 0; d0 < 4; ++d0) { c0 = mfma32(af[0][d0], bfr[d0], c0); c1 = mfma32(af[1][d0], bfr[d0], c1); }
            float s00 = 0.f, s01 = 0.f, s10 = 0.f, s11 = 0.f;
#pragma unroll
            for (int r = 0; r < 8; ++r) { s00 += w[0][r] * fmaxf(c0[r], 0.f); s01 += w[0][8 + r] * fmaxf(c0[8 + r], 0.f); s10 += w[1][r] * fmaxf(c1[r], 0.f); s11 += w[1][8 + r] * fmaxf(c1[8 + r], 0.f); }
            const int q00 = 2 * hi, q01 = 2 * hi + 1, q10 = 4 + 2 * hi, q11 = 5 + 2 * hi;
            sc[q00 * 4096 + key] = (key > t0 + q00) ? -INFINITY : s00;
            sc[q01 * 4096 + key] = (key > t0 + q01) ? -INFINITY : s01;
            sc[q10 * 4096 + key] = (key > t0 + q10) ? -INFINITY : s10;
            sc[q11 * 4096 + key] = (key > t0 + q11) ? -INFINITY : s11;
#pragma unroll
            for (int d0 = 0; d0 < 4; ++d0) bfr[d0] = bnx[d0];
        }
    }
    __syncthreads();
    const int t = t0 + wid, n = t + 1;
    int count; bool badsel = false; (void)badsel;
    for (int rb_ = 0; rb_ < REP_DB; ++rb_) {
        unsigned key[64];
        const LAS float* row = sc + wid * 4096;
#pragma unroll
        for (int j = 0; j < 64; ++j) { const int idx = j * 64 + lane; const int idc = idx < n ? idx : n - 1;
            const unsigned bits = __float_as_uint(row[idc]); const unsigned k = bits ^ (unsigned)(((int)bits >> 31) | (int)0x80000000);
            key[j] = idx < n ? k : 0u; }
        unsigned T = 0u; int cT = 0;
        const int nb8 = (n + 511) >> 9;
        bool bad = false; (void)bad;
#define DSA_COUNT(CAND, OUT) do { int cl_ = 0; _Pragma("unroll") for (int jb = 0; jb < 8; ++jb) { if (jb < nb8) { _Pragma("unroll") for (int j = 8 * jb; j < 8 * jb + 8; ++j) cl_ += (key[j] >= (CAND)) ? 1 : 0; } } \
            OUT = wave_total(cl_); \
            if (DSA_SELFCHECK) { int c2_ = 0; _Pragma("unroll") for (int j = 0; j < 64; ++j) c2_ += __builtin_popcountll(__ballot(key[j] >= (CAND))); if (c2_ != OUT) bad = true; } } while (0)
        if (n > 256) {
            int bit = 30, c;
            DSA_COUNT(0x80000000u, c);
            if (c >= 256) { T = 0x80000000u; cT = c;
                if (c > 256) {
                    unsigned mxk = 0u;
#pragma unroll
                    for (int jb = 0; jb < 8; ++jb) { if (jb < nb8) {
#pragma unroll
                        for (int j = 8 * jb; j < 8 * jb + 8; ++j) mxk = key[j] > mxk ? key[j] : mxk; } }
#pragma unroll
                    for (int o = 1; o < 64; o <<= 1) { const unsigned ov = (unsigned)__builtin_amdgcn_ds_bpermute((lane ^ o) << 2, (int)mxk); mxk = ov > mxk ? ov : mxk; }
                    unsigned cand = mxk & 0xFF800000u;
                    for (int tr_ = 0; tr_ < 4; ++tr_) { DSA_COUNT(cand, c); if (c >= 256) { T = cand; cT = c; bit = 22; break; } if (cand <= 0x80800000u) break; cand -= 0x00800000u; }
                }
            }
            for (; bit >= 0 && cT != 256; --bit) { const unsigned cand = T | (1u << bit); DSA_COUNT(cand, c); if (c >= 256) { T = cand; cT = c; } }
            if (DSA_SELFCHECK) {
                unsigned Tr = 0u; int cr = 0;
                for (int b2 = 31; b2 >= 0; --b2) { const unsigned cand = Tr | (1u << b2); int c2 = 0;
#pragma unroll
                    for (int j = 0; j < 64; ++j) c2 += __builtin_popcountll(__ballot(key[j] >= cand));
                    if (c2 >= 256) { Tr = cand; cr = c2; if (c2 == 256) break; } }
                if (cT == 256 || cr == 256) { if (cT != cr) bad = true; } else if (T != Tr) bad = true;
            }
        }
        if (n <= 256) {
            for (int p2 = lane; p2 < 256; p2 += 64) lists[wid * 256 + p2] = p2;
        } else if (cT == 256) {
            int cl = 0;
#pragma unroll
            for (int jb = 0; jb < 8; ++jb) { if (jb < nb8) {
#pragma unroll
                for (int j = 8 * jb; j < 8 * jb + 8; ++j) cl += (key[j] >= T) ? 1 : 0; } }
            int incl = cl;
#pragma unroll
            for (int o = 1; o < 64; o <<= 1) { const int nbv = __builtin_amdgcn_ds_bpermute(((lane >= o) ? (lane - o) : lane) << 2, incl); if (lane >= o) incl += nbv; }
            int off = wid * 256 + incl - cl;
#pragma unroll
            for (int jb = 0; jb < 8; ++jb) { if (jb < nb8) {
#pragma unroll
                for (int j = 8 * jb; j < 8 * jb + 8; ++j) { if (key[j] >= T) { lists[off] = j * 64 + lane; ++off; } } } }
        } else {
        int eqbase = 0;
#pragma unroll
        for (int j = 0; j < 64; ++j) { const int idx = j * 64 + lane;
            const bool eq = (key[j] == T); const unsigned long long meq = __ballot(eq); const int r = eqbase + mbcnt64(meq);
            if (eq && r < 256) lists[wid * 256 + 255 - r] = idx;
            eqbase += __builtin_popcountll(meq); __builtin_amdgcn_sched_barrier(0); }
        int base = 0;
#pragma unroll
        for (int j = 0; j < 64; ++j) { const int idx = j * 64 + lane;
            const bool gt = (key[j] > T); const unsigned long long mg = __ballot(gt); const int pos = base + mbcnt64(mg);
            if (gt) lists[wid * 256 + pos] = idx;
            base += __builtin_popcountll(mg); __builtin_amdgcn_sched_barrier(0); }
        }
        count = n < 256 ? n : 256; badsel = badsel || bad;
    }
    asm volatile("s_waitcnt lgkmcnt(0)" ::: "memory");
    __builtin_amdgcn_wave_barrier();
    for (int rc_ = 0; rc_ < REP_DC; ++rc_) {
        const bool do_store_c = do_store && (rc_ == REP_DC - 1);
        const int hh = lane & 15, g = lane >> 4;
        bf16x8 qb[2];
#pragma unroll
        for (int ks = 0; ks < 2; ++ks) { if (hh < 8) qb[ks] = *(const bf16x8*)(QD + (tokb + t) * 512 + hh * 64 + ks * 32 + g * 8); else qb[ks] = (bf16x8){0, 0, 0, 0, 0, 0, 0, 0}; }
        const LAS int* lw = lists + wid * 256;
        const int cg = count - 4 * g;
        float s[64];
        const int nhalf = (count > 128) ? 2 : 1;
        u32x4 vr[16];
        {
            bf16x8 ka[16][2];
#pragma unroll
            for (int tile = 0; tile < 16; ++tile) { const int idx = lw[tile * 16 + hh];
                ka[tile][0] = *(const bf16x8*)(DK + (tokb + idx) * 64 + g * 8); ka[tile][1] = *(const bf16x8*)(DK + (tokb + idx) * 64 + 32 + g * 8); }
#pragma unroll
            for (int i = 0; i < 16; ++i) { const int row = i * 8 + (lane >> 3); const int idx = lw[row]; vr[i] = *(const u32x4*)(DV + (tokb + idx) * 64 + (lane & 7) * 8); }
            asm volatile("" ::: "memory");
#pragma unroll
            for (int tile = 0; tile < 16; ++tile) {
                f32x4 c = (f32x4){0.f, 0.f, 0.f, 0.f}; c = mfma16(ka[tile][0], qb[0], c); c = mfma16(ka[tile][1], qb[1], c);
#pragma unroll
                for (int j = 0; j < 4; ++j) s[4 * tile + j] = (tile * 16 + j < cg) ? c[j] : -INFINITY; }
        }
        float mx = s[0];
#pragma unroll
        for (int j = 1; j < 64; ++j) mx = fmaxf(mx, s[j]);
        mx = fmaxf(mx, shx(mx, 16, lane)); mx = fmaxf(mx, shx32(mx, lane));
        float sum = 0.f;
#pragma unroll
        for (int j = 0; j < 64; ++j) { s[j] = ex2(s[j] - mx); sum += s[j]; }
        sum += shx(sum, 16, lane); sum += shx32(sum, lane);
        LAS unsigned char* vs = (LAS unsigned char*)(sc + wid * 4096);
        f32x4 oacc[4];
#pragma unroll
        for (int dt = 0; dt < 4; ++dt) oacc[dt] = (f32x4){0.f, 0.f, 0.f, 0.f};
        u32x2 ggv[4];
#pragma unroll
        for (int dt = 0; dt < 4; ++dt) ggv[dt] = *(const u32x2*)(GD + (tokb + t) * 512 + (hh & 7) * 64 + dt * 16 + 4 * g);
#pragma unroll
        for (int half = 0; half < 2; ++half) {
            if (half < nhalf) {
#pragma unroll
                for (int i = 0; i < 16; ++i) { const int row = i * 8 + (lane >> 3); const int phys = (lane & 7) ^ (2 * ((row >> 2) & 1) + 4 * ((row >> 1) & 1)); *(LAS u32x4*)(vs + row * 128 + phys * 16) = vr[i]; }
                asm volatile("s_waitcnt lgkmcnt(0)" ::: "memory");
                __builtin_amdgcn_wave_barrier();
                if (half == 0 && nhalf == 2) {
#pragma unroll
                    for (int i = 0; i < 16; ++i) { const int row = i * 8 + (lane >> 3); const int idx = lw[128 + row]; vr[i] = *(const u32x4*)(DV + (tokb + idx) * 64 + (lane & 7) * 8); }
                    asm volatile("" ::: "memory");
                }
                const int q_ = (lane >> 2) & 3, p_ = lane & 3;
#pragma unroll
                for (int ks = 0; ks < 4; ++ks) {
                    const int ta = 2 * (half * 4 + ks), tb = ta + 1;
                    const bf16x8 pb = pack8(s[4 * ta], s[4 * ta + 1], s[4 * ta + 2], s[4 * ta + 3], s[4 * tb], s[4 * tb + 1], s[4 * tb + 2], s[4 * tb + 3]);
#pragma unroll
                    for (int dt = 0; dt < 4; ++dt) {
                        const int phys = (2 * dt + (p_ >> 1)) ^ (2 * (g & 1) + 4 * (q_ >> 1));
                        LAS unsigned char* ap = vs + (4 * g + q_) * 128 + phys * 16 + 8 * (p_ & 1) + ks * 4096;
                        const bf16x4 lo = __builtin_bit_cast(bf16x4, __builtin_amdgcn_ds_read_tr16_b64_v4i16((LAS bf16x4*)ap));
                        const bf16x4 hi4 = __builtin_bit_cast(bf16x4, __builtin_amdgcn_ds_read_tr16_b64_v4i16((LAS bf16x4*)(ap + 2048)));
                        const bf16x8 va = (bf16x8){lo[0], lo[1], lo[2], lo[3], hi4[0], hi4[1], hi4[2], hi4[3]};
                        oacc[dt] = mfma16(va, pb, oacc[dt]);
                    }
                }
                asm volatile("s_waitcnt lgkmcnt(0)" ::: "memory");
                __builtin_amdgcn_wave_barrier();
            }
        }
        if (hh < 8 && do_store_c) {
            float inv = 1.0f / sum;
            if (DSA_SELFCHECK && badsel) inv = __builtin_nanf("");
#pragma unroll
            for (int dt = 0; dt < 4; ++dt) { const size_t off = (tokb + t) * 512 + hh * 64 + dt * 16 + 4 * g;
                const u32x2 gg = ggv[dt];
                u32x2 w; w.x = cvt_pk(oacc[dt][0] * inv * bflo(gg.x), oacc[dt][1] * inv * bfhi(gg.x)); w.y = cvt_pk(oacc[dt][2] * inv * bflo(gg.y), oacc[dt][3] * inv * bfhi(gg.y));
                *(u32x2*)(QD + off) = w; }
        }
    }
    __syncthreads();
}

#define XB_TMO      128
#define XB_XCNT(j)  (256  + 64 * (j))
#define XB_XSUB(j)  (1280 + 64 * (j))
#define XB_XGEN(j)  (2304 + 64 * (j))
#define XB_TOP      3328
#define XB_TOPGEN   3392
#define XCD_BAR_WORDS 3456
#define XB_SPIN_CAP (1u << 22)
__device__ __forceinline__ unsigned xb_ld(unsigned* p)              { return __hip_atomic_load(p, __ATOMIC_RELAXED, __HIP_MEMORY_SCOPE_AGENT); }
__device__ __forceinline__ unsigned xb_add(unsigned* p, unsigned v) { return __hip_atomic_fetch_add(p, v, __ATOMIC_RELAXED, __HIP_MEMORY_SCOPE_AGENT); }
__device__ __forceinline__ unsigned xb_xcc_id() { return (unsigned)__builtin_amdgcn_s_getreg((3 << 11) | 20) & 0xFu; }
#define XB_SPIN(cond, bar) do { unsigned _sp = 0; while (cond) { __builtin_amdgcn_s_sleep(1); \
    if ((++_sp & 255u) == 0u) { if (xb_ld(&(bar)[XB_TMO])) break; if (_sp > XB_SPIN_CAP) { atomicAdd(&(bar)[XB_TMO], 1u); break; } } } } while (0)
__device__ __forceinline__ void xcd_barrier_complete(unsigned* bar, unsigned x, unsigned G, unsigned& nloc, unsigned& nx) {
    unsigned sum, cnt, mine, sp = 0u;
    for (;;) {
        sum = 0u; cnt = 0u; mine = 0u;
#pragma unroll
        for (unsigned j = 0; j < 16; ++j) { const unsigned c = xb_ld(&bar[XB_XCNT(j)]); sum += c; cnt += (c > 0u) ? 1u : 0u; mine = (j == x) ? c : mine; }
        if (sum == G) break;
        __builtin_amdgcn_s_sleep(1);
        if ((++sp & 255u) == 0u) { if (xb_ld(&bar[XB_TMO])) break; if (sp > XB_SPIN_CAP) { atomicAdd(&bar[XB_TMO], 1u); break; } }
    }
    nloc = mine > 0u ? mine : 1u; nx = cnt > 0u ? cnt : 1u;
}
__device__ __forceinline__ void xcd_barrier(unsigned* bar, unsigned x, unsigned G, volatile LAS unsigned* st, bool leader) {
    asm volatile("s_waitcnt vmcnt(0)" ::: "memory");
    __syncthreads();
    if (leader) {
        __builtin_amdgcn_s_waitcnt(0);
        unsigned nloc = st[0], nx = st[1];
        if (nloc == 0u) { xcd_barrier_complete(bar, x, G, nloc, nx); st[0] = nloc; st[1] = nx; }
        const unsigned old = xb_add(&bar[XB_XSUB(x)], 1u);
        const unsigned gen = old / nloc;
        if (old + 1u == (gen + 1u) * nloc) {
            __builtin_amdgcn_fence(__ATOMIC_RELEASE, "agent");
            asm volatile("s_waitcnt vmcnt(0)" ::: "memory");
            const unsigned og = xb_add(&bar[XB_TOP], 1u);
            const unsigned tg = og / nx;
            if (og + 1u == (tg + 1u) * nx) xb_add(&bar[XB_TOPGEN], 1u);
            else XB_SPIN(xb_ld(&bar[XB_TOPGEN]) == tg, bar);
            __builtin_amdgcn_fence(__ATOMIC_ACQUIRE, "agent");
            xb_add(&bar[XB_XGEN(x)], 1u);
            asm volatile("s_waitcnt vmcnt(0)" ::: "memory");
        } else {
            XB_SPIN(xb_ld(&bar[XB_XGEN(x)]) == gen, bar);
            __builtin_amdgcn_fence(__ATOMIC_ACQUIRE, "agent");
            asm volatile("s_waitcnt vmcnt(0)" ::: "memory");
        }
    }
    __syncthreads();
}
__device__ __forceinline__ void grid_bar(unsigned* bar, unsigned target, unsigned gen, bool leader) {
    asm volatile("s_waitcnt vmcnt(0) lgkmcnt(0)" ::: "memory");
    __syncthreads();
    if (leader) {
        __builtin_amdgcn_fence(__ATOMIC_RELEASE, "agent");
        asm volatile("s_waitcnt vmcnt(0)" ::: "memory");
        const unsigned old = __hip_atomic_fetch_add(&bar[0], 1u, __ATOMIC_RELAXED, __HIP_MEMORY_SCOPE_AGENT);
        if (old + 1u == target) __hip_atomic_fetch_add(&bar[64], 1u, __ATOMIC_RELAXED, __HIP_MEMORY_SCOPE_AGENT);
        else while (__hip_atomic_load(&bar[64], __ATOMIC_RELAXED, __HIP_MEMORY_SCOPE_AGENT) <= gen) __builtin_amdgcn_s_sleep(1);
        __builtin_amdgcn_fence(__ATOMIC_ACQUIRE, "agent");
        asm volatile("s_waitcnt vmcnt(0)" ::: "memory");
    }
    __syncthreads();
}
#ifndef DBG
#define DBG 0
#endif
#ifndef REP_P2
#define REP_P2 1
#endif
#ifndef REP_FOX
#define REP_FOX 1
#endif
#ifndef REP_SB
#define REP_SB 1
#endif
#ifndef REP_DSA
#define REP_DSA 1
#endif
#ifndef REP_P0
#define REP_P0 1
#endif
#ifndef REP_P1
#define REP_P1 1
#endif
#ifndef REP_P3
#define REP_P3 1
#endif
#ifndef REP_P5A
#define REP_P5A 1
#endif
#ifndef REP_P5B
#define REP_P5B 1
#endif
#ifndef REP_BAR
#define REP_BAR 1
#endif
#ifndef REP_P6
#define REP_P6 1
#endif
#ifndef REP_FIN
#define REP_FIN 1
#endif
__device__ __forceinline__ float dbg_value(const unsigned char* ws, int m, int c) {
    auto B = [&](size_t off, size_t idx) { return bf2f(((const bf16_t*)(ws + off))[idx]); };
    const size_t r512 = (size_t)m * 512;
    if (DBG == 1) return B(WS_H, (size_t)m * 1024 + c);
    if (DBG == 2) {
        if (c < 512) return B(WS_QF, r512 + c) + B(WS_KF, r512 + c) + B(WS_GF, r512 + c) + B(WS_QD, r512 + c) + B(WS_IQ, r512 + c) + B(WS_GD, r512 + c) + B(WS_QS, r512 + c) + B(WS_KS, r512 + c) + B(WS_GS, r512 + c);
        if (c < 640) return B(WS_DCKV, (size_t)m * 128 + (c - 512));
        if (c < 768) return ((const float*)(ws + WS_MISCF))[(size_t)m * 128 + (c - 640)];
        { const int cc = c - 768; float v = 0.f; for (int q = 0; q < 4; ++q) v += B(WS_VT, (size_t)(4 * cc + q) * NTOK + m); return v; }
    }
    if (DBG == 3) {
        if (c < 64) return B(WS_DK, (size_t)m * 64 + c);
        if (c < 128) return B(WS_DV, (size_t)m * 64 + c - 64);
        if (c < 192) return B(WS_IK, (size_t)m * 64 + c - 128);
        if (c < 200) return ((const float*)(ws + WS_F2))[(size_t)((m >> 12) * 8 + (c - 192)) * SEQ + (m & 4095)];
        return 0.f;
    }
    if (DBG == 4 || DBG == 41 || DBG == 42 || DBG == 43) { if (c < 512) return B(WS_QF, r512 + c); return B(WS_QD, r512 + c - 512) + B(WS_QS, r512 + c - 512); }
    if (DBG == 5) return B(WS_M3, (size_t)m * 3072 + c) + B(WS_M3, (size_t)m * 3072 + 1024 + c) + B(WS_M3, (size_t)m * 3072 + 2048 + c);
    if (DBG == 6) return B(WS_MIX, (size_t)m * 1024 + c);
    return 0.f;
}
#define DBG_DUMP(k) if (DBG != 0 && (DBG == (k) || DBG / 10 == (k)) && l == 0) { KArgP ap2_ = (KArgP)__builtin_amdgcn_kernarg_segment_ptr(); float* o_ = ap2_->out; const unsigned char* w_ = ap2_->ws; \
        for (size_t e = (size_t)bx0 * NTHR + wid0 * 64 + lane_id_fresh(); e < (size_t)NTOK * 1024; e += (size_t)G0 * NTHR) o_[e] = dbg_value(w_, (int)(e >> 10), (int)(e & 1023)); return; }
#ifndef ONLY
#define ONLY -1
#endif
#define PH(k) (ONLY < 0 || ONLY == (k))
struct Args { const float* x; const float* c; const int* pos; const float* w_ada; const float* b_ada; const float* g_norm; const float* w_in; const float* b_fgt;
              const float* g_kv; const float* w_kv_up; const float* w_br[3]; const float* w_out; const float* g_final; float* out; unsigned char* ws; };

typedef const __attribute__((address_space(4))) Args* KArgP;
__global__ void __launch_bounds__(NTHR, 2) fwd_megakernel(Args A_kernarg) {
    extern __shared__ __attribute__((aligned(16))) unsigned char lds_raw[];
    LAS unsigned char* lds = (LAS unsigned char*)lds_raw;
    cg::grid_group grid = cg::this_grid();
    const int G0 = gridDim.x, bx0 = blockIdx.x;
    const int wid0 = __builtin_amdgcn_readfirstlane((int)threadIdx.x >> 6);
    const unsigned xcc_id = xb_xcc_id();
    unsigned* const barp = (unsigned*)(((KArgP)__builtin_amdgcn_kernarg_segment_ptr())->ws + 4096);
    if (threadIdx.x == 0) { ((volatile LAS unsigned*)(lds + 147000))[0] = 0u; ((volatile LAS unsigned*)(lds + 147000))[1] = 0u;
        (void)xb_add(barp + XB_XCNT(xcc_id), 1u); }
    __syncthreads();
#define LOAD_ARGS KArgP ap_ = (KArgP)__builtin_amdgcn_kernarg_segment_ptr(); int G = G0, bx = bx0; asm volatile("" : "+s"(ap_), "+s"(G), "+s"(bx)); const int NGW = G * NWAVES; (void)NGW; unsigned char* ws = A.ws; float* MOD = (float*)(ws + WS_MOD); (void)MOD;
#define A (*ap_)
#define PHASE_VARS LOAD_ARGS int lane = lane_id_fresh(); asm volatile("" : "+v"(lane)); const int wid = wid0; const int tid = wid * 64 + lane; (void)tid; const int gw = bx * NWAVES + wid; LAS float* scr = (LAS float*)(lds + wid * 16384); (void)scr; (void)gw; (void)lane;

    if constexpr (PH(0)) for (int rep_ = 0; rep_ < REP_P0; ++rep_) {
        PHASE_VARS
        LAS float* red = (LAS float*)lds;
        LAS float* sl = (LAS float*)(lds + 32768);
        if (bx < 96) {
#pragma unroll
            for (int i = 0; i < 16; ++i) { const float cv = A.c[tid + i * NTHR]; sl[tid + i * NTHR] = cv / (1.0f + __expf(-cv)); } }
        __syncthreads();
        for (int it = bx; it < 96; it += G) {
            const int l = it / 48, cgp = it % 48, cc = tid & 63, kp = tid >> 6; const int col = cgp * 64 + cc;
            float acc[8];
#pragma unroll
            for (int b = 0; b < 8; ++b) acc[b] = 0.f;
            const float* wp = A.w_ada + ((size_t)l * 1024 + kp * 128) * 3072 + col;
#pragma unroll 32
            for (int k = 0; k < 128; ++k) { const float w = wp[(size_t)k * 3072];
#pragma unroll
                for (int b = 0; b < 8; ++b) acc[b] += sl[b * 1024 + kp * 128 + k] * w; }
#pragma unroll
            for (int b = 0; b < 8; ++b) red[(kp * 8 + b) * 64 + cc] = acc[b];
            __syncthreads();
            { const int b = tid >> 6; float s = 0.f;
#pragma unroll
              for (int k2 = 0; k2 < 8; ++k2) s += red[(k2 * 8 + b) * 64 + cc];
              MOD[((size_t)l * 8 + b) * 3072 + col] = s + A.b_ada[l * 3072 + col]; }
            __syncthreads();
        }
        f32x2* CS = (f32x2*)(ws + WS_CS);
        for (int e = bx * NTHR + tid; e < NTOK * 32; e += G * NTHR) { const int tok = e >> 5, i = e & 31;
            const double rev = (double)A.pos[tok] * INVF[i] * 0.15915494309189535; const double fr = rev - floor(rev); const float f = (float)fr;
            CS[e] = (f32x2){__builtin_amdgcn_cosf(f), __builtin_amdgcn_sinf(f)}; }
        __syncthreads();
        for (int it = gw; it < 2 * (3 * 256 + 512); it += NGW) { const int l = it / 1280; int r = it % 1280;
            if (r < 768) { const int br = r / 256; transpose_item<false>(A.w_br[br] + (size_t)l * 512 * 1024, 512, 1024, 1024, (bf16_t*)(ws + WS_WTBR) + ((size_t)l * 3 + br) * 1024 * 512, scr, r % 256, lane); }
            else { r -= 768; transpose_item<false>(A.w_out + (size_t)l * 1024 * 1024, 1024, 1024, 1024, (bf16_t*)(ws + WS_WTOUT) + (size_t)l * 1024 * 1024, scr, r, lane); } }
    }
    if (G0 == 0x7fffff01) grid.sync();
    { const int ln_ = lane_id_fresh(); unsigned* bp_ = barp; unsigned xc_ = xcc_id; asm volatile("" : "+s"(bp_), "+s"(xc_)); xcd_barrier(bp_, xc_, (unsigned)G0, (volatile LAS unsigned*)(lds + 147000), wid0 == 0 && ln_ == 0); }

    for (int l = 0; l < DEPTH; ++l) {
        if constexpr (PH(1)) for (int rep_ = 0; rep_ < REP_P1; ++rep_) {
            PHASE_VARS
            const float* xsrc = (l == 0) ? A.x : A.out;
            for (int it = gw; it < 16 * (NPAD / 32); it += NGW) transpose_item<true>(A.w_in + (size_t)l * 1024 * NIN, 1024, NIN, NPAD, (bf16_t*)(ws + WS_WTIN), scr, it, lane);
            bf16_t* H = (bf16_t*)(ws + WS_H); const float* gn = A.g_norm + l * 1024;
            for (int m0 = gw * 4; m0 < NTOK; m0 += NGW * 4) {
                f32x4 v[4][4]; float ss[4];
#pragma unroll
                for (int r = 0; r < 4; ++r) { const f32x4* xr = (const f32x4*)(xsrc + (size_t)(m0 + r) * 1024) + lane; ss[r] = 0.f;
#pragma unroll
                    for (int j = 0; j < 4; ++j) v[r][j] = xr[64 * j]; }
#pragma unroll
                for (int r = 0; r < 4; ++r)
#pragma unroll
                    for (int j = 0; j < 4; ++j) ss[r] += (v[r][j][0] * v[r][j][0] + v[r][j][1] * v[r][j][1]) + (v[r][j][2] * v[r][j][2] + v[r][j][3] * v[r][j][3]);
#pragma unroll
                for (int o = 1; o < 64; o <<= 1) {
#pragma unroll
                    for (int r = 0; r < 4; ++r) ss[r] += shx(ss[r], o, lane); }
                const float* mp = MOD + ((size_t)l * 8 + (m0 >> 12)) * 3072;
#pragma unroll
                for (int j = 0; j < 4; ++j) { const int col = 4 * lane + 256 * j;
                    const f32x4 gg = *(const f32x4*)(gn + col), sh = *(const f32x4*)(mp + col), scl = *(const f32x4*)(mp + 1024 + col);
                    const f32x4 gs = gg * (scl + 1.0f);
#pragma unroll
                    for (int r = 0; r < 4; ++r) { const float rstd = 1.0f / sqrtf(ss[r] * (1.0f / 1024.f) + EPS);
                        const f32x4 hv = v[r][j] * rstd * gs + sh;
                        u32x2 w; w.x = cvt_pk(hv[0], hv[1]); w.y = cvt_pk(hv[2], hv[3]);
                        *(u32x2*)(H + (size_t)(m0 + r) * 1024 + col) = w; } }
            }
        }
        { const int ln_ = lane_id_fresh(); unsigned* bp_ = barp; unsigned xc_ = xcc_id; asm volatile("" : "+s"(bp_), "+s"(xc_)); xcd_barrier(bp_, xc_, (unsigned)G0, (volatile LAS unsigned*)(lds + 147000), wid0 == 0 && ln_ == 0); }
        DBG_DUMP(1)
        if constexpr (PH(2)) {
            LOAD_ARGS
            for (int rep_ = 0; rep_ < REP_P2; ++rep_) {
            pg8::SchedStd S; S.init(ws + WS_H, ws + WS_WTIN, NTOK, 19 * 256, 1024, G, bx);
            EpiIn E{ws};
            pg8::gemm_phase<EpiIn, pg8::SchedStd>(lds, 1024, S, E, wid0);
            pg8::SchedStd S2; S2.init(ws + WS_WTIN + (size_t)31 * 256 * 1024 * 2, ws + WS_H, 1024, NTOK, 1024, G, bx);
            EpiPlain E2{(bf16_t*)(ws + WS_VT), (size_t)NTOK};
            pg8::gemm_phase<EpiPlain, pg8::SchedStd>(lds, 1024, S2, E2, wid0);
            }
        }
        { const int ln_ = lane_id_fresh(); unsigned* bp_ = barp; unsigned xc_ = xcc_id; asm volatile("" : "+s"(bp_), "+s"(xc_)); xcd_barrier(bp_, xc_, (unsigned)G0, (volatile LAS unsigned*)(lds + 147000), wid0 == 0 && ln_ == 0); }
        DBG_DUMP(2)
        if constexpr (PH(3)) for (int rep_ = 0; rep_ < REP_P3; ++rep_) {
            PHASE_VARS
            const float* MF = (const float*)(ws + WS_MISCF);
            if (bx < 64) {
                const int b = bx >> 3, h = bx & 7; const float bf = A.b_fgt[l * 8 + h];
                const float* mfp = MF + ((size_t)b * SEQ + tid * 8) * 128 + 64 + h;
                float v[8]; float run = 0.f;
#pragma unroll
                for (int i = 0; i < 8; ++i) { const float xx = mfp[(size_t)i * 128] + bf; run += -lg2(1.0f + ex2(-xx * LOG2E)); v[i] = run; }
                float incl = run;
#pragma unroll
                for (int o = 1; o < 64; o <<= 1) { const float nb = __int_as_float(__builtin_amdgcn_ds_bpermute(((lane >= o) ? (lane - o) : lane) << 2, __float_as_int(incl))); if (lane >= o) incl += nb; }
                LAS float* wt = (LAS float*)(lds + 70000);
                if (lane == 63) wt[wid] = incl;
                __syncthreads();
                float off = 0.f;
#pragma unroll
                for (int w2 = 0; w2 < 8; ++w2) { const float tv = wt[w2]; if (w2 < wid) off += tv; }
                const float excl = incl - run + off;
                float* Fo = (float*)(ws + WS_F2) + (size_t)bx * SEQ + tid * 8;
                *(f32x4*)Fo = (f32x4){v[0] + excl, v[1] + excl, v[2] + excl, v[3] + excl}; *(f32x4*)(Fo + 4) = (f32x4){v[4] + excl, v[5] + excl, v[6] + excl, v[7] + excl};
            }
            for (int blk = gw; blk < 8 * 8 * 64; blk += NGW) {
                const bf16_t* kb = (const bf16_t*)(ws + WS_KF) + (size_t)blk * 4096; float mxk = 0.f;
#pragma unroll
                for (int hf = 0; hf < 2; ++hf) { float ss = 0.f;
#pragma unroll
                    for (int d0 = 0; d0 < 4; ++d0) { const bf16x8 v = *(const bf16x8*)(kb + ((hf * 4 + d0) * 64 + lane) * 8);
#pragma unroll
                        for (int e = 0; e < 8; ++e) { const float f = bf2f((bf16_t)v[e]); ss += f * f; } }
                    ss += shx32(ss, lane); mxk = fmaxf(mxk, ss); }
#pragma unroll
                for (int o = 1; o < 32; o <<= 1) mxk = fmaxf(mxk, shx(mxk, o, lane));
                if (lane == 0) __hip_atomic_fetch_max((unsigned*)ws + 128 + l * 64 + (blk >> 6), __float_as_uint(mxk), __ATOMIC_RELAXED, __HIP_MEMORY_SCOPE_AGENT);
            }
            LAS float* Wl = (LAS float*)lds;
            { const f32x4* wsrc = (const f32x4*)(A.w_kv_up + (size_t)l * 128 * 128);
#pragma unroll
              for (int i = 0; i < 8; ++i) ((LAS f32x4*)Wl)[tid + i * NTHR] = wsrc[tid + i * NTHR]; }
            __syncthreads();
            const bf16_t* DC = (const bf16_t*)(ws + WS_DCKV); const f32x2* CS = (const f32x2*)(ws + WS_CS);
            bf16_t* DK = (bf16_t*)(ws + WS_DK); bf16_t* DV = (bf16_t*)(ws + WS_DV); bf16_t* IKo = (bf16_t*)(ws + WS_IK);
            const float gk0 = A.g_kv[l * 128 + lane], gk1 = A.g_kv[l * 128 + 64 + lane];
            for (int t4 = gw; t4 < NTOK / 4; t4 += NGW) {
                float n0[4], n1[4], a0[4], a1[4];
#pragma unroll
                for (int q = 0; q < 4; ++q) { const size_t tok = (size_t)t4 * 4 + q; const float x0 = bf2f(DC[tok * 128 + lane]), x1 = bf2f(DC[tok * 128 + 64 + lane]);
                    const float rstd = 1.0f / sqrtf(wave_sum(x0 * x0 + x1 * x1, lane) * (1.0f / 128.f) + EPS);
                    n0[q] = x0 * rstd * gk0; n1[q] = x1 * rstd * gk1; a0[q] = 0.f; a1[q] = 0.f; }
#pragma unroll 4
                for (int k = 0; k < 64; ++k) { const float w0 = Wl[k * 128 + lane], w1 = Wl[k * 128 + 64 + lane];
#pragma unroll
                    for (int q = 0; q < 4; ++q) { const float nk = __builtin_bit_cast(float, __builtin_amdgcn_readlane(__builtin_bit_cast(int, n0[q]), k)); a0[q] += nk * w0; a1[q] += nk * w1; } }
#pragma unroll 4
                for (int k = 0; k < 64; ++k) { const float w0 = Wl[(64 + k) * 128 + lane], w1 = Wl[(64 + k) * 128 + 64 + lane];
#pragma unroll
                    for (int q = 0; q < 4; ++q) { const float nk = __builtin_bit_cast(float, __builtin_amdgcn_readlane(__builtin_bit_cast(int, n1[q]), k)); a0[q] += nk * w0; a1[q] += nk * w1; } }
#pragma unroll
                for (int q = 0; q < 4; ++q) { const size_t tok = (size_t)t4 * 4 + q; const f32x2 cs = CS[tok * 32 + (lane & 31)];
                    const float pk = shx32(a0[q], lane);
                    const float kr = (lane < 32) ? (a0[q] * cs[0] - pk * cs[1]) : (a0[q] * cs[0] + pk * cs[1]);
                    DK[tok * 64 + lane] = (bf16_t)(cvt_pk(kr, 0.f) & 0xffffu); DV[tok * 64 + lane] = (bf16_t)(cvt_pk(a1[q], 0.f) & 0xffffu);
                    const float xi = MF[tok * 128 + lane]; const float pi = shx32(xi, lane);
                    const float ir = (lane < 32) ? (xi * cs[0] - pi * cs[1]) : (xi * cs[0] + pi * cs[1]);
                    IKo[(((tok >> 5) * 4 + (lane >> 4)) * 64 + ((lane >> 3) & 1) * 32 + (tok & 31)) * 8 + (lane & 7)] = (bf16_t)(cvt_pk(ir, 0.f) & 0xffffu); }
            }
            __syncthreads();
        }
        { const int ln_ = lane_id_fresh(); unsigned* bp_ = barp; unsigned xc_ = xcc_id; asm volatile("" : "+s"(bp_), "+s"(xc_)); xcd_barrier(bp_, xc_, (unsigned)G0, (volatile LAS unsigned*)(lds + 147000), wid0 == 0 && ln_ == 0); }
        DBG_DUMP(3)
        if constexpr (PH(4) || PH(8) || PH(9)) {
            PHASE_VARS
            const int b = bx & 7, w = bx >> 3, GW = (G + 7) >> 3;
            if constexpr (PH(4) && (DBG != 42 && DBG != 43)) for (int rep_ = 0; rep_ < REP_FOX; ++rep_) for (int u = w; u < 128; u += GW) { const int qb = u >> 3, h = (u + 2 * (u / GW)) & 7; const bool st_ = (rep_ == REP_FOX - 1) || (G0 == 0x7fffff01);
                attn_fs_wave<false>((const bf16_t*)(ws + WS_QF), (const bf16_t*)(ws + WS_KF), (const bf16_t*)(ws + WS_VT), (const float*)(ws + WS_F2), (const bf16_t*)(ws + WS_GF), (bf16_t*)(ws + WS_QF), b, h, qb * 256 + wid * 32, lane, st_, (const unsigned*)ws + 128 + l * 64); }
            if constexpr (PH(8) && (DBG != 41 && DBG != 43)) for (int rep_ = 0; rep_ < REP_SB; ++rep_) for (int u = w; u < 128; u += GW) { const int qb = u >> 3, h = (u + 2 * (u / GW)) & 7; const bool st_ = (rep_ == REP_SB - 1) || (G0 == 0x7fffff01);
                attn_fs_wave<true>((const bf16_t*)(ws + WS_QS), (const bf16_t*)(ws + WS_KS), (const bf16_t*)(ws + WS_VT) + (size_t)512 * NTOK, nullptr, (const bf16_t*)(ws + WS_GS), (bf16_t*)(ws + WS_QS), b, h, qb * 256 + wid * 32, lane, st_, nullptr); }
            __syncthreads();
            if constexpr (PH(9) && (DBG != 41 && DBG != 42)) {
                unsigned* qcnt = (unsigned*)ws + 256 + l * 8 + b; LAS int* ubox = (LAS int*)(lds + 147008);
                if (tid == 0) *ubox = (int)__hip_atomic_fetch_add(qcnt, 1u, __ATOMIC_RELAXED, __HIP_MEMORY_SCOPE_AGENT);
                __syncthreads();
                int k = *ubox;
                while (k < 512) {
                    int nxt = 0;
                    if (tid == 0) nxt = (int)__hip_atomic_fetch_add(qcnt, 1u, __ATOMIC_RELAXED, __HIP_MEMORY_SCOPE_AGENT);
                    dsa_unit(lds, ws, b, (511 - k) * 8, wid, lane, true);
                    if (tid == 0) *ubox = nxt;
                    __syncthreads();
                    k = *ubox;
                }
            }
        }
        { const int ln_ = lane_id_fresh(); unsigned* bp_ = barp; unsigned xc_ = xcc_id; asm volatile("" : "+s"(bp_), "+s"(xc_)); xcd_barrier(bp_, xc_, (unsigned)G0, (volatile LAS unsigned*)(lds + 147000), wid0 == 0 && ln_ == 0); }
        DBG_DUMP(4)
        if constexpr (PH(5)) for (int rep_ = 0; rep_ < REP_P5A; ++rep_) {
            LOAD_ARGS
            pg8::SchedStd S; S.init(ws + WS_H, ws + WS_WTIN + (size_t)19 * 256 * 1024 * 2, NTOK, 3072, 1024, G, bx);
            EpiMerge E{(unsigned char*)(ws + WS_M3)};
            pg8::gemm_phase<EpiMerge, pg8::SchedStd>(lds, 1024, S, E, wid0);
        }
        { const int ln_ = lane_id_fresh(); unsigned* bp_ = barp; unsigned xc_ = xcc_id; asm volatile("" : "+s"(bp_), "+s"(xc_)); xcd_barrier(bp_, xc_, (unsigned)G0, (volatile LAS unsigned*)(lds + 147000), wid0 == 0 && ln_ == 0); }
        DBG_DUMP(5)
        if constexpr (PH(6)) for (int rep_ = 0; rep_ < REP_P5B; ++rep_) {
            LOAD_ARGS
            pg8::SchedMix S{(const char*)(ws + WS_QF), (const char*)(ws + WS_WTBR) + (size_t)l * 3 * 1024 * 512 * 2, G, bx};
            EpiMix E{(const unsigned char*)(ws + WS_M3), (bf16_t*)(ws + WS_MIX)};
            pg8::gemm_phase<EpiMix, pg8::SchedMix>(lds, 512, S, E, wid0);
        }
        { const int ln_ = lane_id_fresh(); unsigned* bp_ = barp; unsigned xc_ = xcc_id; asm volatile("" : "+s"(bp_), "+s"(xc_)); xcd_barrier(bp_, xc_, (unsigned)G0, (volatile LAS unsigned*)(lds + 147000), wid0 == 0 && ln_ == 0); }
        DBG_DUMP(6)
        if constexpr (PH(7)) for (int rep_ = 0; rep_ < (l == 0 ? REP_P6 : 1); ++rep_) {
            LOAD_ARGS
            const float* xsrc = (l == 0) ? A.x : A.out;
            pg8::SchedStd S; S.init(ws + WS_MIX, ws + WS_WTOUT + (size_t)l * 1024 * 1024 * 2, NTOK, 1024, 1024, G, bx);
            EpiOut E{xsrc, A.out, MOD + (size_t)l * 8 * 3072 + 2048};
            pg8::gemm_phase<EpiOut, pg8::SchedStd>(lds, 1024, S, E, wid0);
        }
        { const int ln_ = lane_id_fresh(); unsigned* bp_ = barp; unsigned xc_ = xcc_id; asm volatile("" : "+s"(bp_), "+s"(xc_)); xcd_barrier(bp_, xc_, (unsigned)G0, (volatile LAS unsigned*)(lds + 147000), wid0 == 0 && ln_ == 0); }
        DBG_DUMP(7)
        for (int rb_ = 1; rb_ < REP_BAR; ++rb_) { const int ln_ = lane_id_fresh(); unsigned* bp_ = barp; unsigned xc_ = xcc_id; asm volatile("" : "+s"(bp_), "+s"(xc_)); xcd_barrier(bp_, xc_, (unsigned)G0, (volatile LAS unsigned*)(lds + 147000), wid0 == 0 && ln_ == 0); }
    }
    PHASE_VARS
    for (int rep_ = 0; rep_ < REP_FIN; ++rep_)
    for (int m0 = gw * 4; m0 < NTOK; m0 += NGW * 4) {
        f32x4 v[4][4]; float ss[4];
#pragma unroll
        for (int r = 0; r < 4; ++r) { const f32x4* xr = (const f32x4*)(A.out + (size_t)(m0 + r) * 1024) + lane; ss[r] = 0.f;
#pragma unroll
            for (int j = 0; j < 4; ++j) v[r][j] = xr[64 * j]; }
        f32x4 gg[4];
#pragma unroll
        for (int j = 0; j < 4; ++j) gg[j] = *(const f32x4*)(A.g_final + 4 * lane + 256 * j);
#pragma unroll
        for (int r = 0; r < 4; ++r)
#pragma unroll
            for (int j = 0; j < 4; ++j) ss[r] += (v[r][j][0] * v[r][j][0] + v[r][j][1] * v[r][j][1]) + (v[r][j][2] * v[r][j][2] + v[r][j][3] * v[r][j][3]);
#pragma unroll
        for (int o = 1; o < 64; o <<= 1) {
#pragma unroll
            for (int r = 0; r < 4; ++r) ss[r] += shx(ss[r], o, lane); }
#pragma unroll
        for (int r = 0; r < 4; ++r) { const float rstd = 1.0f / sqrtf(ss[r] * (1.0f / 1024.f) + EPS); f32x4* xo = (f32x4*)(A.out + (size_t)(m0 + r) * 1024) + lane;
#pragma unroll
            for (int j = 0; j < 4; ++j) { if (rep_ == REP_FIN - 1 || G0 == 0x7fffff01) xo[64 * j] = v[r][j] * rstd * gg[j]; } }
    }
}

#undef A
extern "C" void kernel_launch(void* const* d_in, const int* in_sizes, int n_in, void* d_out, int out_size, void* d_ws, size_t ws_size, hipStream_t stream) {
    static int grid = 0;
    if (grid == 0) {
        if (n_in != 15 || ws_size < WS_END) { fprintf(stderr, "kernel_launch: unexpected n_in %d / ws %zu\n", n_in, ws_size); grid = -1; return; }
        int dev = 0, cus = 0, per_cu = 0;
        hipGetDevice(&dev);
        hipDeviceGetAttribute(&cus, hipDeviceAttributeMultiprocessorCount, dev);
        hipFuncSetAttribute((const void*)fwd_megakernel, hipFuncAttributeMaxDynamicSharedMemorySize, LDS_BYTES);
        hipOccupancyMaxActiveBlocksPerMultiprocessor(&per_cu, (const void*)fwd_megakernel, NTHR, LDS_BYTES);
        if (per_cu < 1) per_cu = 1;
        grid = cus * per_cu;
    }
    if (grid < 0) return;
    Args a{};
    a.x = (const float*)d_in[0]; a.c = (const float*)d_in[1]; a.pos = (const int*)d_in[2]; a.w_ada = (const float*)d_in[3]; a.b_ada = (const float*)d_in[4];
    a.g_norm = (const float*)d_in[5]; a.w_in = (const float*)d_in[6]; a.b_fgt = (const float*)d_in[7]; a.g_kv = (const float*)d_in[8]; a.w_kv_up = (const float*)d_in[9];
    a.w_br[0] = (const float*)d_in[10]; a.w_br[1] = (const float*)d_in[11]; a.w_br[2] = (const float*)d_in[12]; a.w_out = (const float*)d_in[13]; a.g_final = (const float*)d_in[14];
    a.out = (float*)d_out; a.ws = (unsigned char*)d_ws;
    hipMemsetAsync(d_ws, 0, 32768, stream);
    void* args[] = {&a};
    hipError_t e = hipLaunchCooperativeKernel((const void*)fwd_megakernel, dim3(grid), dim3(NTHR), args, LDS_BYTES, stream);
    if (e != hipSuccess) fprintf(stderr, "cooperative launch failed: %s (grid %d)\n", hipGetErrorString(e), grid);
}
```

```cpp
#include <hip/hip_runtime.h>
#include <hip/hip_cooperative_groups.h>
#include <cstdio>
#include <cstdint>
namespace cg = cooperative_groups;
#ifndef REP_DA
#define REP_DA 1
#endif
#ifndef REP_DB
#define REP_DB 1
#endif
#ifndef REP_DC
#define REP_DC 1
#endif

#define LAS __attribute__((address_space(3)))
typedef unsigned short bf16_t;
typedef short bf16x8 __attribute__((ext_vector_type(8)));
typedef short bf16x4 __attribute__((ext_vector_type(4)));
typedef float f32x4 __attribute__((ext_vector_type(4)));
typedef float f32x2 __attribute__((ext_vector_type(2)));
typedef float f32x16 __attribute__((ext_vector_type(16)));
typedef unsigned u32x4 __attribute__((ext_vector_type(4)));
typedef unsigned u32x2 __attribute__((ext_vector_type(2)));

constexpr int DM = 1024, NB = 8, SEQ = 4096, NTOK = NB * SEQ, DEPTH = 2;
constexpr int NIN = 8912, NPAD = 8960;
constexpr float LOG2E = 1.4426950408889634f;
constexpr float C2 = 0.125f * LOG2E;
constexpr float EPS = 1e-6f;
constexpr int NWAVES = 8, NTHR = 512;
constexpr int LDS_BYTES = 147456;

constexpr size_t MiB = 1u << 20;
constexpr size_t WS_MOD = 1 * MiB;
constexpr size_t WS_F2 = 2 * MiB;
constexpr size_t WS_CS = 8 * MiB;
constexpr size_t WS_WTBR = 16 * MiB;
constexpr size_t WS_WTOUT = 22 * MiB;
constexpr size_t WS_WTIN = 28 * MiB;
constexpr size_t WS_H = 46 * MiB;
constexpr size_t WS_QF = 110 * MiB;
constexpr size_t WS_QD = 142 * MiB;
constexpr size_t WS_QS = 174 * MiB;
constexpr size_t WS_GF = 206 * MiB;
constexpr size_t WS_GD = 238 * MiB;
constexpr size_t WS_GS = 270 * MiB;
constexpr size_t WS_MIX = 206 * MiB;
constexpr size_t WS_KF = 302 * MiB;
constexpr size_t WS_KS = 334 * MiB;
constexpr size_t WS_VT = 366 * MiB;
constexpr size_t WS_IQ = 430 * MiB;
constexpr size_t WS_DCKV = 462 * MiB;
constexpr size_t WS_MISCF = 470 * MiB;
constexpr size_t WS_DK = 486 * MiB;
constexpr size_t WS_DV = 490 * MiB;
constexpr size_t WS_M3 = 302 * MiB;
constexpr size_t WS_IK = 494 * MiB;
constexpr size_t WS_END = 498 * MiB;

__device__ const double INVF[32] = {1.0, 0.7498942093324559, 0.5623413251903491, 0.4216965034285822, 0.31622776601683794, 0.23713737056616552, 0.1778279410038923, 0.1333521432163324, 0.1, 0.07498942093324558, 0.05623413251903491, 0.042169650342858224, 0.03162277660168379, 0.023713737056616554, 0.01778279410038923, 0.01333521432163324, 0.01, 0.007498942093324558, 0.005623413251903491, 0.004216965034285823, 0.0031622776601683794, 0.0023713737056616554, 0.0017782794100389228, 0.001333521432163324, 0.001, 0.0007498942093324559, 0.0005623413251903491, 0.00042169650342858224, 0.00031622776601683794, 0.00023713737056616554, 0.00017782794100389227, 0.0001333521432163324};

typedef __bf16 bf16x2_t __attribute__((ext_vector_type(2)));
__device__ __forceinline__ unsigned cvt_pk(float lo, float hi) { f32x2 v = {lo, hi}; bf16x2_t b = __builtin_convertvector(v, bf16x2_t); return __builtin_bit_cast(unsigned, b); }
__device__ __forceinline__ float bf2f(bf16_t v) { return __uint_as_float((unsigned)v << 16); }
__device__ __forceinline__ float bflo(unsigned w) { return __uint_as_float(w << 16); }
__device__ __forceinline__ float bfhi(unsigned w) { return __uint_as_float(w & 0xffff0000u); }
__device__ __forceinline__ float ex2(float x) { return __builtin_amdgcn_exp2f(x); }
__device__ __forceinline__ float lg2(float x) { return __builtin_amdgcn_logf(x); }
__device__ __forceinline__ float sigmoidf_(float x) { return __builtin_amdgcn_rcpf(1.0f + ex2(-x * LOG2E)); }
__device__ __forceinline__ int lane_id_fresh() { unsigned ones = ~0u; asm volatile("" : "+s"(ones)); return __builtin_amdgcn_mbcnt_hi(ones, __builtin_amdgcn_mbcnt_lo(ones, 0u)); }
__device__ __forceinline__ float shx(float v, int o, int lane) { return __int_as_float(__builtin_amdgcn_ds_bpermute((lane ^ o) << 2, __float_as_int(v))); }
__device__ __forceinline__ float shx32(float v, int lane) {
    const auto rr = __builtin_amdgcn_permlane32_swap(__float_as_uint(v), __float_as_uint(v), false, false);
    return __uint_as_float((lane & 32) ? rr[0] : rr[1]);
}
__device__ __forceinline__ float wave_sum(float v, int lane) {
#pragma unroll
    for (int o = 1; o < 64; o <<= 1) v += shx(v, o, lane);
    return v;
}
__device__ __forceinline__ int crow(int r, int hi) { return (r & 3) + 8 * (r >> 2) + 4 * hi; }
__device__ __forceinline__ f32x16 mfma32(bf16x8 a, bf16x8 b, f32x16 c) { return __builtin_amdgcn_mfma_f32_32x32x16_bf16(a, b, c, 0, 0, 0); }
__device__ __forceinline__ f32x4 mfma16(bf16x8 a, bf16x8 b, f32x4 c) { return __builtin_amdgcn_mfma_f32_16x16x32_bf16(a, b, c, 0, 0, 0); }
__device__ __forceinline__ bf16x8 pack8(float a0, float a1, float a2, float a3, float a4, float a5, float a6, float a7) {
    u32x4 w; w.x = cvt_pk(a0, a1); w.y = cvt_pk(a2, a3); w.z = cvt_pk(a4, a5); w.w = cvt_pk(a6, a7); return __builtin_bit_cast(bf16x8, w);
}
__device__ __forceinline__ int mbcnt64(unsigned long long m) { return __builtin_amdgcn_mbcnt_hi((unsigned)(m >> 32), __builtin_amdgcn_mbcnt_lo((unsigned)m, 0u)); }

namespace pg8 {
constexpr int BM = 256, BK = 64, HALF = 128, HTB = HALF * BK * 2, STAGE_BYTES = 8 * HTB, NXCD = 8, WGM = 8;
__device__ __forceinline__ int lds_byte(int r, int c) { const int st = (r >> 4) * 2 + (c >> 5), rr = r & 15, cc = c & 31, ob = rr * 64 + cc * 2; return st * 1024 + (ob ^ (((ob >> 9) & 1) << 5)); }
__device__ __forceinline__ void stage_rc(int b, int& R, int& C) { const int st = b / 1024, sb = b % 1024, swz = sb ^ (((sb >> 9) & 1) << 5); R = (st >> 1) * 16 + swz / 64; C = (st & 1) * 32 + (swz % 64) / 2; }
__device__ __forceinline__ int perm32(int rho) { const int n = rho >> 4, i = rho & 15; return 8 * (i >> 2) + 4 * n + (i & 3); }
struct Unit { int pm, pn, aux; };

struct StaticOrder {
    int nM, nN, nwg, G, c;
    __device__ void init(int M, int N, int G_, int c_) { nM = M / BM; nN = N / BM; nwg = nM * nN; G = G_; c = c_; }
    __device__ bool next(int i, Unit& u) const {
        const long L = (long)i * G + c; if (L >= nwg) return false;
        int wgid = (int)L; { const int q = nwg / NXCD, r = nwg % NXCD, xcd = wgid % NXCD, off = wgid / NXCD; wgid = (xcd < r ? xcd * (q + 1) : r * (q + 1) + (xcd - r) * q) + off; }
        const int nig = WGM * nN, gid = wgid / nig, fm = gid * WGM, gsz = (nM - fm) < WGM ? (nM - fm) : WGM;
        u.pm = fm + ((wgid % nig) % gsz); u.pn = (wgid % nig) / gsz; u.aux = 0; return true;
    }
};
struct SchedStd {
    const char* A; const char* B; size_t tstep; StaticOrder so;
    __device__ void init(const void* A_, const void* B_, int M, int N, int K, int G, int c) { A = (const char*)A_; B = (const char*)B_; tstep = (size_t)BM * K * 2; so.init(M, N, G, c); }
    __device__ __forceinline__ bool next(int i, Unit& u) const { return so.next(i, u); }
    __device__ __forceinline__ const char* a_base(const Unit& u) const { return A + (size_t)u.pm * tstep; }
    __device__ __forceinline__ const char* b_base(const Unit& u) const { return B + (size_t)u.pn * tstep; }
};
struct SchedMix {
    const char* Y; const char* W; int G, c;
    __device__ __forceinline__ bool next(int i, Unit& u) const { const int tl = c + G * (i / 3); if (tl >= 512) return false; u.pm = tl >> 2; u.pn = tl & 3; u.aux = i % 3; return true; }
    __device__ __forceinline__ const char* a_base(const Unit& u) const { return Y + (size_t)u.aux * (32 * MiB) + (size_t)u.pm * (256 * 512 * 2); }
    __device__ __forceinline__ const char* b_base(const Unit& u) const { return W + (size_t)u.aux * (1024 * 512 * 2) + (size_t)u.pn * (256 * 512 * 2); }
};

template <class Epi, class Sched>
__device__ __forceinline__ void gemm_phase(LAS unsigned char* lds, const int K, const Sched& S, const Epi& E, const int wid) {
    int lane = lane_id_fresh(); asm volatile("" : "+v"(lane));
    const int tid = wid * 64 + lane, wr = wid >> 2, wc = wid & 3, fr = lane & 15, fq = lane >> 4;
    const int nt = K / BK;
    unsigned voffA[2], voffB[2];
#pragma unroll
    for (int i = 0; i < 2; ++i) { int R, C; stage_rc(tid * 16 + i * 8192, R, C); const int Rb = (R & ~31) + perm32(R & 31);
        voffA[i] = (unsigned)(R * K + C) * 2u; voffB[i] = (unsigned)(Rb * K + C) * 2u; }
    const size_t kstep = (size_t)(BK * 2);
    const size_t hstep = (size_t)HALF * K * 2;
    const unsigned ldsw = (unsigned)wid * 1024u;
    const int aoff = lds_byte(wr * 64 + fr, fq * 8), boff = lds_byte(wc * 32 + fr, fq * 8);
#define PG8_SA(b, h) (((b) * 2 + (h)) * HTB)
#define PG8_SB(b, h) ((4 + (b) * 2 + (h)) * HTB)
#define PG8_STAGE(bufoff, gbase, voff) do { _Pragma("unroll") for (int _i = 0; _i < 2; ++_i) \
        __builtin_amdgcn_global_load_lds((const unsigned*)((const char*)(gbase) + (voff)[_i]), (LAS unsigned*)(lds + (bufoff) + ldsw + _i * 8192), 16, 0, 0); } while (0)
#define PG8_LDA(dst, b, h) do { _Pragma("unroll") for (int m = 0; m < 4; ++m) _Pragma("unroll") for (int k = 0; k < 2; ++k) dst[m][k] = *(const LAS bf16x8*)(lds + PG8_SA(b, h) + aoff + m * 2048 + k * 1024); } while (0)
#define PG8_LDB(dst, b, h) do { _Pragma("unroll") for (int n = 0; n < 2; ++n) _Pragma("unroll") for (int k = 0; k < 2; ++k) dst[n][k] = *(const LAS bf16x8*)(lds + PG8_SB(b, h) + boff + n * 2048 + k * 1024); } while (0)
#define PG8_MMA(ai, bj, At, Bt) do { __builtin_amdgcn_s_setprio(1); _Pragma("unroll") for (int m = 0; m < 4; ++m) _Pragma("unroll") for (int n = 0; n < 2; ++n) _Pragma("unroll") for (int k = 0; k < 2; ++k) \
        acc[ai][bj][m][n] = __builtin_amdgcn_mfma_f32_16x16x32_bf16(Bt[n][k], At[m][k], acc[ai][bj][m][n], 0, 0, 0); __builtin_amdgcn_s_setprio(0); } while (0)
#define PG8_WAIT_V(n) asm volatile("s_waitcnt vmcnt(" #n ")" ::: "memory")
#define PG8_WAIT_L(n) asm volatile("s_waitcnt lgkmcnt(" #n ")" ::: "memory")
#define PG8_BAR __builtin_amdgcn_s_barrier()
#define PG8_SCHED __builtin_amdgcn_sched_barrier(0)
    Unit cur, nxt; int ui = 0;
    if (!S.next(0, cur)) return;
    f32x4 acc[2][2][4][2];
#pragma unroll
    for (int a = 0; a < 2; ++a)
#pragma unroll
        for (int b = 0; b < 2; ++b)
#pragma unroll
            for (int m = 0; m < 4; ++m)
#pragma unroll
                for (int n = 0; n < 2; ++n) acc[a][b][m][n] = (f32x4){0.f, 0.f, 0.f, 0.f};
    bf16x8 At[4][2], B0[2][2], B1[2][2];
    const char* cA = S.a_base(cur); const char* cB = S.b_base(cur);
    PG8_STAGE(PG8_SB(0, 0), cB, voffB); PG8_STAGE(PG8_SB(0, 1), cB + hstep, voffB); PG8_STAGE(PG8_SA(0, 0), cA, voffA); PG8_STAGE(PG8_SA(0, 1), cA + hstep, voffA);
    if (wr == 1) PG8_BAR;
    PG8_WAIT_V(2); PG8_BAR;
    PG8_STAGE(PG8_SB(1, 0), cB + kstep, voffB); PG8_STAGE(PG8_SA(1, 0), cA + kstep, voffA); PG8_STAGE(PG8_SB(1, 1), cB + hstep + kstep, voffB);
    PG8_WAIT_V(6); PG8_BAR;
    for (;;) {
        const bool has_next = S.next(ui + 1, nxt);
        const char* nA = has_next ? S.a_base(nxt) : cA; const char* nB = has_next ? S.b_base(nxt) : cB;
        for (int t = 0; t < nt; t += 2) {
            const bool last = (t == nt - 2);
            const char* a1 = cA + (size_t)(t + 1) * kstep;
            const char* a2 = last ? nA : cA + (size_t)(t + 2) * kstep; const char* b2 = last ? nB : cB + (size_t)(t + 2) * kstep;
            const char* a3 = a2 + kstep; const char* b3 = b2 + kstep;
            PG8_LDB(B0, 0, 0); PG8_LDB(B1, 0, 1); PG8_SCHED; PG8_LDA(At, 0, 0); PG8_STAGE(PG8_SA(1, 1), a1 + hstep, voffA);
            PG8_WAIT_V(8); PG8_WAIT_L(0); PG8_BAR; PG8_MMA(0, 0, At, B0); PG8_MMA(0, 1, At, B1); PG8_BAR; PG8_SCHED;
            PG8_LDA(At, 0, 1); PG8_STAGE(PG8_SB(0, 0), b2, voffB); PG8_STAGE(PG8_SB(0, 1), b2 + hstep, voffB); PG8_STAGE(PG8_SA(0, 0), a2, voffA);
            PG8_WAIT_V(8); PG8_WAIT_L(0); PG8_BAR; PG8_MMA(1, 0, At, B0); PG8_MMA(1, 1, At, B1); PG8_BAR; PG8_SCHED;
            PG8_LDB(B0, 1, 0); PG8_LDB(B1, 1, 1); PG8_SCHED; PG8_LDA(At, 1, 0); PG8_STAGE(PG8_SA(0, 1), a2 + hstep, voffA);
            PG8_WAIT_V(8); PG8_WAIT_L(0); PG8_BAR; PG8_MMA(0, 0, At, B0); PG8_MMA(0, 1, At, B1); PG8_BAR; PG8_SCHED;
            PG8_LDA(At, 1, 1); PG8_STAGE(PG8_SB(1, 0), b3, voffB); PG8_STAGE(PG8_SB(1, 1), b3 + hstep, voffB); PG8_STAGE(PG8_SA(1, 0), a3, voffA);
            PG8_WAIT_V(8); PG8_WAIT_L(0); PG8_BAR; PG8_MMA(1, 0, At, B0); PG8_MMA(1, 1, At, B1); PG8_BAR; PG8_SCHED;
        }
        if (wr == 0) PG8_BAR;
        E(acc, cur, wr, wc, fr, fq);
        if (!has_next) break;
#pragma unroll
        for (int a = 0; a < 2; ++a)
#pragma unroll
            for (int b = 0; b < 2; ++b)
#pragma unroll
                for (int m = 0; m < 4; ++m)
#pragma unroll
                    for (int n = 0; n < 2; ++n) acc[a][b][m][n] = (f32x4){0.f, 0.f, 0.f, 0.f};
        cur = nxt; cA = nA; cB = nB; ++ui;
        if (wr == 1) PG8_BAR;
    }
    PG8_WAIT_V(0);
    PG8_BAR;
#undef PG8_SA
#undef PG8_SB
#undef PG8_STAGE
#undef PG8_LDA
#undef PG8_LDB
#undef PG8_MMA
#undef PG8_WAIT_V
#undef PG8_WAIT_L
#undef PG8_BAR
#undef PG8_SCHED
}
}
using pg8::Unit;

__device__ __forceinline__ u32x4 pack_f8(const f32x4& v0, const f32x4& v1) { u32x4 w; w.x = cvt_pk(v0[0], v0[1]); w.y = cvt_pk(v0[2], v0[3]); w.z = cvt_pk(v1[0], v1[1]); w.w = cvt_pk(v1[2], v1[3]); return w; }

struct EpiIn {
    unsigned char* ws;
    __device__ __forceinline__ void operator()(const f32x4 (&acc)[2][2][4][2], const Unit& u, int wr, int wc, int fr, int fq) const {
        const int pn = u.pn; const int row0 = u.pm * 256 + wr * 64 + fr;
        if (pn == 18) {
            bf16_t* dc = (bf16_t*)(ws + WS_DCKV); float* mf = (float*)(ws + WS_MISCF);
            const int col = wc * 32 + 8 * fq;
#pragma unroll
            for (int ai = 0; ai < 2; ++ai)
#pragma unroll
                for (int m = 0; m < 4; ++m) { const size_t row = (size_t)(row0 + ai * 128 + m * 16);
                    *(u32x4*)(dc + row * 128 + col) = pack_f8(acc[ai][0][m][0], acc[ai][0][m][1]);
                    *(f32x4*)(mf + row * 128 + col) = acc[ai][1][m][0]; *(f32x4*)(mf + row * 128 + col + 4) = acc[ai][1][m][1]; asm volatile("" ::: "memory"); }
            return;
        }
        const int grp = pn >> 1, half = pn & 1;
        size_t boff; int mode = 0; float sc = 1.f;
        switch (grp) {
            case 0: boff = WS_QF; sc = C2; break;
            case 1: boff = WS_KF; mode = 3; break;
            case 2: boff = WS_GF; mode = 1; break;
            case 3: boff = WS_QD; mode = 2; sc = C2; break;
            case 4: boff = WS_IQ; mode = 2; break;
            case 5: boff = WS_GD; mode = 1; break;
            case 6: boff = WS_QS; sc = C2; break;
            case 7: boff = WS_KS; mode = 3; break;
            default: boff = WS_GS; mode = 1; break;
        }
        bf16_t* base = (bf16_t*)(ws + boff);
        if (mode == 2) {
            const f32x4* cs = (const f32x4*)(ws + WS_CS);
            const int head = half * 4 + wc, i0 = 8 * fq;
#pragma unroll
            for (int ai = 0; ai < 2; ++ai)
#pragma unroll
                for (int m = 0; m < 4; ++m) { const size_t row = (size_t)(row0 + ai * 128 + m * 16);
                    const f32x4* cp = cs + (row * 32 + i0) / 2;
                    f32x4 y1[2], y2[2];
#pragma unroll
                    for (int n = 0; n < 2; ++n) { const f32x4 ca = cp[2 * n], cb = cp[2 * n + 1];
                        const f32x4 x1 = acc[ai][0][m][n], x2 = acc[ai][1][m][n];
                        y1[n][0] = (x1[0] * ca[0] - x2[0] * ca[1]) * sc; y2[n][0] = (x2[0] * ca[0] + x1[0] * ca[1]) * sc;
                        y1[n][1] = (x1[1] * ca[2] - x2[1] * ca[3]) * sc; y2[n][1] = (x2[1] * ca[2] + x1[1] * ca[3]) * sc;
                        y1[n][2] = (x1[2] * cb[0] - x2[2] * cb[1]) * sc; y2[n][2] = (x2[2] * cb[0] + x1[2] * cb[1]) * sc;
                        y1[n][3] = (x1[3] * cb[2] - x2[3] * cb[3]) * sc; y2[n][3] = (x2[3] * cb[2] + x1[3] * cb[3]) * sc; }
                    bf16_t* rp = base + row * 512 + head * 64 + i0;
                    *(u32x4*)rp = pack_f8(y1[0], y1[1]); *(u32x4*)(rp + 32) = pack_f8(y2[0], y2[1]); if (m & 1) asm volatile("" ::: "memory"); }
            return;
        }
        if (mode == 3) {
#pragma unroll
            for (int ai = 0; ai < 2; ++ai)
#pragma unroll
                for (int m = 0; m < 4; ++m) { const int tok = row0 + ai * 128 + m * 16; const int b = tok >> 12, sq = tok & 4095, kv = sq & 63;
#pragma unroll
                    for (int bj = 0; bj < 2; ++bj) { const int head = half * 4 + bj * 2 + (wc >> 1), d0 = (wc & 1) * 2 + (fq >> 1);
                        bf16_t* bp = base + (((size_t)(b * 8 + head) * 64 + (sq >> 6)) * 4096) + (((kv >> 5) * 4 + d0) * 64 + (fq & 1) * 32 + (kv & 31)) * 8;
                        *(u32x4*)bp = pack_f8(acc[ai][bj][m][0], acc[ai][bj][m][1]); }
                    asm volatile("" ::: "memory"); }
            return;
        }
        const int col0 = half * 256 + wc * 32 + 8 * fq;
#pragma unroll
        for (int ai = 0; ai < 2; ++ai)
#pragma unroll
            for (int m = 0; m < 4; ++m) { bf16_t* rowp = base + (size_t)(row0 + ai * 128 + m * 16) * 512 + col0;
#pragma unroll
                for (int bj = 0; bj < 2; ++bj) { f32x4 v0 = acc[ai][bj][m][0], v1 = acc[ai][bj][m][1];
                    if (mode == 1) {
#pragma unroll
                        for (int e = 0; e < 4; ++e) { v0[e] = v0[e] * sigmoidf_(v0[e]); v1[e] = v1[e] * sigmoidf_(v1[e]); } }
                    else { v0 = v0 * sc; v1 = v1 * sc; }
                    *(u32x4*)(rowp + bj * 128) = pack_f8(v0, v1); asm volatile("" ::: "memory"); } }
    }
};
struct EpiPlain {
    bf16_t* O; size_t ldc;
    __device__ __forceinline__ void operator()(const f32x4 (&acc)[2][2][4][2], const Unit& u, int wr, int wc, int fr, int fq) const {
        const int row0 = u.pm * 256 + wr * 64 + fr, col0 = u.pn * 256 + wc * 32 + 8 * fq;
#pragma unroll
        for (int ai = 0; ai < 2; ++ai)
#pragma unroll
            for (int m = 0; m < 4; ++m) { const int r = row0 + ai * 128 + m * 16; const int hb = r >> 6, d = r & 63;
#pragma unroll
                for (int bj = 0; bj < 2; ++bj) { const int tok = col0 + bj * 128; const int b = tok >> 12, sq = tok & 4095, j = sq >> 6, kv0 = sq & 63;
                    bf16_t* bp = O + (((size_t)(hb * 8 + b) * 64 + j) * 4096) + (((kv0 >> 4) * 2 + (d >> 5)) * 64 + (d & 31)) * 8 + ((kv0 & 8) >> 1);
                    const u32x4 w = pack_f8(acc[ai][bj][m][0], acc[ai][bj][m][1]);
                    *(u32x2*)bp = (u32x2){w.x, w.y}; *(u32x2*)(bp + 32 * 8) = (u32x2){w.z, w.w}; }
                asm volatile("" ::: "memory"); }
    }
};
struct EpiMerge {
    unsigned char* O;
    __device__ __forceinline__ void operator()(const f32x4 (&acc)[2][2][4][2], const Unit& u, int wr, int wc, int fr, int fq) const {
        const int row0 = u.pm * 256 + wr * 64 + fr, col0 = u.pn * 256 + wc * 32 + 8 * fq;
#pragma unroll
        for (int ai = 0; ai < 2; ++ai)
#pragma unroll
            for (int m = 0; m < 4; ++m) { unsigned char* rowp = O + (size_t)(row0 + ai * 128 + m * 16) * 3072 + col0;
#pragma unroll
                for (int bj = 0; bj < 2; ++bj) { const f32x4 v0 = acc[ai][bj][m][0], v1 = acc[ai][bj][m][1];
                    unsigned q0[4], q1[4];
#pragma unroll
                    for (int e = 0; e < 4; ++e) { q0[e] = (unsigned)(sigmoidf_(v0[e]) * 255.0f + 0.5f); q1[e] = (unsigned)(sigmoidf_(v1[e]) * 255.0f + 0.5f); }
                    u32x2 w; w.x = q0[0] | (q0[1] << 8) | (q0[2] << 16) | (q0[3] << 24); w.y = q1[0] | (q1[1] << 8) | (q1[2] << 16) | (q1[3] << 24);
                    *(u32x2*)(rowp + bj * 128) = w; asm volatile("" ::: "memory"); } }
    }
};
struct EpiMix {
    const unsigned char* M3; bf16_t* MIX;
    __device__ __forceinline__ void operator()(const f32x4 (&acc)[2][2][4][2], const Unit& u, int wr, int wc, int fr, int fq) const {
        const int row0 = u.pm * 256 + wr * 64 + fr, col0 = u.pn * 256 + wc * 32 + 8 * fq; const int br = u.aux;
#pragma unroll
        for (int ai = 0; ai < 2; ++ai) {
            u32x2 g[2][4]; u32x4 o[2][4];
#pragma unroll
            for (int bj = 0; bj < 2; ++bj)
#pragma unroll
                for (int m = 0; m < 4; ++m) { const size_t row = (size_t)(row0 + ai * 128 + m * 16); const int col = col0 + bj * 128;
                    g[bj][m] = *(const u32x2*)(M3 + row * 3072 + br * 1024 + col);
                    if (br != 0) o[bj][m] = *(const u32x4*)(MIX + row * 1024 + col); else o[bj][m] = (u32x4){0u, 0u, 0u, 0u}; }
#pragma unroll
            for (int bj = 0; bj < 2; ++bj)
#pragma unroll
                for (int m = 0; m < 4; ++m) { const size_t row = (size_t)(row0 + ai * 128 + m * 16); const int col = col0 + bj * 128;
                    const u32x2 gg = g[bj][m]; const u32x4 oo = o[bj][m]; const float k255 = 1.0f / 255.0f;
                    f32x4 v0 = acc[ai][bj][m][0] * k255, v1 = acc[ai][bj][m][1] * k255;
                    v0[0] = v0[0] * (float)(gg.x & 0xffu) + bflo(oo.x); v0[1] = v0[1] * (float)((gg.x >> 8) & 0xffu) + bfhi(oo.x); v0[2] = v0[2] * (float)((gg.x >> 16) & 0xffu) + bflo(oo.y); v0[3] = v0[3] * (float)(gg.x >> 24) + bfhi(oo.y);
                    v1[0] = v1[0] * (float)(gg.y & 0xffu) + bflo(oo.z); v1[1] = v1[1] * (float)((gg.y >> 8) & 0xffu) + bfhi(oo.z); v1[2] = v1[2] * (float)((gg.y >> 16) & 0xffu) + bflo(oo.w); v1[3] = v1[3] * (float)(gg.y >> 24) + bfhi(oo.w);
                    *(u32x4*)(MIX + row * 1024 + col) = pack_f8(v0, v1); }
            asm volatile("" ::: "memory"); }
    }
};
struct EpiOut {
    const float* xold; float* xnew; const float* gate;
    __device__ __forceinline__ void operator()(const f32x4 (&acc)[2][2][4][2], const Unit& u, int wr, int wc, int fr, int fq) const {
        const int row0 = u.pm * 256 + wr * 64 + fr, col0 = u.pn * 256 + wc * 32 + 8 * fq; const int b = u.pm >> 4;
        const float* gp = gate + (size_t)b * 3072;
#pragma unroll
        for (int bj = 0; bj < 2; ++bj) { const int col = col0 + bj * 128; const f32x4 g0 = *(const f32x4*)(gp + col), g1 = *(const f32x4*)(gp + col + 4);
#pragma unroll
            for (int ai = 0; ai < 2; ++ai) {
                f32x4 a0[4], a1[4];
#pragma unroll
                for (int m = 0; m < 4; ++m) { const size_t off = (size_t)(row0 + ai * 128 + m * 16) * 1024 + col; a0[m] = *(const f32x4*)(xold + off); a1[m] = *(const f32x4*)(xold + off + 4); }
#pragma unroll
                for (int m = 0; m < 4; ++m) { const size_t off = (size_t)(row0 + ai * 128 + m * 16) * 1024 + col;
                    *(f32x4*)(xnew + off) = a0[m] + g0 * acc[ai][bj][m][0]; *(f32x4*)(xnew + off + 4) = a1[m] + g1 * acc[ai][bj][m][1]; }
                asm volatile("" ::: "memory"); } }
    }
};

__device__ __forceinline__ int in_src_col(int np) {
    const int tile = np >> 8, cp = np & 255;
    const int rp = 64 * ((cp & 127) >> 5) + 32 * (cp >> 7) + (cp & 31);
    if (tile < 2) return np;
    if (tile < 4) return 512 + (np - 2 * 256);
    if (tile < 6) return 1544 + (np - 4 * 256);
    if (tile < 8) return 2056 + (tile - 6) * 256 + rp;
    if (tile < 10) return 2696 + (tile - 8) * 256 + rp;
    if (tile < 12) return 3280 + (np - 10 * 256);
    if (tile < 14) return 3792 + (np - 12 * 256);
    if (tile < 16) return 4304 + (np - 14 * 256);
    if (tile < 18) return 5328 + (np - 16 * 256);
    if (tile == 18) { if (cp < 128) return 2568 + cp; if (cp < 192) return 3208 + cp - 128; if (cp < 200) return 1536 + cp - 192; if (cp < 208) return 3272 + cp - 200; return -1; }
    if (tile < 31) return 5840 + (np - 19 * 256);
    if (tile < 33) return 1024 + (np - 31 * 256);
    return 4816 + (np - 33 * 256);
}
template <bool MAP>
__device__ __forceinline__ void transpose_item(const float* W, int K, int N, int NP, bf16_t* WT, LAS float* scr, int item, int lane) {
    const int nblk = NP / 32, kb = item / nblk, nb = item % nblk, k0 = 64 * kb, n0 = 32 * nb;
    int src = n0 + (lane & 31); if (MAP) src = in_src_col(src);
#pragma unroll
    for (int i = 0; i < 32; ++i) { const int kk = 2 * i + (lane >> 5); scr[kk * 33 + (lane & 31)] = (src >= 0) ? W[(size_t)(k0 + kk) * N + src] : 0.f; }
    asm volatile("s_waitcnt lgkmcnt(0)" ::: "memory");
    const int c = lane & 7;
#pragma unroll
    for (int j = 0; j < 4; ++j) { const int n = (lane >> 3) + 8 * j; const LAS float* s = scr + (8 * c) * 33 + n;
        u32x4 o; o.x = cvt_pk(s[0 * 33], s[1 * 33]); o.y = cvt_pk(s[2 * 33], s[3 * 33]); o.z = cvt_pk(s[4 * 33], s[5 * 33]); o.w = cvt_pk(s[6 * 33], s[7 * 33]);
        *(u32x4*)(WT + (size_t)(n0 + n) * K + k0 + 8 * c) = o; }
    asm volatile("s_waitcnt lgkmcnt(0)" ::: "memory");
}

template <bool SB>
__device__ __forceinline__ void attn_fs_wave(const bf16_t* Q, const bf16_t* Kb, const bf16_t* VT, const float* F2, const bf16_t* G, bf16_t* Y, int b, int h, int q0w, int lane, bool do_store, const unsigned* kmaxw) {
    asm volatile("" : "+v"(lane));
    const int r32 = lane & 31, hi = lane >> 5;
    const int tq = q0w + r32;
    const size_t rowQ = (size_t)b * SEQ + tq;
    bf16x8 qf[4];
#pragma unroll
    for (int d0 = 0; d0 < 4; ++d0) qf[d0] = *(const bf16x8*)(Q + rowQ * 512 + h * 64 + d0 * 16 + hi * 8);
    f32x16 o0, o1;
#pragma unroll
    for (int r = 0; r < 16; ++r) { o0[r] = 0.f; o1[r] = 0.f; }
    float m = -INFINITY, l = 0.f, carry = 0.f, Ft = 0.f;
    const float* F2b = F2 + (size_t)(b * 8 + h) * SEQ;
    float qk = 0.f;
    if (!SB) { Ft = F2b[tq];
        float ss = 0.f;
#pragma unroll
        for (int d0 = 0; d0 < 4; ++d0)
#pragma unroll
            for (int e = 0; e < 8; ++e) { const float f = bf2f((bf16_t)qf[d0][e]); ss += f * f; }
        ss += shx32(ss, lane);
        qk = sqrtf(ss * __uint_as_float(kmaxw[b * 8 + h])) * 1.001f; }
    const bf16_t* Kh = Kb + (size_t)(b * 8 + h) * 64 * 4096;
    const bf16_t* VTh = VT + (size_t)(h * 8 + b) * 64 * 4096;
    const int jmax = (q0w + 31) >> 6;
    bf16x8 kf[2][4];
#pragma unroll
    for (int hf = 0; hf < 2; ++hf)
#pragma unroll
        for (int d0 = 0; d0 < 4; ++d0) kf[hf][d0] = *(const bf16x8*)(Kh + (size_t)jmax * 4096 + ((hf * 4 + d0) * 64 + lane) * 8);
    for (int j = jmax; j >= 0; --j) {
        const int kv0 = j * 64;
        bf16x8 vf[4][2];
#pragma unroll
        for (int ks = 0; ks < 4; ++ks)
#pragma unroll
            for (int dd = 0; dd < 2; ++dd) vf[ks][dd] = *(const bf16x8*)(VTh + (size_t)j * 4096 + ((ks * 2 + dd) * 64 + lane) * 8);
        bf16x8 kn[2][4];
        { const int jn = (j > 0 ? j - 1 : 0);
#pragma unroll
          for (int hf = 0; hf < 2; ++hf)
#pragma unroll
              for (int d0 = 0; d0 < 4; ++d0) kn[hf][d0] = *(const bf16x8*)(Kh + (size_t)jn * 4096 + ((hf * 4 + d0) * 64 + lane) * 8); }
        f32x4 fa4[4], fb4[4]; float fs_next = 0.f;
        if (!SB) {
#pragma unroll
            for (int g = 0; g < 4; ++g) { fa4[g] = *(const f32x4*)(F2b + kv0 + 8 * g + 4 * hi); fb4[g] = *(const f32x4*)(F2b + kv0 + 32 + 8 * g + 4 * hi); }
            fs_next = F2b[j > 0 ? 64 * j - 1 : 0];
        }
        asm volatile("" ::: "memory");
        f32x16 p0, p1;
#pragma unroll
        for (int r = 0; r < 16; ++r) { p0[r] = 0.f; p1[r] = 0.f; }
#pragma unroll
        for (int d0 = 0; d0 < 4; ++d0) { p0 = mfma32(kf[0][d0], qf[d0], p0); p1 = mfma32(kf[1][d0], qf[d0], p1); }
        if (!SB) {
#pragma unroll
            for (int g = 0; g < 4; ++g) { const f32x4 fa = fa4[g], fb = fb4[g];
#pragma unroll
                for (int e = 0; e < 4; ++e) { p0[4 * g + e] += Ft - fa[e]; p1[4 * g + e] += Ft - fb[e]; } }
            if (j == jmax) {
#pragma unroll
                for (int r = 0; r < 16; ++r) { const int kv = kv0 + crow(r, hi); if (kv > tq) p0[r] = -INFINITY; if (kv + 32 > tq) p1[r] = -INFINITY; } }
            float mx = p0[0];
#pragma unroll
            for (int r = 1; r < 16; ++r) mx = fmaxf(mx, p0[r]);
#pragma unroll
            for (int r = 0; r < 16; ++r) mx = fmaxf(mx, p1[r]);
            mx = fmaxf(mx, shx32(mx, lane));
            const float mnew = fmaxf(m, mx); const float alpha = ex2(m - mnew); m = mnew;
            l *= alpha;
#pragma unroll
            for (int r = 0; r < 16; ++r) { o0[r] *= alpha; o1[r] *= alpha; }
            float s = 0.f;
#pragma unroll
            for (int r = 0; r < 16; ++r) { p0[r] = ex2(p0[r] - m); p1[r] = ex2(p1[r] - m); s += p0[r] + p1[r]; }
            l += s;
        } else {
            float lm0[16], lm1[16];
#pragma unroll
            for (int r = 0; r < 16; ++r) {
                const int kv = kv0 + crow(r, hi);
                const float z0 = p0[r], z1 = p1[r];
                const float sp0 = (z0 > 40.f) ? z0 : lg2(1.0f + ex2(z0)), sp1 = (z1 > 40.f) ? z1 : lg2(1.0f + ex2(z1));
                const bool v0 = kv < tq, v1 = (kv + 32) < tq;
                lm0[r] = v0 ? sp0 : 0.f; lm1[r] = v1 ? sp1 : 0.f;
                p0[r] = v0 ? (z0 - sp0) : -INFINITY; p1[r] = v1 ? (z1 - sp1) : -INFINITY;
            }
            float gs0[4], gs1[4], ps0[4], ps1[4];
#pragma unroll
            for (int a = 0; a < 4; ++a) { gs0[a] = (lm0[4 * a] + lm0[4 * a + 1]) + (lm0[4 * a + 2] + lm0[4 * a + 3]); gs1[a] = (lm1[4 * a] + lm1[4 * a + 1]) + (lm1[4 * a + 2] + lm1[4 * a + 3]); }
#pragma unroll
            for (int a = 0; a < 4; ++a) { ps0[a] = shx32(gs0[a], lane); ps1[a] = shx32(gs1[a], lane); }
            float run = carry;
            float ex0[4], ex1[4];
#pragma unroll
            for (int a = 3; a >= 0; --a) { const float odd = hi ? gs1[a] : ps1[a]; const float pair = gs1[a] + ps1[a]; ex1[a] = run + (hi ? 0.f : odd); run += pair; }
#pragma unroll
            for (int a = 3; a >= 0; --a) { const float odd = hi ? gs0[a] : ps0[a]; const float pair = gs0[a] + ps0[a]; ex0[a] = run + (hi ? 0.f : odd); run += pair; }
            carry = run;
#pragma unroll
            for (int a = 0; a < 4; ++a) {
                float w = ex0[a];
                p0[4 * a + 3] = ex2(p0[4 * a + 3] - w); w += lm0[4 * a + 3];
                p0[4 * a + 2] = ex2(p0[4 * a + 2] - w); w += lm0[4 * a + 2];
                p0[4 * a + 1] = ex2(p0[4 * a + 1] - w); w += lm0[4 * a + 1];
                p0[4 * a + 0] = ex2(p0[4 * a + 0] - w);
                w = ex1[a];
                p1[4 * a + 3] = ex2(p1[4 * a + 3] - w); w += lm1[4 * a + 3];
                p1[4 * a + 2] = ex2(p1[4 * a + 2] - w); w += lm1[4 * a + 2];
                p1[4 * a + 1] = ex2(p1[4 * a + 1] - w); w += lm1[4 * a + 1];
                p1[4 * a + 0] = ex2(p1[4 * a + 0] - w);
            }
        }
        bf16x8 pw[4];
        pw[0] = pack8(p0[0], p0[1], p0[2], p0[3], p0[4], p0[5], p0[6], p0[7]);
        pw[1] = pack8(p0[8], p0[9], p0[10], p0[11], p0[12], p0[13], p0[14], p0[15]);
        pw[2] = pack8(p1[0], p1[1], p1[2], p1[3], p1[4], p1[5], p1[6], p1[7]);
        pw[3] = pack8(p1[8], p1[9], p1[10], p1[11], p1[12], p1[13], p1[14], p1[15]);
#pragma unroll
        for (int ks = 0; ks < 4; ++ks) { o0 = mfma32(vf[ks][0], pw[ks], o0); o1 = mfma32(vf[ks][1], pw[ks], o1); }
#pragma unroll
        for (int hf = 0; hf < 2; ++hf)
#pragma unroll
            for (int d0 = 0; d0 < 4; ++d0) kf[hf][d0] = kn[hf][d0];
        if (SB) { if (__all(carry > 160.f)) break; }
        else if (j > 0) {
            const float fs = fs_next;
            if (__all(qk + Ft - m + 64.f < fs)) break; }
    }
    float inv = 1.f;
    if (!SB) { const float lt = l + shx32(l, lane); inv = 1.0f / lt; }
    if (do_store)
#pragma unroll
    for (int g = 0; g < 4; ++g)
#pragma unroll
        for (int dd = 0; dd < 2; ++dd) {
            const size_t off = rowQ * 512 + h * 64 + dd * 32 + 8 * g + 4 * hi;
            const u32x2 gg = *(const u32x2*)(G + off);
            const f32x16& o = dd ? o1 : o0;
            u32x2 w; w.x = cvt_pk(o[4 * g] * inv * bflo(gg.x), o[4 * g + 1] * inv * bfhi(gg.x)); w.y = cvt_pk(o[4 * g + 2] * inv * bflo(gg.y), o[4 * g + 3] * inv * bfhi(gg.y));
            *(u32x2*)(Y + off) = w;
        }
}

__device__ __forceinline__ int wave_total(int v) {
    v += __builtin_amdgcn_update_dpp(0, v, 0x111, 0xf, 0xf, false);
    v += __builtin_amdgcn_update_dpp(0, v, 0x112, 0xf, 0xf, false);
    v += __builtin_amdgcn_update_dpp(0, v, 0x114, 0xf, 0xf, false);
    v += __builtin_amdgcn_update_dpp(0, v, 0x118, 0xf, 0xf, false);
    v += __builtin_amdgcn_update_dpp(0, v, 0x142, 0xa, 0xf, false);
    v += __builtin_amdgcn_update_dpp(0, v, 0x143, 0xc, 0xf, false);
    return __builtin_amdgcn_readlane(v, 63);
}
#ifndef DSA_SELFCHECK
#define DSA_SELFCHECK 0
#endif
__device__ __forceinline__ void dsa_unit(LAS unsigned char* lds, unsigned char* ws, int b, int t0, int wid, int lane, bool do_store) {
    asm volatile("" : "+v"(lane));
    LAS float* sc = (LAS float*)lds;
    LAS int* lists = (LAS int*)(lds + 131072);
    const bf16_t* IQ = (const bf16_t*)(ws + WS_IQ); const bf16_t* IK = (const bf16_t*)(ws + WS_IK);
    const float* MF = (const float*)(ws + WS_MISCF);
    const bf16_t* DK = (const bf16_t*)(ws + WS_DK); const bf16_t* DV = (const bf16_t*)(ws + WS_DV);
    const bf16_t* GD = (const bf16_t*)(ws + WS_GD); bf16_t* QD = (bf16_t*)(ws + WS_QD);
    const size_t tokb = (size_t)b * SEQ;
    const int r32 = lane & 31, hi = lane >> 5;
    for (int ra_ = 0; ra_ < REP_DA; ++ra_) {
        const int a_ = r32 >> 3, uu = (r32 >> 2) & 1, bb = r32 & 3; const int qq = 2 * uu + (a_ >> 1), hd = 4 * (a_ & 1) + bb;
        bf16x8 af[2][4];
#pragma unroll
        for (int rt = 0; rt < 2; ++rt)
#pragma unroll
            for (int d0 = 0; d0 < 4; ++d0) af[rt][d0] = *(const bf16x8*)(IQ + (tokb + t0 + 4 * rt + qq) * 512 + hd * 64 + d0 * 16 + hi * 8);
        const float WSC = 0.35355339059327373f * 0.125f;
        float w[2][16];
#pragma unroll
        for (int rt = 0; rt < 2; ++rt)
#pragma unroll
            for (int qh = 0; qh < 2; ++qh) { const float* wp = MF + (tokb + t0 + 4 * rt + 2 * hi + qh) * 128 + 72; const f32x4 wa = *(const f32x4*)wp, wb = *(const f32x4*)(wp + 4);
#pragma unroll
                for (int e = 0; e < 4; ++e) { w[rt][8 * qh + e] = wa[e] * WSC; w[rt][8 * qh + 4 + e] = wb[e] * WSC; } }
        const int nkt = (t0 + 8 + 31) >> 5;
        bf16x8 bfr[4];
#pragma unroll
        for (int d0 = 0; d0 < 4; ++d0) bfr[d0] = *(const bf16x8*)(IK + (((size_t)b * 128 + (wid < nkt ? wid : 0)) * 4 + d0) * 512 + lane * 8);
        for (int kt = wid; kt < nkt; kt += 8) {
            const int key = kt * 32 + r32;
            bf16x8 bnx[4];
            { const int ktn = (kt + 8 < nkt) ? kt + 8 : kt;
#pragma unroll
              for (int d0 = 0; d0 < 4; ++d0) bnx[d0] = *(const bf16x8*)(IK + (((size_t)b * 128 + ktn) * 4 + d0) * 512 + lane * 8); }
            asm volatile("" ::: "memory");
            f32x16 c0, c1;
#pragma unroll
            for (int r = 0; r < 16; ++r) { c0[r] = 0.f; c1[r] = 0.f; }
#pragma unroll
            for (int d0 = 0; d0 < 4; ++d0) { c0 = mfma32(af[0][d0], bfr[d0], c0); c1 = mfma32(af[1][d0], bfr[d0], c1); }
            float s00 = 0.f, s01 = 0.f, s10 = 0.f, s11 = 0.f;
#pragma unroll
            for (int r = 0; r < 8; ++r) { s00 += w[0][r] * fmaxf(c0[r], 0.f); s01 += w[0][8 + r] * fmaxf(c0[8 + r], 0.f); s10 += w[1][r] * fmaxf(c1[r], 0.f); s11 += w[1][8 + r] * fmaxf(c1[8 + r], 0.f); }
            const int q00 = 2 * hi, q01 = 2 * hi + 1, q10 = 4 + 2 * hi, q11 = 5 + 2 * hi;
            sc[q00 * 4096 + key] = (key > t0 + q00) ? -INFINITY : s00;
            sc[q01 * 4096 + key] = (key > t0 + q01) ? -INFINITY : s01;
            sc[q10 * 4096 + key] = (key > t0 + q10) ? -INFINITY : s10;
            sc[q11 * 4096 + key] = (key > t0 + q11) ? -INFINITY : s11;
#pragma unroll
            for (int d0 = 0; d0 < 4; ++d0) bfr[d0] = bnx[d0];
        }
    }
    __syncthreads();
    const int t = t0 + wid, n = t + 1;
    int count; bool badsel = false; (void)badsel;
    for (int rb_ = 0; rb_ < REP_DB; ++rb_) {
        unsigned key[64];
        const LAS float* row = sc + wid * 4096;
#pragma unroll
        for (int j = 0; j < 64; ++j) { const int idx = j * 64 + lane; const int idc = idx < n ? idx : n - 1;
            const unsigned bits = __float_as_uint(row[idc]); const unsigned k = bits ^ (unsigned)(((int)bits >> 31) | (int)0x80000000);
            key[j] = idx < n ? k : 0u; }
        unsigned T = 0u; int cT = 0;
        const int nb8 = (n + 511) >> 9;
        bool bad = false; (void)bad;
#define DSA_COUNT(CAND, OUT) do { int cl_ = 0; _Pragma("unroll") for (int jb = 0; jb < 8; ++jb) { if (jb < nb8) { _Pragma("unroll") for (int j = 8 * jb; j < 8 * jb + 8; ++j) cl_ += (key[j] >= (CAND)) ? 1 : 0; } } \
            OUT = wave_total(cl_); \
            if (DSA_SELFCHECK) { int c2_ = 0; _Pragma("unroll") for (int j = 0; j < 64; ++j) c2_ += __builtin_popcountll(__ballot(key[j] >= (CAND))); if (c2_ != OUT) bad = true; } } while (0)
        if (n > 256) {
            int bit = 30, c;
            DSA_COUNT(0x80000000u, c);
            if (c >= 256) { T = 0x80000000u; cT = c;
                if (c > 256) {
                    unsigned mxk = 0u;
#pragma unroll
                    for (int jb = 0; jb < 8; ++jb) { if (jb < nb8) {
#pragma unroll
                        for (int j = 8 * jb; j < 8 * jb + 8; ++j) mxk = key[j] > mxk ? key[j] : mxk; } }
#pragma unroll
                    for (int o = 1; o < 64; o <<= 1) { const unsigned ov = (unsigned)__builtin_amdgcn_ds_bpermute((lane ^ o) << 2, (int)mxk); mxk = ov > mxk ? ov : mxk; }
                    unsigned cand = mxk & 0xFF800000u;
                    for (int tr_ = 0; tr_ < 4; ++tr_) { DSA_COUNT(cand, c); if (c >= 256) { T = cand; cT = c; bit = 22; break; } if (cand <= 0x80800000u) break; cand -= 0x00800000u; }
                }
            }
            for (; bit >= 0 && cT != 256; --bit) { const unsigned cand = T | (1u << bit); DSA_COUNT(cand, c); if (c >= 256) { T = cand; cT = c; } }
            if (DSA_SELFCHECK) {
                unsigned Tr = 0u; int cr = 0;
                for (int b2 = 31; b2 >= 0; --b2) { const unsigned cand = Tr | (1u << b2); int c2 = 0;
#pragma unroll
                    for (int j = 0; j < 64; ++j) c2 += __builtin_popcountll(__ballot(key[j] >= cand));
                    if (c2 >= 256) { Tr = cand; cr = c2; if (c2 == 256) break; } }
                if (cT == 256 || cr == 256) { if (cT != cr) bad = true; } else if (T != Tr) bad = true;
            }
        }
        if (n <= 256) {
            for (int p2 = lane; p2 < 256; p2 += 64) lists[wid * 256 + p2] = p2;
        } else if (cT == 256) {
            int cl = 0;
#pragma unroll
            for (int jb = 0; jb < 8; ++jb) { if (jb < nb8) {
#pragma unroll
                for (int j = 8 * jb; j < 8 * jb + 8; ++j) cl += (key[j] >= T) ? 1 : 0; } }
            int incl = cl;
#pragma unroll
            for (int o = 1; o < 64; o <<= 1) { const int nbv = __builtin_amdgcn_ds_bpermute(((lane >= o) ? (lane - o) : lane) << 2, incl); if (lane >= o) incl += nbv; }
            int off = wid * 256 + incl - cl;
#pragma unroll
            for (int jb = 0; jb < 8; ++jb) { if (jb < nb8) {
#pragma unroll
                for (int j = 8 * jb; j < 8 * jb + 8; ++j) { if (key[j] >= T) { lists[off] = j * 64 + lane; ++off; } } } }
        } else {
        int eqbase = 0;
#pragma unroll
        for (int j = 0; j < 64; ++j) { const int idx = j * 64 + lane;
            const bool eq = (key[j] == T); const unsigned long long meq = __ballot(eq); const int r = eqbase + mbcnt64(meq);
            if (eq && r < 256) lists[wid * 256 + 255 - r] = idx;
            eqbase += __builtin_popcountll(meq); __builtin_amdgcn_sched_barrier(0); }
        int base = 0;
#pragma unroll
        for (int j = 0; j < 64; ++j) { const int idx = j * 64 + lane;
            const bool gt = (key[j] > T); const unsigned long long mg = __ballot(gt); const int pos = base + mbcnt64(mg);
            if (gt) lists[wid * 256 + pos] = idx;
            base += __builtin_popcountll(mg); __builtin_amdgcn_sched_barrier(0); }
        }
        count = n < 256 ? n : 256; badsel = badsel || bad;
    }
    asm volatile("s_waitcnt lgkmcnt(0)" ::: "memory");
    __builtin_amdgcn_wave_barrier();
    for (int rc_ = 0; rc_ < REP_DC; ++rc_) {
        const bool do_store_c = do_store && (rc_ == REP_DC - 1);
        const int hh = lane & 15, g = lane >> 4;
        bf16x8 qb[2];
#pragma unroll
        for (int ks = 0; ks < 2; ++ks) { if (hh < 8) qb[ks] = *(const bf16x8*)(QD + (tokb + t) * 512 + hh * 64 + ks * 32 + g * 8); else qb[ks] = (bf16x8){0, 0, 0, 0, 0, 0, 0, 0}; }
        const LAS int* lw = lists + wid * 256;
        const int cg = count - 4 * g;
        float s[64];
        const int nhalf = (count > 128) ? 2 : 1;
        u32x4 vr[16];
        {
            bf16x8 ka[16][2];
#pragma unroll
            for (int tile = 0; tile < 16; ++tile) { const int idx = lw[tile * 16 + hh];
                ka[tile][0] = *(const bf16x8*)(DK + (tokb + idx) * 64 + g * 8); ka[tile][1] = *(const bf16x8*)(DK + (tokb + idx) * 64 + 32 + g * 8); }
#pragma unroll
            for (int i = 0; i < 16; ++i) { const int row = i * 8 + (lane >> 3); const int idx = lw[row]; vr[i] = *(const u32x4*)(DV + (tokb + idx) * 64 + (lane & 7) * 8); }
            asm volatile("" ::: "memory");
#pragma unroll
            for (int tile = 0; tile < 16; ++tile) {
                f32x4 c = (f32x4){0.f, 0.f, 0.f, 0.f}; c = mfma16(ka[tile][0], qb[0], c); c = mfma16(ka[tile][1], qb[1], c);
#pragma unroll
                for (int j = 0; j < 4; ++j) s[4 * tile + j] = (tile * 16 + j < cg) ? c[j] : -INFINITY; }
        }
        float mx = s[0];
#pragma unroll
        for (int j = 1; j < 64; ++j) mx = fmaxf(mx, s[j]);
        mx = fmaxf(mx, shx(mx, 16, lane)); mx = fmaxf(mx, shx32(mx, lane));
        float sum = 0.f;
#pragma unroll
        for (int j = 0; j < 64; ++j) { s[j] = ex2(s[j] - mx); sum += s[j]; }
        sum += shx(sum, 16, lane); sum += shx32(sum, lane);
        LAS unsigned char* vs = (LAS unsigned char*)(sc + wid * 4096);
        f32x4 oacc[4];
#pragma unroll
        for (int dt = 0; dt < 4; ++dt) oacc[dt] = (f32x4){0.f, 0.f, 0.f, 0.f};
        u32x2 ggv[4];
#pragma unroll
        for (int dt = 0; dt < 4; ++dt) ggv[dt] = *(const u32x2*)(GD + (tokb + t) * 512 + (hh & 7) * 64 + dt * 16 + 4 * g);
#pragma unroll
        for (int half = 0; half < 2; ++half) {
            if (half < nhalf) {
#pragma unroll
                for (int i = 0; i < 16; ++i) { const int row = i * 8 + (lane >> 3); const int phys = (lane & 7) ^ (2 * ((row >> 2) & 1) + 4 * ((row >> 1) & 1)); *(LAS u32x4*)(vs + row * 128 + phys * 16) = vr[i]; }
                asm volatile("s_waitcnt lgkmcnt(0)" ::: "memory");
                __builtin_amdgcn_wave_barrier();
                if (half == 0 && nhalf == 2) {
#pragma unroll
                    for (int i = 0; i < 16; ++i) { const int row = i * 8 + (lane >> 3); const int idx = lw[128 + row]; vr[i] = *(const u32x4*)(DV + (tokb + idx) * 64 + (lane & 7) * 8); }
                    asm volatile("" ::: "memory");
                }
                const int q_ = (lane >> 2) & 3, p_ = lane & 3;
#pragma unroll
                for (int ks = 0; ks < 4; ++ks) {
                    const int ta = 2 * (half * 4 + ks), tb = ta + 1;
                    const bf16x8 pb = pack8(s[4 * ta], s[4 * ta + 1], s[4 * ta + 2], s[4 * ta + 3], s[4 * tb], s[4 * tb + 1], s[4 * tb + 2], s[4 * tb + 3]);
#pragma unroll
                    for (int dt = 0; dt < 4; ++dt) {
                        const int phys = (2 * dt + (p_ >> 1)) ^ (2 * (g & 1) + 4 * (q_ >> 1));
                        LAS unsigned char* ap = vs + (4 * g + q_) * 128 + phys * 16 + 8 * (p_ & 1) + ks * 4096;
                        const bf16x4 lo = __builtin_bit_cast(bf16x4, __builtin_amdgcn_ds_read_tr16_b64_v4i16((LAS bf16x4*)ap));
                        const bf16x4 hi4 = __builtin_bit_cast(bf16x4, __builtin_amdgcn_ds_read_tr16_b64_v4i16((LAS bf16x4*)(ap + 2048)));
                        const bf16x8 va = (bf16x8){lo[0], lo[1], lo[2], lo[3], hi4[0], hi4[1], hi4[2], hi4[3]};
                        oacc[dt] = mfma16(va, pb, oacc[dt]);
                    }
                }
                asm volatile("s_waitcnt lgkmcnt(0)" ::: "memory");
                __builtin_amdgcn_wave_barrier();
            }
        }
        if (hh < 8 && do_store_c) {
            float inv = 1.0f / sum;
            if (DSA_SELFCHECK && badsel) inv = __builtin_nanf("");
#pragma unroll
            for (int dt = 0; dt < 4; ++dt) { const size_t off = (tokb + t) * 512 + hh * 64 + dt * 16 + 4 * g;
                const u32x2 gg = ggv[dt];
                u32x2 w; w.x = cvt_pk(oacc[dt][0] * inv * bflo(gg.x), oacc[dt][1] * inv * bfhi(gg.x)); w.y = cvt_pk(oacc[dt][2] * inv * bflo(gg.y), oacc[dt][3] * inv * bfhi(gg.y));
                *(u32x2*)(QD + off) = w; }
        }
    }
    __syncthreads();
}

#define XB_TMO      128
#define XB_XCNT(j)  (256  + 64 * (j))
#define XB_XSUB(j)  (1280 + 64 * (j))
#define XB_XGEN(j)  (2304 + 64 * (j))
#define XB_TOP      3328
#define XB_TOPGEN   3392
#define XCD_BAR_WORDS 3456
#define XB_SPIN_CAP (1u << 22)
__device__ __forceinline__ unsigned xb_ld(unsigned* p)              { return __hip_atomic_load(p, __ATOMIC_RELAXED, __HIP_MEMORY_SCOPE_AGENT); }
__device__ __forceinline__ unsigned xb_add(unsigned* p, unsigned v) { return __hip_atomic_fetch_add(p, v, __ATOMIC_RELAXED, __HIP_MEMORY_SCOPE_AGENT); }
__device__ __forceinline__ unsigned xb_xcc_id() { return (unsigned)__builtin_amdgcn_s_getreg((3 << 11) | 20) & 0xFu; }
#define XB_SPIN(cond, bar) do { unsigned _sp = 0; while (cond) { __builtin_amdgcn_s_sleep(1); \
    if ((++_sp & 255u) == 0u) { if (xb_ld(&(bar)[XB_TMO])) break; if (_sp > XB_SPIN_CAP) { atomicAdd(&(bar)[XB_TMO], 1u); break; } } } } while (0)
__device__ __forceinline__ void xcd_barrier_complete(unsigned* bar, unsigned x, unsigned G, unsigned& nloc, unsigned& nx) {
    unsigned sum, cnt, mine, sp = 0u;
    for (;;) {
        sum = 0u; cnt = 0u; mine = 0u;
#pragma unroll
        for (unsigned j = 0; j < 16; ++j) { const unsigned c = xb_ld(&bar[XB_XCNT(j)]); sum += c; cnt += (c > 0u) ? 1u : 0u; mine = (j == x) ? c : mine; }
        if (sum == G) break;
        __builtin_amdgcn_s_sleep(1);
        if ((++sp & 255u) == 0u) { if (xb_ld(&bar[XB_TMO])) break; if (sp > XB_SPIN_CAP) { atomicAdd(&bar[XB_TMO], 1u); break; } }
    }
    nloc = mine > 0u ? mine : 1u; nx = cnt > 0u ? cnt : 1u;
}
__device__ __forceinline__ void xcd_barrier(unsigned* bar, unsigned x, unsigned G, volatile LAS unsigned* st, bool leader) {
    asm volatile("s_waitcnt vmcnt(0)" ::: "memory");
    __syncthreads();
    if (leader) {
        __builtin_amdgcn_s_waitcnt(0);
        unsigned nloc = st[0], nx = st[1];
        if (nloc == 0u) { xcd_barrier_complete(bar, x, G, nloc, nx); st[0] = nloc; st[1] = nx; }
        const unsigned old = xb_add(&bar[XB_XSUB(x)], 1u);
        const unsigned gen = old / nloc;
        if (old + 1u == (gen + 1u) * nloc) {
            __builtin_amdgcn_fence(__ATOMIC_RELEASE, "agent");
            asm volatile("s_waitcnt vmcnt(0)" ::: "memory");
            const unsigned og = xb_add(&bar[XB_TOP], 1u);
            const unsigned tg = og / nx;
            if (og + 1u == (tg + 1u) * nx) xb_add(&bar[XB_TOPGEN], 1u);
            else XB_SPIN(xb_ld(&bar[XB_TOPGEN]) == tg, bar);
            __builtin_amdgcn_fence(__ATOMIC_ACQUIRE, "agent");
            xb_add(&bar[XB_XGEN(x)], 1u);
            asm volatile("s_waitcnt vmcnt(0)" ::: "memory");
        } else {
            XB_SPIN(xb_ld(&bar[XB_XGEN(x)]) == gen, bar);
            __builtin_amdgcn_fence(__ATOMIC_ACQUIRE, "agent");
            asm volatile("s_waitcnt vmcnt(0)" ::: "memory");
        }
    }
    __syncthreads();
}
__device__ __forceinline__ void grid_bar(unsigned* bar, unsigned target, unsigned gen, bool leader) {
    asm volatile("s_waitcnt vmcnt(0) lgkmcnt(0)" ::: "memory");
    __syncthreads();
    if (leader) {
        __builtin_amdgcn_fence(__ATOMIC_RELEASE, "agent");
        asm volatile("s_waitcnt vmcnt(0)" ::: "memory");
        const unsigned old = __hip_atomic_fetch_add(&bar[0], 1u, __ATOMIC_RELAXED, __HIP_MEMORY_SCOPE_AGENT);
        if (old + 1u == target) __hip_atomic_fetch_add(&bar[64], 1u, __ATOMIC_RELAXED, __HIP_MEMORY_SCOPE_AGENT);
        else while (__hip_atomic_load(&bar[64], __ATOMIC_RELAXED, __HIP_MEMORY_SCOPE_AGENT) <= gen) __builtin_amdgcn_s_sleep(1);
        __builtin_amdgcn_fence(__ATOMIC_ACQUIRE, "agent");
        asm volatile("s_waitcnt vmcnt(0)" ::: "memory");
    }
    __syncthreads();
}
#ifndef DBG
#define DBG 0
#endif
#ifndef REP_P2
#define REP_P2 1
#endif
#ifndef REP_FOX
#define REP_FOX 1
#endif
#ifndef REP_SB
#define REP_SB 1
#endif
#ifndef REP_DSA
#define REP_DSA 1
#endif
#ifndef REP_P0
#define REP_P0 1
#endif
#ifndef REP_P1
#define REP_P1 1
#endif
#ifndef REP_P3
#define REP_P3 1
#endif
#ifndef REP_P5A
#define REP_P5A 1
#endif
#ifndef REP_P5B
#define REP_P5B 1
#endif
#ifndef REP_BAR
#define REP_BAR 1
#endif
#ifndef REP_P6
#define REP_P6 1
#endif
#ifndef REP_FIN
#define REP_FIN 1
#endif
__device__ __forceinline__ float dbg_value(const unsigned char* ws, int m, int c) {
    auto B = [&](size_t off, size_t idx) { return bf2f(((const bf16_t*)(ws + off))[idx]); };
    const size_t r512 = (size_t)m * 512;
    if (DBG == 1) return B(WS_H, (size_t)m * 1024 + c);
    if (DBG == 2) {
        if (c < 512) return B(WS_QF, r512 + c) + B(WS_KF, r512 + c) + B(WS_GF, r512 + c) + B(WS_QD, r512 + c) + B(WS_IQ, r512 + c) + B(WS_GD, r512 + c) + B(WS_QS, r512 + c) + B(WS_KS, r512 + c) + B(WS_GS, r512 + c);
        if (c < 640) return B(WS_DCKV, (size_t)m * 128 + (c - 512));
        if (c < 768) return ((const float*)(ws + WS_MISCF))[(size_t)m * 128 + (c - 640)];
        { const int cc = c - 768; float v = 0.f; for (int q = 0; q < 4; ++q) v += B(WS_VT, (size_t)(4 * cc + q) * NTOK + m); return v; }
    }
    if (DBG == 3) {
        if (c < 64) return B(WS_DK, (size_t)m * 64 + c);
        if (c < 128) return B(WS_DV, (size_t)m * 64 + c - 64);
        if (c < 192) return B(WS_IK, (size_t)m * 64 + c - 128);
        if (c < 200) return ((const float*)(ws + WS_F2))[(size_t)((m >> 12) * 8 + (c - 192)) * SEQ + (m & 4095)];
        return 0.f;
    }
    if (DBG == 4 || DBG == 41 || DBG == 42 || DBG == 43) { if (c < 512) return B(WS_QF, r512 + c); return B(WS_QD, r512 + c - 512) + B(WS_QS, r512 + c - 512); }
    if (DBG == 5) return B(WS_M3, (size_t)m * 3072 + c) + B(WS_M3, (size_t)m * 3072 + 1024 + c) + B(WS_M3, (size_t)m * 3072 + 2048 + c);
    if (DBG == 6) return B(WS_MIX, (size_t)m * 1024 + c);
    return 0.f;
}
#define DBG_DUMP(k) if (DBG != 0 && (DBG == (k) || DBG / 10 == (k)) && l == 0) { KArgP ap2_ = (KArgP)__builtin_amdgcn_kernarg_segment_ptr(); float* o_ = ap2_->out; const unsigned char* w_ = ap2_->ws; \
        for (size_t e = (size_t)bx0 * NTHR + wid0 * 64 + lane_id_fresh(); e < (size_t)NTOK * 1024; e += (size_t)G0 * NTHR) o_[e] = dbg_value(w_, (int)(e >> 10), (int)(e & 1023)); return; }
#ifndef ONLY
#define ONLY -1
#endif
#define PH(k) (ONLY < 0 || ONLY == (k))
struct Args { const float* x; const float* c; const int* pos; const float* w_ada; const float* b_ada; const float* g_norm; const float* w_in; const float* b_fgt;
              const float* g_kv; const float* w_kv_up; const float* w_br[3]; const float* w_out; const float* g_final; float* out; unsigned char* ws; };

typedef const __attribute__((address_space(4))) Args* KArgP;
__global__ void __launch_bounds__(NTHR, 2) fwd_megakernel(Args A_kernarg) {
    extern __shared__ __attribute__((aligned(16))) unsigned char lds_raw[];
    LAS unsigned char* lds = (LAS unsigned char*)lds_raw;
    cg::grid_group grid = cg::this_grid();
    const int G0 = gridDim.x, bx0 = blockIdx.x;
    const int wid0 = __builtin_amdgcn_readfirstlane((int)threadIdx.x >> 6);
    const unsigned xcc_id = xb_xcc_id();
    unsigned* const barp = (unsigned*)(((KArgP)__builtin_amdgcn_kernarg_segment_ptr())->ws + 4096);
    if (threadIdx.x == 0) { ((volatile LAS unsigned*)(lds + 147000))[0] = 0u; ((volatile LAS unsigned*)(lds + 147000))[1] = 0u;
        (void)xb_add(barp + XB_XCNT(xcc_id), 1u); }
    __syncthreads();
#define LOAD_ARGS KArgP ap_ = (KArgP)__builtin_amdgcn_kernarg_segment_ptr(); int G = G0, bx = bx0; asm volatile("" : "+s"(ap_), "+s"(G), "+s"(bx)); const int NGW = G * NWAVES; (void)NGW; unsigned char* ws = A.ws; float* MOD = (float*)(ws + WS_MOD); (void)MOD;
#define A (*ap_)
#define PHASE_VARS LOAD_ARGS int lane = lane_id_fresh(); asm volatile("" : "+v"(lane)); const int wid = wid0; const int tid = wid * 64 + lane; (void)tid; const int gw = bx * NWAVES + wid; LAS float* scr = (LAS float*)(lds + wid * 16384); (void)scr; (void)gw; (void)lane;

    if constexpr (PH(0)) for (int rep_ = 0; rep_ < REP_P0; ++rep_) {
        PHASE_VARS
        LAS float* red = (LAS float*)lds;
        LAS float* sl = (LAS float*)(lds + 32768);
        if (bx < 96) {
#pragma unroll
            for (int i = 0; i < 16; ++i) { const float cv = A.c[tid + i * NTHR]; sl[tid + i * NTHR] = cv / (1.0f + __expf(-cv)); } }
        __syncthreads();
        for (int it = bx; it < 96; it += G) {
            const int l = it / 48, cgp = it % 48, cc = tid & 63, kp = tid >> 6; const int col = cgp * 64 + cc;
            float acc[8];
#pragma unroll
            for (int b = 0; b < 8; ++b) acc[b] = 0.f;
            const float* wp = A.w_ada + ((size_t)l * 1024 + kp * 128) * 3072 + col;
#pragma unroll 32
            for (int k = 0; k < 128; ++k) { const float w = wp[(size_t)k * 3072];
#pragma unroll
                for (int b = 0; b < 8; ++b) acc[b] += sl[b * 1024 + kp * 128 + k] * w; }
#pragma unroll
            for (int b = 0; b < 8; ++b) red[(kp * 8 + b) * 64 + cc] = acc[b];
            __syncthreads();
            { const int b = tid >> 6; float s = 0.f;
#pragma unroll
              for (int k2 = 0; k2 < 8; ++k2) s += red[(k2 * 8 + b) * 64 + cc];
              MOD[((size_t)l * 8 + b) * 3072 + col] = s + A.b_ada[l * 3072 + col]; }
            __syncthreads();
        }
        f32x2* CS = (f32x2*)(ws + WS_CS);
        for (int e = bx * NTHR + tid; e < NTOK * 32; e += G * NTHR) { const int tok = e >> 5, i = e & 31;
            const double rev = (double)A.pos[tok] * INVF[i] * 0.15915494309189535; const double fr = rev - floor(rev); const float f = (float)fr;
            CS[e] = (f32x2){__builtin_amdgcn_cosf(f), __builtin_amdgcn_sinf(f)}; }
        __syncthreads();
        for (int it = gw; it < 2 * (3 * 256 + 512); it += NGW) { const int l = it / 1280; int r = it % 1280;
            if (r < 768) { const int br = r / 256; transpose_item<false>(A.w_br[br] + (size_t)l * 512 * 1024, 512, 1024, 1024, (bf16_t*)(ws + WS_WTBR) + ((size_t)l * 3 + br) * 1024 * 512, scr, r % 256, lane); }
            else { r -= 768; transpose_item<false>(A.w_out + (size_t)l * 1024 * 1024, 1024, 1024, 1024, (bf16_t*)(ws + WS_WTOUT) + (size_t)l * 1024 * 1024, scr, r, lane); } }
    }
    if (G0 == 0x7fffff01) grid.sync();
    { const int ln_ = lane_id_fresh(); unsigned* bp_ = barp; unsigned xc_ = xcc_id; asm volatile("" : "+s"(bp_), "+s"(xc_)); xcd_barrier(bp_, xc_, (unsigned)G0, (volatile LAS unsigned*)(lds + 147000), wid0 == 0 && ln_ == 0); }

    for (int l = 0; l < DEPTH; ++l) {
        if constexpr (PH(1)) for (int rep_ = 0; rep_ < REP_P1; ++rep_) {
            PHASE_VARS
            const float* xsrc = (l == 0) ? A.x : A.out;
            for (int it = gw; it < 16 * (NPAD / 32); it += NGW) transpose_item<true>(A.w_in + (size_t)l * 1024 * NIN, 1024, NIN, NPAD, (bf16_t*)(ws + WS_WTIN), scr, it, lane);
            bf16_t* H = (bf16_t*)(ws + WS_H); const float* gn = A.g_norm + l * 1024;
            for (int m0 = gw * 4; m0 < NTOK; m0 += NGW * 4) {
                f32x4 v[4][4]; float ss[4];
#pragma unroll
                for (int r = 0; r < 4; ++r) { const f32x4* xr = (const f32x4*)(xsrc + (size_t)(m0 + r) * 1024) + lane; ss[r] = 0.f;
#pragma unroll
                    for (int j = 0; j < 4; ++j) v[r][j] = xr[64 * j]; }
#pragma unroll
                for (int r = 0; r < 4; ++r)
#pragma unroll
                    for (int j = 0; j < 4; ++j) ss[r] += (v[r][j][0] * v[r][j][0] + v[r][j][1] * v[r][j][1]) + (v[r][j][2] * v[r][j][2] + v[r][j][3] * v[r][j][3]);
#pragma unroll
                for (int o = 1; o < 64; o <<= 1) {
#pragma unroll
                    for (int r = 0; r < 4; ++r) ss[r] += shx(ss[r], o, lane); }
                const float* mp = MOD + ((size_t)l * 8 + (m0 >> 12)) * 3072;
#pragma unroll
                for (int j = 0; j < 4; ++j) { const int col = 4 * lane + 256 * j;
                    const f32x4 gg = *(const f32x4*)(gn + col), sh = *(const f32x4*)(mp + col), scl = *(const f32x4*)(mp + 1024 + col);
                    const f32x4 gs = gg * (scl + 1.0f);
#pragma unroll
                    for (int r = 0; r < 4; ++r) { const float rstd = 1.0f / sqrtf(ss[r] * (1.0f / 1024.f) + EPS);
                        const f32x4 hv = v[r][j] * rstd * gs + sh;
                        u32x2 w; w.x = cvt_pk(hv[0], hv[1]); w.y = cvt_pk(hv[2], hv[3]);
                        *(u32x2*)(H + (size_t)(m0 + r) * 1024 + col) = w; } }
            }
        }
        { const int ln_ = lane_id_fresh(); unsigned* bp_ = barp; unsigned xc_ = xcc_id; asm volatile("" : "+s"(bp_), "+s"(xc_)); xcd_barrier(bp_, xc_, (unsigned)G0, (volatile LAS unsigned*)(lds + 147000), wid0 == 0 && ln_ == 0); }
        DBG_DUMP(1)
        if constexpr (PH(2)) {
            LOAD_ARGS
            for (int rep_ = 0; rep_ < REP_P2; ++rep_) {
            pg8::SchedStd S; S.init(ws + WS_H, ws + WS_WTIN, NTOK, 19 * 256, 1024, G, bx);
            EpiIn E{ws};
            pg8::gemm_phase<EpiIn, pg8::SchedStd>(lds, 1024, S, E, wid0);
            pg8::SchedStd S2; S2.init(ws + WS_WTIN + (size_t)31 * 256 * 1024 * 2, ws + WS_H, 1024, NTOK, 1024, G, bx);
            EpiPlain E2{(bf16_t*)(ws + WS_VT), (size_t)NTOK};
            pg8::gemm_phase<EpiPlain, pg8::SchedStd>(lds, 1024, S2, E2, wid0);
            }
        }
        { const int ln_ = lane_id_fresh(); unsigned* bp_ = barp; unsigned xc_ = xcc_id; asm volatile("" : "+s"(bp_), "+s"(xc_)); xcd_barrier(bp_, xc_, (unsigned)G0, (volatile LAS unsigned*)(lds + 147000), wid0 == 0 && ln_ == 0); }
        DBG_DUMP(2)
        if constexpr (PH(3)) for (int rep_ = 0; rep_ < REP_P3; ++rep_) {
            PHASE_VARS
            const float* MF = (const float*)(ws + WS_MISCF);
            if (bx < 64) {
                const int b = bx >> 3, h = bx & 7; const float bf = A.b_fgt[l * 8 + h];
                const float* mfp = MF + ((size_t)b * SEQ + tid * 8) * 128 + 64 + h;
                float v[8]; float run = 0.f;
#pragma unroll
                for (int i = 0; i < 8; ++i) { const float xx = mfp[(size_t)i * 128] + bf; run += -lg2(1.0f + ex2(-xx * LOG2E)); v[i] = run; }
                float incl = run;
#pragma unroll
                for (int o = 1; o < 64; o <<= 1) { const float nb = __int_as_float(__builtin_amdgcn_ds_bpermute(((lane >= o) ? (lane - o) : lane) << 2, __float_as_int(incl))); if (lane >= o) incl += nb; }
                LAS float* wt = (LAS float*)(lds + 70000);
                if (lane == 63) wt[wid] = incl;
                __syncthreads();
                float off = 0.f;
#pragma unroll
                for (int w2 = 0; w2 < 8; ++w2) { const float tv = wt[w2]; if (w2 < wid) off += tv; }
                const float excl = incl - run + off;
                float* Fo = (float*)(ws + WS_F2) + (size_t)bx * SEQ + tid * 8;
                *(f32x4*)Fo = (f32x4){v[0] + excl, v[1] + excl, v[2] + excl, v[3] + excl}; *(f32x4*)(Fo + 4) = (f32x4){v[4] + excl, v[5] + excl, v[6] + excl, v[7] + excl};
            }
            for (int blk = gw; blk < 8 * 8 * 64; blk += NGW) {
                const bf16_t* kb = (const bf16_t*)(ws + WS_KF) + (size_t)blk * 4096; float mxk = 0.f;
#pragma unroll
                for (int hf = 0; hf < 2; ++hf) { float ss = 0.f;
#pragma unroll
                    for (int d0 = 0; d0 < 4; ++d0) { const bf16x8 v = *(const bf16x8*)(kb + ((hf * 4 + d0) * 64 + lane) * 8);
#pragma unroll
                        for (int e = 0; e < 8; ++e) { const float f = bf2f((bf16_t)v[e]); ss += f * f; } }
                    ss += shx32(ss, lane); mxk = fmaxf(mxk, ss); }
#pragma unroll
                for (int o = 1; o < 32; o <<= 1) mxk = fmaxf(mxk, shx(mxk, o, lane));
                if (lane == 0) __hip_atomic_fetch_max((unsigned*)ws + 128 + l * 64 + (blk >> 6), __float_as_uint(mxk), __ATOMIC_RELAXED, __HIP_MEMORY_SCOPE_AGENT);
            }
            LAS bf16_t* Wt = (LAS bf16_t*)lds;
            { const float* wsrc = A.w_kv_up + (size_t)l * 128 * 128; const float* gk = A.g_kv + l * 128;
#pragma unroll
              for (int i = 0; i < 32; ++i) { const int e = tid + i * NTHR, k = e >> 7, n = e & 127; Wt[n * 136 + k] = (bf16_t)(cvt_pk(wsrc[e] * gk[k], 0.f) & 0xffffu); } }
            __syncthreads();
            const bf16_t* DC = (const bf16_t*)(ws + WS_DCKV); const f32x2* CS = (const f32x2*)(ws + WS_CS);
            bf16_t* DK = (bf16_t*)(ws + WS_DK); bf16_t* DV = (bf16_t*)(ws + WS_DV); bf16_t* IKo = (bf16_t*)(ws + WS_IK);
            for (int grp = gw; grp < NTOK / 16; grp += NGW) {
                const int i16 = lane & 15, g = lane >> 4; const size_t tok0 = (size_t)grp * 16;
                bf16x8 af[4]; float ss = 0.f;
#pragma unroll
                for (int ks = 0; ks < 4; ++ks) { af[ks] = *(const bf16x8*)(DC + (tok0 + i16) * 128 + ks * 32 + g * 8);
#pragma unroll
                    for (int e = 0; e < 8; ++e) { const float f = bf2f((bf16_t)af[ks][e]); ss += f * f; } }
                ss += shx(ss, 16, lane); ss += shx32(ss, lane);
                const float rstd_i = 1.0f / sqrtf(ss * (1.0f / 128.f) + EPS);
                float rs[4];
#pragma unroll
                for (int j2 = 0; j2 < 4; ++j2) rs[j2] = __int_as_float(__builtin_amdgcn_ds_bpermute((4 * g + j2) << 2, __float_as_int(rstd_i)));
                f32x4 acc[8];
#pragma unroll
                for (int nt = 0; nt < 8; ++nt) { acc[nt] = (f32x4){0.f, 0.f, 0.f, 0.f};
#pragma unroll
                    for (int ks = 0; ks < 4; ++ks) { const bf16x8 bfrag = *(const LAS bf16x8*)(Wt + (16 * nt + i16) * 136 + ks * 32 + g * 8); acc[nt] = mfma16(af[ks], bfrag, acc[nt]); } }
#pragma unroll
                for (int j2 = 0; j2 < 4; ++j2) { const size_t tok = tok0 + 4 * g + j2; const f32x2 c0 = CS[tok * 32 + i16], c1 = CS[tok * 32 + 16 + i16]; const float r = rs[j2];
                    const float k0 = acc[0][j2] * r, k1 = acc[1][j2] * r, k2 = acc[2][j2] * r, k3 = acc[3][j2] * r;
                    DK[tok * 64 + i16]      = (bf16_t)(cvt_pk(k0 * c0[0] - k2 * c0[1], 0.f) & 0xffffu);
                    DK[tok * 64 + 32 + i16] = (bf16_t)(cvt_pk(k2 * c0[0] + k0 * c0[1], 0.f) & 0xffffu);
                    DK[tok * 64 + 16 + i16] = (bf16_t)(cvt_pk(k1 * c1[0] - k3 * c1[1], 0.f) & 0xffffu);
                    DK[tok * 64 + 48 + i16] = (bf16_t)(cvt_pk(k3 * c1[0] + k1 * c1[1], 0.f) & 0xffffu);
#pragma unroll
                    for (int nt = 4; nt < 8; ++nt) DV[tok * 64 + 16 * (nt - 4) + i16] = (bf16_t)(cvt_pk(acc[nt][j2] * r, 0.f) & 0xffffu); }
            }
            for (int t4 = gw; t4 < NTOK / 4; t4 += NGW) {
#pragma unroll
                for (int q = 0; q < 4; ++q) { const size_t tok = (size_t)t4 * 4 + q; const f32x2 cs = CS[tok * 32 + (lane & 31)];
                    const float xi = MF[tok * 128 + lane]; const float pi = shx32(xi, lane);
                    const float ir = (lane < 32) ? (xi * cs[0] - pi * cs[1]) : (xi * cs[0] + pi * cs[1]);
                    IKo[(((tok >> 5) * 4 + (lane >> 4)) * 64 + ((lane >> 3) & 1) * 32 + (tok & 31)) * 8 + (lane & 7)] = (bf16_t)(cvt_pk(ir, 0.f) & 0xffffu); }
            }
            __syncthreads();
        }
        { const int ln_ = lane_id_fresh(); unsigned* bp_ = barp; unsigned xc_ = xcc_id; asm volatile("" : "+s"(bp_), "+s"(xc_)); xcd_barrier(bp_, xc_, (unsigned)G0, (volatile LAS unsigned*)(lds + 147000), wid0 == 0 && ln_ == 0); }
        DBG_DUMP(3)
        if constexpr (PH(4) || PH(8) || PH(9)) {
            PHASE_VARS
            const int b = bx & 7, w = bx >> 3, GW = (G + 7) >> 3;
            if constexpr (PH(4) && (DBG != 42 && DBG != 43)) for (int rep_ = 0; rep_ < REP_FOX; ++rep_) for (int u = w; u < 128; u += GW) { const int qb = u >> 3, h = (u + 2 * (u / GW)) & 7; const bool st_ = (rep_ == REP_FOX - 1) || (G0 == 0x7fffff01);
                attn_fs_wave<false>((const bf16_t*)(ws + WS_QF), (const bf16_t*)(ws + WS_KF), (const bf16_t*)(ws + WS_VT), (const float*)(ws + WS_F2), (const bf16_t*)(ws + WS_GF), (bf16_t*)(ws + WS_QF), b, h, qb * 256 + wid * 32, lane, st_, (const unsigned*)ws + 128 + l * 64); }
            if constexpr (PH(8) && (DBG != 41 && DBG != 43)) for (int rep_ = 0; rep_ < REP_SB; ++rep_) for (int u = w; u < 128; u += GW) { const int qb = u >> 3, h = (u + 2 * (u / GW)) & 7; const bool st_ = (rep_ == REP_SB - 1) || (G0 == 0x7fffff01);
                attn_fs_wave<true>((const bf16_t*)(ws + WS_QS), (const bf16_t*)(ws + WS_KS), (const bf16_t*)(ws + WS_VT) + (size_t)512 * NTOK, nullptr, (const bf16_t*)(ws + WS_GS), (bf16_t*)(ws + WS_QS), b, h, qb * 256 + wid * 32, lane, st_, nullptr); }
            __syncthreads();
            if constexpr (PH(9) && (DBG != 41 && DBG != 42)) {
                unsigned* qcnt = (unsigned*)ws + 256 + l * 8 + b; LAS int* ubox = (LAS int*)(lds + 147008);
                if (tid == 0) *ubox = (int)__hip_atomic_fetch_add(qcnt, 1u, __ATOMIC_RELAXED, __HIP_MEMORY_SCOPE_AGENT);
                __syncthreads();
                int k = *ubox;
                while (k < 512) {
                    int nxt = 0;
                    if (tid == 0) nxt = (int)__hip_atomic_fetch_add(qcnt, 1u, __ATOMIC_RELAXED, __HIP_MEMORY_SCOPE_AGENT);
                    dsa_unit(lds, ws, b, (511 - k) * 8, wid, lane, true);
                    if (tid == 0) *ubox = nxt;
                    __syncthreads();
                    k = *ubox;
                }
            }
        }
        { const int ln_ = lane_id_fresh(); unsigned* bp_ = barp; unsigned xc_ = xcc_id; asm volatile("" : "+s"(bp_), "+s"(xc_)); xcd_barrier(bp_, xc_, (unsigned)G0, (volatile LAS unsigned*)(lds + 147000), wid0 == 0 && ln_ == 0); }
        DBG_DUMP(4)
        if constexpr (PH(5)) for (int rep_ = 0; rep_ < REP_P5A; ++rep_) {
            LOAD_ARGS
            pg8::SchedStd S; S.init(ws + WS_H, ws + WS_WTIN + (size_t)19 * 256 * 1024 * 2, NTOK, 3072, 1024, G, bx);
            EpiMerge E{(unsigned char*)(ws + WS_M3)};
            pg8::gemm_phase<EpiMerge, pg8::SchedStd>(lds, 1024, S, E, wid0);
        }
        { const int ln_ = lane_id_fresh(); unsigned* bp_ = barp; unsigned xc_ = xcc_id; asm volatile("" : "+s"(bp_), "+s"(xc_)); xcd_barrier(bp_, xc_, (unsigned)G0, (volatile LAS unsigned*)(lds + 147000), wid0 == 0 && ln_ == 0); }
        DBG_DUMP(5)
        if constexpr (PH(6)) for (int rep_ = 0; rep_ < REP_P5B; ++rep_) {
            LOAD_ARGS
            pg8::SchedMix S{(const char*)(ws + WS_QF), (const char*)(ws + WS_WTBR) + (size_t)l * 3 * 1024 * 512 * 2, G, bx};
            EpiMix E{(const unsigned char*)(ws + WS_M3), (bf16_t*)(ws + WS_MIX)};
            pg8::gemm_phase<EpiMix, pg8::SchedMix>(lds, 512, S, E, wid0);
        }
        { const int ln_ = lane_id_fresh(); unsigned* bp_ = barp; unsigned xc_ = xcc_id; asm volatile("" : "+s"(bp_), "+s"(xc_)); xcd_barrier(bp_, xc_, (unsigned)G0, (volatile LAS unsigned*)(lds + 147000), wid0 == 0 && ln_ == 0); }
        DBG_DUMP(6)
        if constexpr (PH(7)) for (int rep_ = 0; rep_ < (l == 0 ? REP_P6 : 1); ++rep_) {
            LOAD_ARGS
            const float* xsrc = (l == 0) ? A.x : A.out;
            pg8::SchedStd S; S.init(ws + WS_MIX, ws + WS_WTOUT + (size_t)l * 1024 * 1024 * 2, NTOK, 1024, 1024, G, bx);
            EpiOut E{xsrc, A.out, MOD + (size_t)l * 8 * 3072 + 2048};
            pg8::gemm_phase<EpiOut, pg8::SchedStd>(lds, 1024, S, E, wid0);
        }
        { const int ln_ = lane_id_fresh(); unsigned* bp_ = barp; unsigned xc_ = xcc_id; asm volatile("" : "+s"(bp_), "+s"(xc_)); xcd_barrier(bp_, xc_, (unsigned)G0, (volatile LAS unsigned*)(lds + 147000), wid0 == 0 && ln_ == 0); }
        DBG_DUMP(7)
        for (int rb_ = 1; rb_ < REP_BAR; ++rb_) { const int ln_ = lane_id_fresh(); unsigned* bp_ = barp; unsigned xc_ = xcc_id; asm volatile("" : "+s"(bp_), "+s"(xc_)); xcd_barrier(bp_, xc_, (unsigned)G0, (volatile LAS unsigned*)(lds + 147000), wid0 == 0 && ln_ == 0); }
    }
    PHASE_VARS
    for (int rep_ = 0; rep_ < REP_FIN; ++rep_)
    for (int m0 = gw * 4; m0 < NTOK; m0 += NGW * 4) {
        f32x4 v[4][4]; float ss[4];
#pragma unroll
        for (int r = 0; r < 4; ++r) { const f32x4* xr = (const f32x4*)(A.out + (size_t)(m0 + r) * 1024) + lane; ss[r] = 0.f;
#pragma unroll
            for (int j = 0; j < 4; ++j) v[r][j] = xr[64 * j]; }
        f32x4 gg[4];
#pragma unroll
        for (int j = 0; j < 4; ++j) gg[j] = *(const f32x4*)(A.g_final + 4 * lane + 256 * j);
#pragma unroll
        for (int r = 0; r < 4; ++r)
#pragma unroll
            for (int j = 0; j < 4; ++j) ss[r] += (v[r][j][0] * v[r][j][0] + v[r][j][1] * v[r][j][1]) + (v[r][j][2] * v[r][j][2] + v[r][j][3] * v[r][j][3]);
#pragma unroll
        for (int o = 1; o < 64; o <<= 1) {
#pragma unroll
            for (int r = 0; r < 4; ++r) ss[r] += shx(ss[r], o, lane); }
#pragma unroll
        for (int r = 0; r < 4; ++r) { const float rstd = 1.0f / sqrtf(ss[r] * (1.0f / 1024.f) + EPS); f32x4* xo = (f32x4*)(A.out + (size_t)(m0 + r) * 1024) + lane;
#pragma unroll
            for (int j = 0; j < 4; ++j) { if (rep_ == REP_FIN - 1 || G0 == 0x7fffff01) xo[64 * j] = v[r][j] * rstd * gg[j]; } }
    }
}

#undef A
extern "C" void kernel_launch(void* const* d_in, const int* in_sizes, int n_in, void* d_out, int out_size, void* d_ws, size_t ws_size, hipStream_t stream) {
    static int grid = 0;
    if (grid == 0) {
        if (n_in != 15 || ws_size < WS_END) { fprintf(stderr, "kernel_launch: unexpected n_in %d / ws %zu\n", n_in, ws_size); grid = -1; return; }
        int dev = 0, cus = 0, per_cu = 0;
        hipGetDevice(&dev);
        hipDeviceGetAttribute(&cus, hipDeviceAttributeMultiprocessorCount, dev);
        hipFuncSetAttribute((const void*)fwd_megakernel, hipFuncAttributeMaxDynamicSharedMemorySize, LDS_BYTES);
        hipOccupancyMaxActiveBlocksPerMultiprocessor(&per_cu, (const void*)fwd_megakernel, NTHR, LDS_BYTES);
        if (per_cu < 1) per_cu = 1;
        grid = cus * per_cu;
    }
    if (grid < 0) return;
    Args a{};
    a.x = (const float*)d_in[0]; a.c = (const float*)d_in[1]; a.pos = (const int*)d_in[2]; a.w_ada = (const float*)d_in[3]; a.b_ada = (const float*)d_in[4];
    a.g_norm = (const float*)d_in[5]; a.w_in = (const float*)d_in[6]; a.b_fgt = (const float*)d_in[7]; a.g_kv = (const float*)d_in[8]; a.w_kv_up = (const float*)d_in[9];
    a.w_br[0] = (const float*)d_in[10]; a.w_br[1] = (const float*)d_in[11]; a.w_br[2] = (const float*)d_in[12]; a.w_out = (const float*)d_in[13]; a.g_final = (const float*)d_in[14];
    a.out = (float*)d_out; a.ws = (unsigned char*)d_ws;
    hipMemsetAsync(d_ws, 0, 32768, stream);
    void* args[] = {&a};
    hipError_t e = hipLaunchCooperativeKernel((const void*)fwd_megakernel, dim3(grid), dim3(NTHR), args, LDS_BYTES, stream);
    if (e != hipSuccess) fprintf(stderr, "cooperative launch failed: %s (grid %d)\n", hipGetErrorString(e), grid);
}
```
